# Optimizing an MI355X kernel written in HIP

```python
import jax, jax.numpy as jnp
from jax import lax
import numpy as np

D_MODEL = 1024
BATCH = 1
SEQ = 16384
DEPTH = 4

N_MIXERS = 2
N_SSM_LAYERS = (DEPTH + 1) // 2
N_ATTN_LAYERS = DEPTH // 2
SSM_WIDTH = D_MODEL
SSM_GROUP = 16
SSM_GROUPS = SSM_WIDTH // SSM_GROUP
SSM_STATE = 64
DT_MIN = 1e-3
DT_MAX = 1e-1
HEAD_DIM = 128
N_HEADS = D_MODEL // HEAD_DIM
ATTN_WIDTH = N_HEADS * HEAD_DIM
ROT_DIM = HEAD_DIM // 4
ROPE_THETA = 500000.0
MOBA_BLOCK = 256
MOBA_TOPK = 3
Q_CHUNK = 128
NORM_EPS = 1e-6

kernel_name = "hybrid_s5_moba_interleaved"


def rms_norm(x, g):
    xf = x.astype(jnp.float32)
    y = xf * lax.rsqrt(jnp.mean(xf * xf, axis=-1, keepdims=True) + NORM_EPS)
    return (y * g.astype(jnp.float32)).astype(x.dtype)


def partial_rotary(x, pos):
    half = ROT_DIM // 2
    inv_freq = ROPE_THETA ** (-(jnp.arange(half, dtype=jnp.float32) * 2.0) / ROT_DIM)
    ang = pos.astype(jnp.float32)[:, None] * inv_freq[None, :]
    cos, sin = jnp.cos(ang), jnp.sin(ang)
    xf = x.astype(jnp.float32)
    x1, x2, rest = xf[..., :half], xf[..., half:ROT_DIM], xf[..., ROT_DIM:]
    out = jnp.concatenate([x1 * cos - x2 * sin, x2 * cos + x1 * sin, rest], axis=-1)
    return out.astype(x.dtype)


def _complex_linear_combine(e1, e2):
    a1r, a1i, b1r, b1i = e1
    a2r, a2i, b2r, b2i = e2
    ar = a2r * a1r - a2i * a1i
    ai = a2r * a1i + a2i * a1r
    br = a2r * b1r - a2i * b1i + b2r
    bi = a2r * b1i + a2i * b1r + b2i
    return (ar, ai, br, bi)


def s5_mixer(h, w_in, a_re, a_im, log_dt, b_re, b_im, c_re, c_im, d_skip, w_glu, b_glu, w_out):
    bsz, seq, _ = h.shape
    proj = h @ w_in
    u, z = proj[..., :SSM_WIDTH], proj[..., SSM_WIDTH:]
    uf = u.astype(jnp.float32)
    ug = uf.reshape(bsz, seq, SSM_GROUPS, SSM_GROUP)
    dt = jnp.exp(log_dt.astype(jnp.float32))[:, None]
    lr, li = a_re.astype(jnp.float32), a_im.astype(jnp.float32)
    mag = jnp.exp(lr * dt)
    ab_re, ab_im = mag * jnp.cos(li * dt), mag * jnp.sin(li * dt)
    den = lr * lr + li * li
    nr, ni = ab_re - 1.0, ab_im
    f_re = (nr * lr + ni * li) / den
    f_im = (ni * lr - nr * li) / den
    bu_re = jnp.einsum('blgc,gpc->blgp', ug, b_re.astype(jnp.float32))
    bu_im = jnp.einsum('blgc,gpc->blgp', ug, b_im.astype(jnp.float32))
    in_re = f_re * bu_re - f_im * bu_im
    in_im = f_re * bu_im + f_im * bu_re
    a_re_t = jnp.broadcast_to(ab_re, in_re.shape)
    a_im_t = jnp.broadcast_to(ab_im, in_re.shape)
    _, _, s_re, s_im = lax.associative_scan(
        _complex_linear_combine, (a_re_t, a_im_t, in_re, in_im), axis=1)
    y = (jnp.einsum('blgp,gcp->blgc', s_re, c_re.astype(jnp.float32))
         - jnp.einsum('blgp,gcp->blgc', s_im, c_im.astype(jnp.float32)))
    y = y.reshape(bsz, seq, SSM_WIDTH) + d_skip.astype(jnp.float32) * uf
    y = jax.nn.gelu(y)
    y = y * jax.nn.sigmoid(y @ w_glu.astype(jnp.float32) + b_glu.astype(jnp.float32))
    y = y.astype(h.dtype) * jax.nn.silu(z)
    return y @ w_out


def moba_mixer(h, w_in, q_gain, k_gain, w_out):
    bsz, seq, _ = h.shape
    proj = h @ w_in
    q, k, v, z = jnp.split(proj, 4, axis=-1)

    def heads(t):
        return t.reshape(bsz, seq, N_HEADS, HEAD_DIM).transpose(0, 2, 1, 3)

    pos = jnp.arange(seq)
    q = partial_rotary(rms_norm(heads(q), q_gain), pos)
    k = partial_rotary(rms_norm(heads(k), k_gain), pos)
    v = heads(v)
    n_blocks = -(-seq // MOBA_BLOCK)
    pad = n_blocks * MOBA_BLOCK - seq
    k_pad = jnp.pad(k, ((0, 0), (0, 0), (0, pad), (0, 0)))
    v_pad = jnp.pad(v, ((0, 0), (0, 0), (0, pad), (0, 0)))
    k_blocks = k_pad.reshape(bsz, N_HEADS, n_blocks, MOBA_BLOCK, HEAD_DIM)
    v_blocks = v_pad.reshape(bsz, N_HEADS, n_blocks, MOBA_BLOCK, HEAD_DIM)
    k_mean = jnp.mean(k_blocks.astype(jnp.float32), axis=3)
    top_k = min(MOBA_TOPK, n_blocks)
    scale = HEAD_DIM ** -0.5
    b_idx = jnp.arange(bsz)[:, None, None, None]
    h_idx = jnp.arange(N_HEADS)[None, :, None, None]
    blk_ids = jnp.arange(n_blocks)
    key_off = jnp.arange(MOBA_BLOCK)

    def chunk(c):
        start = c * Q_CHUNK
        qc = lax.dynamic_slice_in_dim(q, start, Q_CHUNK, axis=2).astype(jnp.float32)
        own = start // MOBA_BLOCK
        q_pos = start + jnp.arange(Q_CHUNK)
        gate = jnp.einsum('bhqd,bhnd->bhqn', qc, k_mean)
        gate = jnp.where(blk_ids[None, None, None, :] < own, gate, -jnp.inf)
        _, sel = lax.top_k(gate, top_k)
        sel_valid = sel < own
        k_sel = k_blocks[b_idx, h_idx, sel].astype(jnp.float32)
        v_sel = v_blocks[b_idx, h_idx, sel].astype(jnp.float32)
        s_sel = jnp.einsum('bhqd,bhqnkd->bhqnk', qc, k_sel) * scale
        s_sel = jnp.where(sel_valid[..., None], s_sel, -jnp.inf)
        k_own = lax.dynamic_slice_in_dim(k_pad, own * MOBA_BLOCK, MOBA_BLOCK, axis=2).astype(jnp.float32)
        v_own = lax.dynamic_slice_in_dim(v_pad, own * MOBA_BLOCK, MOBA_BLOCK, axis=2).astype(jnp.float32)
        s_own = jnp.einsum('bhqd,bhkd->bhqk', qc, k_own) * scale
        causal = (own * MOBA_BLOCK + key_off)[None, :] <= q_pos[:, None]
        s_own = jnp.where(causal, s_own, -jnp.inf)
        logits = jnp.concatenate(
            [s_own, s_sel.reshape(bsz, N_HEADS, Q_CHUNK, top_k * MOBA_BLOCK)], axis=-1)
        p = jax.nn.softmax(logits, axis=-1)
        p_own = p[..., :MOBA_BLOCK]
        p_sel = p[..., MOBA_BLOCK:].reshape(bsz, N_HEADS, Q_CHUNK, top_k, MOBA_BLOCK)
        o = (jnp.einsum('bhqk,bhkd->bhqd', p_own, v_own)
             + jnp.einsum('bhqnk,bhqnkd->bhqd', p_sel, v_sel))
        return o.astype(h.dtype)

    out = lax.map(chunk, jnp.arange(seq // Q_CHUNK))
    out = out.transpose(1, 0, 3, 2, 4).reshape(bsz, seq, ATTN_WIDTH)
    return (out * jax.nn.silu(z)) @ w_out


def setup_inputs(seed: int = 0) -> dict:
    key = jax.random.key(seed)
    ks = jax.random.split(key, 20)
    f32 = jnp.float32
    na, nb = N_SSM_LAYERS, N_ATTN_LAYERS
    G, P, C = SSM_GROUPS, SSM_STATE, SSM_GROUP
    x = jax.random.normal(ks[0], (BATCH, SEQ, D_MODEL), f32)
    norm_g = 1.0 + 0.02 * jax.random.normal(ks[1], (DEPTH, D_MODEL), f32)
    ssm_w_in = jax.random.normal(ks[2], (na, D_MODEL, 2 * SSM_WIDTH), f32) * D_MODEL ** -0.5
    ssm_a_re = -0.5 + 0.01 * jax.random.normal(ks[3], (na, G, P), f32)
    ssm_a_im = (jnp.pi * jnp.arange(P, dtype=f32))[None, None, :] + 0.01 * jax.random.normal(ks[4], (na, G, P), f32)
    ssm_log_dt = jax.random.uniform(ks[5], (na, G), f32, minval=float(np.log(DT_MIN)), maxval=float(np.log(DT_MAX)))
    ssm_b_re = jax.random.normal(ks[6], (na, G, P, C), f32) * (2 * C) ** -0.5
    ssm_b_im = jax.random.normal(ks[7], (na, G, P, C), f32) * (2 * C) ** -0.5
    ssm_c_re = jax.random.normal(ks[8], (na, G, C, P), f32) * P ** -0.5
    ssm_c_im = jax.random.normal(ks[9], (na, G, C, P), f32) * P ** -0.5
    ssm_d = jax.random.normal(ks[10], (na, SSM_WIDTH), f32)
    ssm_w_glu = jax.random.normal(ks[11], (na, SSM_WIDTH, SSM_WIDTH), f32) * SSM_WIDTH ** -0.5
    ssm_b_glu = 0.01 * jax.random.normal(ks[12], (na, SSM_WIDTH), f32)
    ssm_w_out = jax.random.normal(ks[13], (na, SSM_WIDTH, D_MODEL), f32) * SSM_WIDTH ** -0.5
    attn_w_in = jax.random.normal(ks[14], (nb, D_MODEL, 4 * ATTN_WIDTH), f32) * D_MODEL ** -0.5
    attn_q_gain = 1.0 + 0.02 * jax.random.normal(ks[15], (nb, HEAD_DIM), f32)
    attn_k_gain = 1.0 + 0.02 * jax.random.normal(ks[16], (nb, HEAD_DIM), f32)
    attn_w_out = jax.random.normal(ks[17], (nb, ATTN_WIDTH, D_MODEL), f32) * ATTN_WIDTH ** -0.5
    return {"x": x, "norm_g": norm_g, "ssm_w_in": ssm_w_in, "ssm_a_re": ssm_a_re,
            "ssm_a_im": ssm_a_im, "ssm_log_dt": ssm_log_dt, "ssm_b_re": ssm_b_re,
            "ssm_b_im": ssm_b_im, "ssm_c_re": ssm_c_re, "ssm_c_im": ssm_c_im,
            "ssm_d": ssm_d, "ssm_w_glu": ssm_w_glu, "ssm_b_glu": ssm_b_glu,
            "ssm_w_out": ssm_w_out, "attn_w_in": attn_w_in, "attn_q_gain": attn_q_gain,
            "attn_k_gain": attn_k_gain, "attn_w_out": attn_w_out}


def reference(x, norm_g, ssm_w_in, ssm_a_re, ssm_a_im, ssm_log_dt, ssm_b_re, ssm_b_im,
              ssm_c_re, ssm_c_im, ssm_d, ssm_w_glu, ssm_b_glu, ssm_w_out,
              attn_w_in, attn_q_gain, attn_k_gain, attn_w_out):
    h = x
    for i in range(DEPTH):
        hn = rms_norm(h, norm_g[i])
        j = i // N_MIXERS
        if i % N_MIXERS == 0:
            y = s5_mixer(hn, ssm_w_in[j], ssm_a_re[j], ssm_a_im[j], ssm_log_dt[j],
                         ssm_b_re[j], ssm_b_im[j], ssm_c_re[j], ssm_c_im[j], ssm_d[j],
                         ssm_w_glu[j], ssm_b_glu[j], ssm_w_out[j])
        else:
            y = moba_mixer(hn, attn_w_in[j], attn_q_gain[j], attn_k_gain[j], attn_w_out[j])
        h = h + y
    return h
```

```cpp
#include <hip/hip_runtime.h>
#include <hip/hip_cooperative_groups.h>
#include <cstdio>
#include <cstdint>
namespace cg = cooperative_groups;

#define LAS __attribute__((address_space(3)))
typedef unsigned short bf16_t;
typedef short bf16x8 __attribute__((ext_vector_type(8)));
typedef short s16x4 __attribute__((ext_vector_type(4)));
typedef float f32x2 __attribute__((ext_vector_type(2)));
typedef float f32x4 __attribute__((ext_vector_type(4)));
typedef float f32x16 __attribute__((ext_vector_type(16)));
typedef unsigned u32x2 __attribute__((ext_vector_type(2)));
typedef unsigned u32x4 __attribute__((ext_vector_type(4)));
typedef __bf16 bf16v2 __attribute__((ext_vector_type(2)));

__device__ __forceinline__ unsigned pk2(float lo, float hi) { f32x2 v = {lo, hi}; bf16v2 b = __builtin_convertvector(v, bf16v2); return __builtin_bit_cast(unsigned, b); }
__device__ __forceinline__ float bflo(unsigned w) { return __uint_as_float(w << 16); }
__device__ __forceinline__ float bfhi(unsigned w) { return __uint_as_float(w & 0xffff0000u); }
__device__ __forceinline__ float sigmoidf_(float x) { return 1.0f / (1.0f + __expf(-x)); }
__device__ __forceinline__ float gelu_tanh(float y) { const float t = 0.7978845608028654f * (y + 0.044715f * y * y * y); const float e = __expf(2.0f * t); const float th = 1.0f - 2.0f / (e + 1.0f); return 0.5f * y * (1.0f + th); }

__device__ __forceinline__ int tid_l() { int t = threadIdx.x; asm volatile("" : "+v"(t)); return t; }
__device__ __forceinline__ int sg_l(int v) { v = __builtin_amdgcn_readfirstlane(v); asm volatile("" : "+s"(v)); return v; }
constexpr int L = 16384, DM = 1024, NH = 8, HD = 128, NBLK = 64;
constexpr size_t MiB = 1u << 20;
constexpr size_t WS_CTL = 0, WS_KMEAN = 256 * 1024;
constexpr size_t WS_W = 1 * MiB, WS_TAB = 11 * MiB, WS_XN = 21 * MiB, WS_BIG = 53 * MiB;
constexpr size_t WS_U = WS_BIG, WS_Z = WS_BIG + 32 * MiB, WS_YG = WS_BIG + 64 * MiB, WS_Y2 = WS_BIG + 96 * MiB;
constexpr size_t WS_P1 = 181 * MiB, WS_P2 = 213 * MiB, WS_SLOC = 181 * MiB, WS_SIN = 213 * MiB;
constexpr size_t WS_LPART = 245 * MiB, WS_ROPE = 247 * MiB, WS_EP = 249 * MiB, WS_END = 251 * MiB;
constexpr int EP_STRIDE = 19 * 64 * 2;
constexpr int TAB_STRIDE = 147456;
constexpr int LIST_PER_HEAD = 516096;
__host__ __device__ __forceinline__ int list_off(int n) { return 16128 * n - 128 * n * (n - 1); }
constexpr int LDS_BYTES = 147456;
constexpr float NORM_EPS = 1e-6f;

namespace pg8 {
constexpr int BM = 256, BK = 64, HALF = 128, HTB = HALF * BK * 2, STAGE_BYTES = 8 * HTB, NXCD = 8, WGM = 8;
__host__ __device__ __forceinline__ int lds_byte(int r, int c) { const int st = (r >> 4) * 2 + (c >> 5), rr = r & 15, cc = c & 31, ob = rr * 64 + cc * 2; return st * 1024 + (ob ^ (((ob >> 9) & 1) << 5)); }
__host__ __device__ __forceinline__ void stage_rc(int b, int& R, int& C) { const int st = b / 1024, sb = b % 1024, swz = sb ^ (((sb >> 9) & 1) << 5); R = (st >> 1) * 16 + swz / 64; C = (st & 1) * 32 + (swz % 64) / 2; }
__host__ __device__ __forceinline__ int perm32(int rho) { const int n = rho >> 4, i = rho & 15; return 8 * (i >> 2) + 4 * n + (i & 3); }
struct Unit { int pm, pn; };
struct Gemm { const bf16_t* A; const bf16_t* Bt; int M, N, K; };
struct StaticOrder {
    int nM, nN, nwg, G, c;
    __host__ __device__ void init(int M, int N, int G_, int c_) { nM = M / BM; nN = N / BM; nwg = nM * nN; G = G_; c = c_; }
    __host__ __device__ bool next(int i, Unit& u) const {
        const long Lx = (long)i * G + c; if (Lx >= nwg) return false;
        int wgid = (int)Lx; { const int q = nwg / NXCD, r = nwg % NXCD, xcd = wgid % NXCD, off = wgid / NXCD; wgid = (xcd < r ? xcd * (q + 1) : r * (q + 1) + (xcd - r) * q) + off; }
        const int nig = WGM * nN, gid = wgid / nig, fm = gid * WGM, gsz = (nM - fm) < WGM ? (nM - fm) : WGM;
        u.pm = fm + ((wgid % nig) % gsz); u.pn = (wgid % nig) / gsz; return true;
    }
    __device__ __forceinline__ void a_ready(const Unit&) const {}
    __device__ __forceinline__ void done(const Unit&) const {}
};

struct EpiStore {
    static constexpr bool PERM = true, AFTER_DRAIN = false;
    bf16_t* O; int ldc; int split_cols; size_t split_stride;
    __device__ __forceinline__ void operator()(const f32x4 (&acc)[2][2][4][2], const Unit& u, int wr, int wc, int fr, int fq) const {
        const int row0 = u.pm * BM + wr * 64 + fr; int colt = u.pn * BM; bf16_t* base = O;
        if (split_cols) { const int t = colt / split_cols; base += (size_t)t * split_stride; colt -= t * split_cols; }
        const int col0 = colt + wc * 32 + 8 * fq;
#pragma unroll
        for (int ai = 0; ai < 2; ++ai)
#pragma unroll
            for (int m = 0; m < 4; ++m) { bf16_t* rowp = base + (size_t)(row0 + ai * HALF + m * 16) * ldc + col0;
#pragma unroll
                for (int bj = 0; bj < 2; ++bj) { const f32x4 v0 = acc[ai][bj][m][0], v1 = acc[ai][bj][m][1];
                    u32x4 w; w.x = pk2(v0[0], v0[1]); w.y = pk2(v0[2], v0[3]); w.z = pk2(v1[0], v1[1]); w.w = pk2(v1[2], v1[3]);
                    *(u32x4*)(rowp + bj * HALF) = w; } }
    }
};
struct EpiGlu {
    static constexpr bool PERM = true, AFTER_DRAIN = false;
    const bf16_t* YG; const bf16_t* Z; const float* bias; bf16_t* O;
    __device__ __forceinline__ void operator()(const f32x4 (&acc)[2][2][4][2], const Unit& u, int wr, int wc, int fr, int fq) const {
        const int row0 = u.pm * BM + wr * 64 + fr; const int col0 = u.pn * BM + wc * 32 + 8 * fq;
#pragma unroll
        for (int bj = 0; bj < 2; ++bj) {
            const f32x4 b0 = *(const f32x4*)(bias + col0 + bj * HALF), b1 = *(const f32x4*)(bias + col0 + bj * HALF + 4);
#pragma unroll
            for (int ai = 0; ai < 2; ++ai)
#pragma unroll
                for (int m = 0; m < 4; ++m) {
                    const size_t off = (size_t)(row0 + ai * HALF + m * 16) * DM + col0 + bj * HALF;
                    const u32x4 yv = *(const u32x4*)(YG + off), zv = *(const u32x4*)(Z + off);
                    const f32x4 v0 = acc[ai][bj][m][0] + b0, v1 = acc[ai][bj][m][1] + b1;
                    float r[8];
#pragma unroll
                    for (int q = 0; q < 4; ++q) {
                        const float a0 = q < 2 ? v0[2 * q] : v1[2 * q - 4], a1 = q < 2 ? v0[2 * q + 1] : v1[2 * q - 3];
                        const float y0 = bflo(yv[q]), y1 = bfhi(yv[q]), z0 = bflo(zv[q]), z1 = bfhi(zv[q]);
                        r[2 * q] = y0 * sigmoidf_(a0) * (z0 * sigmoidf_(z0)); r[2 * q + 1] = y1 * sigmoidf_(a1) * (z1 * sigmoidf_(z1));
                    }
                    u32x4 w; w.x = pk2(r[0], r[1]); w.y = pk2(r[2], r[3]); w.z = pk2(r[4], r[5]); w.w = pk2(r[6], r[7]);
                    *(u32x4*)(O + off) = w;
                }
        }
    }
};
struct EpiRes {
    static constexpr bool PERM = true, AFTER_DRAIN = false;
    const float* base; float* out;
    __device__ __forceinline__ void operator()(const f32x4 (&acc)[2][2][4][2], const Unit& u, int wr, int wc, int fr, int fq) const {
        const int row0 = u.pm * BM + wr * 64 + fr; const int col0 = u.pn * BM + wc * 32 + 8 * fq;
#pragma unroll
        for (int ai = 0; ai < 2; ++ai)
#pragma unroll
            for (int m = 0; m < 4; ++m)
#pragma unroll
                for (int bj = 0; bj < 2; ++bj) {
                    const size_t off = (size_t)(row0 + ai * HALF + m * 16) * DM + col0 + bj * HALF;
                    const f32x4 a0 = *(const f32x4*)(base + off), a1 = *(const f32x4*)(base + off + 4);
                    *(f32x4*)(out + off) = a0 + acc[ai][bj][m][0]; *(f32x4*)(out + off + 4) = a1 + acc[ai][bj][m][1];
                }
    }
};

template <class Epi, class Sched, bool ALIGN_EPI = false, bool SP2 = false>
__device__ __forceinline__ void gemm_phase(LAS unsigned char* lds, const Gemm g, const Sched& S, const Epi& E) {
    const int tid = tid_l(), wid = __builtin_amdgcn_readfirstlane(tid >> 6), lane = tid & 63, wr = wid >> 2, wc = wid & 3, fr = lane & 15, fq = lane >> 4;
    const int K = g.K, nt = K / BK;
    unsigned voffA[2], voffB[2];
#pragma unroll
    for (int i = 0; i < 2; ++i) { int R, C; stage_rc(tid * 16 + i * 8192, R, C); const int Rb = Epi::PERM ? ((R & ~31) + perm32(R & 31)) : R;
        voffA[i] = (unsigned)(R * K + C) * 2u; voffB[i] = (unsigned)(Rb * K + C) * 2u; }
    const size_t kstep = (size_t)(BK * 2);
    const size_t hstep = (size_t)HALF * K * 2;
    const size_t tstep = 2 * hstep;
    const unsigned ldsw = (unsigned)wid * 1024u;
    const int aoff = lds_byte(wr * 64 + fr, fq * 8), boff = lds_byte(wc * 32 + fr, fq * 8);
#define PG8_SA(b, h) (((b) * 2 + (h)) * HTB)
#define PG8_SB(b, h) ((4 + (b) * 2 + (h)) * HTB)
#define PG8_STAGE(bufoff, gbase, voff) do { _Pragma("unroll") for (int _i = 0; _i < 2; ++_i) \
        __builtin_amdgcn_global_load_lds((const unsigned*)((const char*)(gbase) + (voff)[_i]), (LAS unsigned*)(lds + (bufoff) + ldsw + _i * 8192), 16, 0, 0); } while (0)
#define PG8_LDA(dst, b, h) do { _Pragma("unroll") for (int m = 0; m < 4; ++m) _Pragma("unroll") for (int k = 0; k < 2; ++k) dst[m][k] = *(const LAS bf16x8*)(lds + PG8_SA(b, h) + aoff + m * 2048 + k * 1024); } while (0)
#define PG8_LDB(dst, b, h) do { _Pragma("unroll") for (int n = 0; n < 2; ++n) _Pragma("unroll") for (int k = 0; k < 2; ++k) dst[n][k] = *(const LAS bf16x8*)(lds + PG8_SB(b, h) + boff + n * 2048 + k * 1024); } while (0)
#define PG8_MMA(ai, bj, At, Bt) do { __builtin_amdgcn_s_setprio(1); _Pragma("unroll") for (int m = 0; m < 4; ++m) _Pragma("unroll") for (int n = 0; n < 2; ++n) _Pragma("unroll") for (int k = 0; k < 2; ++k) \
        acc[ai][bj][m][n] = __builtin_amdgcn_mfma_f32_16x16x32_bf16(Bt[n][k], At[m][k], acc[ai][bj][m][n], 0, 0, 0); __builtin_amdgcn_s_setprio(0); } while (0)
#define PG8_WAIT_V(n) asm volatile("s_waitcnt vmcnt(" #n ")" ::: "memory")
#define PG8_WAIT_L(n) asm volatile("s_waitcnt lgkmcnt(" #n ")" ::: "memory")
#define PG8_BAR __builtin_amdgcn_s_barrier()
#define PG8_SCHED __builtin_amdgcn_sched_barrier(0)
    Unit cur, nxt; int ui = 0;
    if (!S.next(0, cur)) return;
    f32x4 acc[2][2][4][2];
#pragma unroll
    for (int a = 0; a < 2; ++a)
#pragma unroll
        for (int b = 0; b < 2; ++b)
#pragma unroll
            for (int m = 0; m < 4; ++m)
#pragma unroll
                for (int n = 0; n < 2; ++n) acc[a][b][m][n] = (f32x4){0.f, 0.f, 0.f, 0.f};
    bf16x8 At[4][2], B0[2][2], B1[2][2];
    const char* cA = (const char*)g.A + (size_t)cur.pm * tstep; const char* cB = (const char*)g.Bt + (size_t)cur.pn * tstep;
    S.a_ready(cur);
    if constexpr (SP2) {
        PG8_STAGE(PG8_SB(0, 0), cB, voffB); PG8_STAGE(PG8_SB(0, 1), cB + hstep, voffB); PG8_STAGE(PG8_SA(0, 0), cA, voffA); PG8_STAGE(PG8_SA(0, 1), cA + hstep, voffA);
        if (wr == 1) PG8_BAR;
        PG8_WAIT_V(2); PG8_BAR;
        PG8_STAGE(PG8_SB(1, 0), cB + kstep, voffB); PG8_STAGE(PG8_SA(1, 0), cA + kstep, voffA); PG8_STAGE(PG8_SB(1, 1), cB + hstep + kstep, voffB);
        PG8_WAIT_V(6); PG8_BAR;
    } else {
        PG8_STAGE(PG8_SB(0, 0), cB, voffB); PG8_STAGE(PG8_SA(0, 0), cA, voffA); PG8_STAGE(PG8_SB(0, 1), cB + hstep, voffB); PG8_STAGE(PG8_SA(0, 1), cA + hstep, voffA);
        if (wr == 1) PG8_BAR;
        PG8_WAIT_V(4); PG8_BAR;
        PG8_STAGE(PG8_SB(1, 0), cB + kstep, voffB); PG8_STAGE(PG8_SA(1, 0), cA + kstep, voffA); PG8_STAGE(PG8_SB(1, 1), cB + hstep + kstep, voffB);
        PG8_WAIT_V(6); PG8_BAR;
    }
    for (;;) {
        const bool has_next = S.next(ui + 1, nxt);
        const char* nA = has_next ? (const char*)g.A + (size_t)nxt.pm * tstep : cA; const char* nB = has_next ? (const char*)g.Bt + (size_t)nxt.pn * tstep : cB;
        for (int t = 0; t < nt; t += 2) {
            const bool last = (t == nt - 2);
            const char* a1 = cA + (size_t)(t + 1) * kstep;
            const char* a2 = last ? nA : cA + (size_t)(t + 2) * kstep; const char* b2 = last ? nB : cB + (size_t)(t + 2) * kstep;
            const char* a3 = a2 + kstep; const char* b3 = b2 + kstep;
            if (last && has_next) S.a_ready(nxt);
            if constexpr (SP2) {
            PG8_LDB(B0, 0, 0); PG8_LDB(B1, 0, 1); PG8_SCHED; PG8_LDA(At, 0, 0); PG8_STAGE(PG8_SA(1, 1), a1 + hstep, voffA);
            PG8_WAIT_V(8); PG8_WAIT_L(0); PG8_BAR; PG8_MMA(0, 0, At, B0); PG8_MMA(0, 1, At, B1); PG8_BAR; PG8_SCHED;
            PG8_LDA(At, 0, 1); PG8_STAGE(PG8_SB(0, 0), b2, voffB); PG8_STAGE(PG8_SB(0, 1), b2 + hstep, voffB); PG8_STAGE(PG8_SA(0, 0), a2, voffA);
            PG8_WAIT_V(8); PG8_WAIT_L(0); PG8_BAR; PG8_MMA(1, 0, At, B0); PG8_MMA(1, 1, At, B1); PG8_BAR; PG8_SCHED;
            PG8_LDB(B0, 1, 0); PG8_LDB(B1, 1, 1); PG8_SCHED; PG8_LDA(At, 1, 0); PG8_STAGE(PG8_SA(0, 1), a2 + hstep, voffA);
            PG8_WAIT_V(8); PG8_WAIT_L(0); PG8_BAR; PG8_MMA(0, 0, At, B0); PG8_MMA(0, 1, At, B1); PG8_BAR; PG8_SCHED;
            PG8_LDA(At, 1, 1); PG8_STAGE(PG8_SB(1, 0), b3, voffB); PG8_STAGE(PG8_SB(1, 1), b3 + hstep, voffB); PG8_STAGE(PG8_SA(1, 0), a3, voffA);
            PG8_WAIT_V(8); PG8_WAIT_L(0); PG8_BAR; PG8_MMA(1, 0, At, B0); PG8_MMA(1, 1, At, B1); PG8_BAR; PG8_SCHED;
            } else {
            PG8_LDB(B0, 0, 0); PG8_SCHED; PG8_LDA(At, 0, 0); PG8_STAGE(PG8_SA(1, 1), a1 + hstep, voffA);
            PG8_WAIT_L(8); PG8_BAR; PG8_WAIT_L(0); PG8_MMA(0, 0, At, B0); PG8_BAR; PG8_SCHED;
            PG8_LDB(B1, 0, 1); PG8_STAGE(PG8_SB(0, 0), b2, voffB);
            PG8_BAR; PG8_WAIT_L(0); PG8_MMA(0, 1, At, B1); PG8_BAR;
            PG8_LDA(At, 0, 1); PG8_STAGE(PG8_SA(0, 0), a2, voffA);
            PG8_BAR; PG8_WAIT_L(0); PG8_MMA(1, 0, At, B0); PG8_BAR; PG8_SCHED;
            PG8_STAGE(PG8_SB(0, 1), b2 + hstep, voffB);
            PG8_WAIT_V(6); PG8_BAR; PG8_MMA(1, 1, At, B1); PG8_BAR;
            PG8_LDB(B0, 1, 0); PG8_SCHED; PG8_LDA(At, 1, 0); PG8_STAGE(PG8_SA(0, 1), a2 + hstep, voffA);
            PG8_WAIT_L(8); PG8_BAR; PG8_WAIT_L(0); PG8_MMA(0, 0, At, B0); PG8_BAR; PG8_SCHED;
            PG8_LDB(B1, 1, 1); PG8_STAGE(PG8_SB(1, 0), b3, voffB);
            PG8_BAR; PG8_WAIT_L(0); PG8_MMA(0, 1, At, B1); PG8_BAR;
            PG8_LDA(At, 1, 1); PG8_STAGE(PG8_SA(1, 0), a3, voffA);
            PG8_BAR; PG8_WAIT_L(0); PG8_MMA(1, 0, At, B0); PG8_BAR; PG8_SCHED;
            PG8_STAGE(PG8_SB(1, 1), b3 + hstep, voffB);
            PG8_WAIT_V(6); PG8_BAR; PG8_MMA(1, 1, At, B1); PG8_BAR;
            }
        }
        if constexpr (ALIGN_EPI) { if (wr == 0) PG8_BAR; }
        if constexpr (!Epi::AFTER_DRAIN) { E(acc, cur, wr, wc, fr, fq); S.done(cur); }
        if (!has_next) break;
#pragma unroll
        for (int a = 0; a < 2; ++a)
#pragma unroll
            for (int b = 0; b < 2; ++b)
#pragma unroll
                for (int m = 0; m < 4; ++m)
#pragma unroll
                    for (int n = 0; n < 2; ++n) acc[a][b][m][n] = (f32x4){0.f, 0.f, 0.f, 0.f};
        cur = nxt; cA = nA; cB = nB; ++ui;
        if constexpr (ALIGN_EPI) { if (wr == 1) PG8_BAR; }
    }
    PG8_WAIT_V(0);
    if constexpr (!ALIGN_EPI) { if (wr == 0) PG8_BAR; }
    PG8_BAR;
#undef PG8_SA
#undef PG8_SB
#undef PG8_STAGE
#undef PG8_LDA
#undef PG8_LDB
#undef PG8_MMA
#undef PG8_WAIT_V
#undef PG8_WAIT_L
#undef PG8_BAR
#undef PG8_SCHED
}
}

struct Args { const float* in[18]; float* out; unsigned char* ws; };
typedef const __attribute__((address_space(4))) Args* ArgsP;
__device__ __forceinline__ ArgsP launder(ArgsP p) { asm volatile("" : "+s"(p)); return p; }

#define MFMA16(a, b, c) __builtin_amdgcn_mfma_f32_16x16x32_bf16((a), (b), (c), 0, 0, 0)
#define MFMA32(a, b, c) __builtin_amdgcn_mfma_f32_32x32x16_bf16((a), (b), (c), 0, 0, 0)

__device__ __forceinline__ float wave_sum(float v) {
#pragma unroll
    for (int o = 1; o < 64; o <<= 1) v += __shfl_xor(v, o);
    return v;
}

__device__ __forceinline__ void transpose_item(const float* W, int K, int N, bf16_t* WT, float* scr, int item, int lane) {
    const int nblk = N / 32, kb = item / nblk, nb = item % nblk, k0 = 64 * kb, n0 = 32 * nb;
#pragma unroll 8
    for (int i = 0; i < 32; ++i) { const int kk = 2 * i + (lane >> 5); scr[kk * 33 + (lane & 31)] = W[(size_t)(k0 + kk) * N + n0 + (lane & 31)]; }
    __builtin_amdgcn_wave_barrier(); asm volatile("s_waitcnt lgkmcnt(0)" ::: "memory");
    const int c = lane & 7;
#pragma unroll
    for (int j = 0; j < 4; ++j) { const int n = (lane >> 3) + 8 * j; const float* s = scr + (8 * c) * 33 + n;
        u32x4 o; o.x = pk2(s[0 * 33], s[1 * 33]); o.y = pk2(s[2 * 33], s[3 * 33]); o.z = pk2(s[4 * 33], s[5 * 33]); o.w = pk2(s[6 * 33], s[7 * 33]);
        *(u32x4*)(WT + (size_t)(n0 + n) * K + k0 + 8 * c) = o; }
    asm volatile("s_waitcnt lgkmcnt(0)" ::: "memory"); __builtin_amdgcn_wave_barrier();
}

__device__ __forceinline__ void ssm_tables(ArgsP a, int j, int g, unsigned char* smem, unsigned char* tab) {
    float* Epow = (float*)smem;
    float* Bb = Epow + 17 * 64 * 2;
    float* Cc = Bb + 64 * 16 * 2;
    float* Fp = Cc + 16 * 64 * 2;
    float* Km = Fp + 128;
    const int tid = tid_l();
    const float* a_re = a->in[3] + (size_t)(j * 64 + g) * 64; const float* a_im = a->in[4] + (size_t)(j * 64 + g) * 64;
    const float* b_re = a->in[6] + (size_t)(j * 64 + g) * 64 * 16; const float* b_im = a->in[7] + (size_t)(j * 64 + g) * 64 * 16;
    const float* c_re = a->in[8] + (size_t)(j * 64 + g) * 16 * 64; const float* c_im = a->in[9] + (size_t)(j * 64 + g) * 16 * 64;
    { const float* ep = (const float*)(a->ws + WS_EP) + (size_t)(j * 64 + g) * EP_STRIDE;
      for (int e = tid; e < 17 * 64 * 2; e += 512) Epow[e] = ep[e];
      if (tid < 128) Fp[tid] = ep[18 * 128 + tid]; }
    __syncthreads();
    for (int e = tid; e < 1024; e += 512) {
        { const int p = e >> 4; const float fr_ = Fp[p * 2], fi_ = Fp[p * 2 + 1], br = b_re[e], bi = b_im[e];
          Bb[e * 2] = fr_ * br - fi_ * bi; Bb[e * 2 + 1] = fr_ * bi + fi_ * br; }
        Cc[e * 2] = c_re[e]; Cc[e * 2 + 1] = c_im[e];
    }
    __syncthreads();
    for (int e = tid; e < 4096; e += 512) {
        const int d = e >> 8, c = (e >> 4) & 15, c2 = e & 15; float acc = 0.f;
        for (int p = 0; p < 64; ++p) {
            const float ar = Epow[(d * 64 + p) * 2], ai = Epow[(d * 64 + p) * 2 + 1], br = Bb[(p * 16 + c2) * 2], bi = Bb[(p * 16 + c2) * 2 + 1];
            const float gr = ar * br - ai * bi, gi = ar * bi + ai * br;
            acc += Cc[(c * 64 + p) * 2] * gr - Cc[(c * 64 + p) * 2 + 1] * gi;
        }
        Km[e] = acc;
    }
    __syncthreads();
    for (int e = tid; e < 16 * 64; e += 512) {
        const int d = e >> 6, l = e & 63, c = l & 15, ts = l >> 5, c0 = ((l >> 4) & 1) * 8, dd = d - ts; float v[8];
#pragma unroll
        for (int jj = 0; jj < 8; ++jj) v[jj] = dd >= 0 ? Km[(dd * 16 + c) * 16 + c0 + jj] : 0.f;
        u32x4 w; w.x = pk2(v[0], v[1]); w.y = pk2(v[2], v[3]); w.z = pk2(v[4], v[5]); w.w = pk2(v[6], v[7]);
        *(u32x4*)(tab + d * 1024 + l * 16) = w;
    }
    for (int e = tid; e < 64 * 64; e += 512) {
        const int f = e >> 6, l = e & 63, mt = f >> 3, ks = f & 7, m = mt * 16 + (l & 15), p = m >> 1, ri = m & 1, tau = ks * 2 + (l >> 5), c0 = ((l >> 4) & 1) * 8;
        const float ar = Epow[((15 - tau) * 64 + p) * 2], ai = Epow[((15 - tau) * 64 + p) * 2 + 1]; float v[8];
#pragma unroll
        for (int jj = 0; jj < 8; ++jj) { const float br = Bb[(p * 16 + c0 + jj) * 2], bi = Bb[(p * 16 + c0 + jj) * 2 + 1]; v[jj] = ri == 0 ? (ar * br - ai * bi) : (ar * bi + ai * br); }
        u32x4 w; w.x = pk2(v[0], v[1]); w.y = pk2(v[2], v[3]); w.z = pk2(v[4], v[5]); w.w = pk2(v[6], v[7]);
        *(u32x4*)(tab + 16384 + f * 1024 + l * 16) = w;
    }
    for (int e = tid; e < 64 * 64; e += 512) {
        const int f = e >> 6, l = e & 63, t = f >> 2, kk = f & 3, c = l & 15, m0 = kk * 32 + (l >> 4) * 8; float v[8];
#pragma unroll
        for (int jj = 0; jj < 8; ++jj) { const int m = m0 + jj, p = m >> 1, ri = m & 1;
            const float ar = Epow[((t + 1) * 64 + p) * 2], ai = Epow[((t + 1) * 64 + p) * 2 + 1], cr = Cc[(c * 64 + p) * 2], ci = Cc[(c * 64 + p) * 2 + 1];
            v[jj] = ri == 0 ? (cr * ar - ci * ai) : -(cr * ai + ci * ar); }
        u32x4 w; w.x = pk2(v[0], v[1]); w.y = pk2(v[2], v[3]); w.z = pk2(v[4], v[5]); w.w = pk2(v[6], v[7]);
        *(u32x4*)(tab + 16384 + 65536 + f * 1024 + l * 16) = w;
    }
    __syncthreads();
}

__device__ __forceinline__ void pre0_phase(ArgsP a) {
    const int tid = tid_l(), G = sg_l(gridDim.x), bid = sg_l(blockIdx.x);
    unsigned char* ws = a->ws;
    float* rope = (float*)(ws + WS_ROPE);
    for (int e = bid * 512 + tid; e < L * 16; e += G * 512) {
        const int pos = e >> 4, i = e & 15;
        const double invf = exp(-(double)i * (1.0 / 16.0) * 13.122363377404328);
        double ang = (double)pos * invf; ang -= 6.283185307179586476925 * floor(ang / 6.283185307179586476925);
        rope[e * 2] = (float)cos(ang); rope[e * 2 + 1] = (float)sin(ang);
    }
    float* epb = (float*)(ws + WS_EP);
    for (int e = bid * 512 + tid; e < 2 * 64 * 19 * 64; e += G * 512) {
        const int p = e & 63, n = (e >> 6) % 19, jg = (e >> 6) / 19;
        const double dt = exp((double)a->in[5][jg]);
        const double lr = (double)a->in[3][(size_t)jg * 64 + p], li = (double)a->in[4][(size_t)jg * 64 + p];
        const double pw = n <= 16 ? (double)n : (n == 17 ? 512.0 : 1.0);
        const double mag = exp(lr * dt * pw); double ang = li * dt * pw; ang -= 6.283185307179586476925 * floor(ang / 6.283185307179586476925);
        double cr = cos(ang) * mag, ci = sin(ang) * mag;
        if (n == 18) { const double nr = cr - 1.0, ni = ci, den = lr * lr + li * li; cr = (nr * lr + ni * li) / den; ci = (ni * lr - nr * li) / den; }
        epb[(size_t)jg * EP_STRIDE + (n * 64 + p) * 2] = (float)cr; epb[(size_t)jg * EP_STRIDE + (n * 64 + p) * 2 + 1] = (float)ci;
    }
}
__device__ __forceinline__ void prep_phase(ArgsP a, int layer, const float* h, unsigned char* smem) {
    const int tid = tid_l(), lane = tid & 63, wave = tid >> 6, G = sg_l(gridDim.x), bid = sg_l(blockIdx.x);
    unsigned char* ws = a->ws;
    const int j = layer >> 1;
    if ((layer & 1) == 0) {
        for (int g = bid; g < 64; g += G) ssm_tables(a, j, g, smem, ws + WS_TAB + (size_t)g * TAB_STRIDE);
    }
    __syncthreads();
    float* scr = (float*)(smem + wave * 16384);
    const int gw = bid * 8 + wave, NGW = G * 8;
    bf16_t* Wb = (bf16_t*)(ws + WS_W);
    if ((layer & 1) == 0) {
        const float* w_in = a->in[2] + (size_t)j * 1024 * 2048; const float* w_glu = a->in[11] + (size_t)j * 1024 * 1024; const float* w_out = a->in[13] + (size_t)j * 1024 * 1024;
        for (int it = gw; it < 2048; it += NGW) {
            if (it < 1024) transpose_item(w_in, 1024, 2048, Wb, scr, it, lane);
            else if (it < 1536) transpose_item(w_glu, 1024, 1024, Wb + 2048 * 1024, scr, it - 1024, lane);
            else transpose_item(w_out, 1024, 1024, Wb + 3072 * 1024, scr, it - 1536, lane);
        }
    } else {
        const float* w_in = a->in[14] + (size_t)j * 1024 * 4096; const float* w_out = a->in[17] + (size_t)j * 1024 * 1024;
        for (int it = gw; it < 2560; it += NGW) {
            if (it < 2048) transpose_item(w_in, 1024, 4096, Wb, scr, it, lane);
            else transpose_item(w_out, 1024, 1024, Wb + 4096 * 1024, scr, it - 2048, lane);
        }
    }
    const float* gain = a->in[1] + layer * 1024;
    bf16_t* XN = (bf16_t*)(ws + WS_XN);
    f32x4 gv[4];
#pragma unroll
    for (int q = 0; q < 4; ++q) gv[q] = *(const f32x4*)(gain + 4 * lane + 256 * q);
    for (int m = gw; m < L; m += NGW) {
        const f32x4* xr = (const f32x4*)(h + (size_t)m * DM) + lane;
        f32x4 v[4]; float s = 0.f;
#pragma unroll
        for (int q = 0; q < 4; ++q) { v[q] = xr[64 * q]; s += (v[q].x * v[q].x + v[q].y * v[q].y) + (v[q].z * v[q].z + v[q].w * v[q].w); }
        const float rstd = rsqrtf(wave_sum(s) * (1.f / DM) + NORM_EPS);
        u32x2* o8 = (u32x2*)(XN + (size_t)m * DM) + lane;
#pragma unroll
        for (int q = 0; q < 4; ++q) { u32x2 w; w.x = pk2(v[q].x * rstd * gv[q].x, v[q].y * rstd * gv[q].y); w.y = pk2(v[q].z * rstd * gv[q].z, v[q].w * rstd * gv[q].w); o8[64 * q] = w; }
    }
}

__device__ __forceinline__ void ssm_s1(ArgsP a, unsigned char* smem) {
    const int tid = tid_l(), lane = tid & 63, wave = tid >> 6, G = sg_l(gridDim.x);
    unsigned char* ws = a->ws;
    const bf16_t* U = (const bf16_t*)(ws + WS_U); float* SL = (float*)(ws + WS_SLOC);
    for (int unit = sg_l(blockIdx.x); unit < 256; unit += G) {
        const int g = unit >> 2, qtr = unit & 3;
        __syncthreads();
        { const u32x4* src = (const u32x4*)(ws + WS_TAB + (size_t)g * TAB_STRIDE + 16384); u32x4* dst = (u32x4*)smem;
          for (int e = tid; e < 4096; e += 512) dst[e] = src[e]; }
        __syncthreads();
#pragma unroll 1
        for (int nt = 0; nt < 2; ++nt) {
            const int chunk0 = qtr * 256 + wave * 32 + nt * 16, n = lane & 15;
            bf16x8 B[8];
#pragma unroll
            for (int ks = 0; ks < 8; ++ks) B[ks] = *(const bf16x8*)(U + (size_t)((chunk0 + n) * 16 + ks * 2 + (lane >> 5)) * DM + g * 16 + ((lane >> 4) & 1) * 8);
#pragma unroll
            for (int mt = 0; mt < 8; ++mt) {
                f32x4 acc = {0.f, 0.f, 0.f, 0.f};
#pragma unroll
                for (int ks = 0; ks < 8; ++ks) { const bf16x8 A = *(const bf16x8*)(smem + (mt * 8 + ks) * 1024 + lane * 16); acc = MFMA16(A, B[ks], acc); }
                *(f32x4*)(SL + ((size_t)(chunk0 + n) * 64 + g) * 128 + mt * 16 + (lane >> 4) * 4) = acc;
                asm volatile("" ::: "memory");
            }
        }
    }
}
__device__ __forceinline__ void ssm_s2(ArgsP a, int j, unsigned char* smem) {
    const int tid = tid_l(), G = sg_l(gridDim.x);
    unsigned char* ws = a->ws;
    const float* SL = (const float*)(ws + WS_SLOC); unsigned* SIN = (unsigned*)(ws + WS_SIN);
    float* ex = (float*)smem;
    for (int unit = sg_l(blockIdx.x); unit < 256; unit += G) {
        const int seg = tid >> 4, sl = tid & 15, st = unit * 16 + sl, g = st >> 6, p = st & 63;
        const float* ep = (const float*)(ws + WS_EP) + (size_t)(j * 64 + g) * EP_STRIDE;
        const float e16r = ep[(16 * 64 + p) * 2], e16i = ep[(16 * 64 + p) * 2 + 1], eSr = ep[(17 * 64 + p) * 2], eSi = ep[(17 * 64 + p) * 2 + 1];
        const float* src = SL + ((size_t)(seg * 32) * 64 + g) * 128 + 2 * p;
        f32x2 v[32];
#pragma unroll
        for (int i = 0; i < 32; ++i) v[i] = *(const f32x2*)(src + (size_t)i * 8192);
        float sr = 0.f, si = 0.f;
#pragma unroll
        for (int i = 0; i < 32; ++i) { const float nr = e16r * sr - e16i * si + v[i].x, ni = e16r * si + e16i * sr + v[i].y; sr = nr; si = ni; }
        __syncthreads();
        ex[(seg * 16 + sl) * 2] = sr; ex[(seg * 16 + sl) * 2 + 1] = si;
        __syncthreads();
        float cr = 0.f, ci = 0.f;
        for (int s = 0; s < seg; ++s) { const float xr = ex[(s * 16 + sl) * 2], xi = ex[(s * 16 + sl) * 2 + 1]; const float nr = eSr * cr - eSi * ci + xr, ni = eSr * ci + eSi * cr + xi; cr = nr; ci = ni; }
        unsigned* dst = SIN + ((size_t)(seg * 32) * 64 + g) * 64 + p;
#pragma unroll
        for (int i = 0; i < 32; ++i) {
            dst[(size_t)i * 4096] = pk2(cr, ci);
            const float nr = e16r * cr - e16i * ci + v[i].x, ni = e16r * ci + e16i * cr + v[i].y; cr = nr; ci = ni;
        }
    }
}
__device__ __forceinline__ void ssm_s3(ArgsP a, int j, unsigned char* smem) {
    const int tid = tid_l(), lane = tid & 63, wave = tid >> 6, G = sg_l(gridDim.x);
    unsigned char* ws = a->ws;
    const bf16_t* U = (const bf16_t*)(ws + WS_U); const bf16_t* SIN = (const bf16_t*)(ws + WS_SIN); bf16_t* YG = (bf16_t*)(ws + WS_YG);
    const float* dsk = a->in[10] + j * 1024;
    for (int unit = sg_l(blockIdx.x); unit < 256; unit += G) {
        const int g = unit >> 2, qtr = unit & 3;
        __syncthreads();
        { const u32x4* srcF = (const u32x4*)(ws + WS_TAB + (size_t)g * TAB_STRIDE); u32x4* dst = (u32x4*)smem;
          for (int e = tid; e < 1024; e += 512) dst[e] = srcF[e];
          const u32x4* srcC = (const u32x4*)(ws + WS_TAB + (size_t)g * TAB_STRIDE + 16384 + 65536);
          for (int e = tid; e < 4096; e += 512) dst[1024 + e] = srcC[e]; }
        __syncthreads();
        const unsigned char* Fl = smem; const unsigned char* Wl = smem + 16384;
        const int n = lane & 15, cq = (lane >> 4) * 4;
        const f32x4 dv = *(const f32x4*)(dsk + g * 16 + cq);
#pragma unroll 1
        for (int nt = 0; nt < 2; ++nt) {
            const int chunk = qtr * 256 + wave * 32 + nt * 16 + n;
            bf16x8 Bu[8], Bs[4];
#pragma unroll
            for (int ks = 0; ks < 8; ++ks) Bu[ks] = *(const bf16x8*)(U + (size_t)(chunk * 16 + ks * 2 + (lane >> 5)) * DM + g * 16 + ((lane >> 4) & 1) * 8);
#pragma unroll
            for (int kk = 0; kk < 4; ++kk) Bs[kk] = *(const bf16x8*)(SIN + ((size_t)chunk * 64 + g) * 128 + kk * 32 + (lane >> 4) * 8);
#pragma unroll
            for (int t = 0; t < 16; ++t) {
                f32x4 acc = {0.f, 0.f, 0.f, 0.f};
#pragma unroll
                for (int i = 0; i <= t / 2; ++i) { const bf16x8 A = *(const bf16x8*)(Fl + (t - 2 * i) * 1024 + lane * 16); acc = MFMA16(A, Bu[i], acc); }
#pragma unroll
                for (int kk = 0; kk < 4; ++kk) { const bf16x8 A = *(const bf16x8*)(Wl + (t * 4 + kk) * 1024 + lane * 16); acc = MFMA16(A, Bs[kk], acc); }
                const size_t off = (size_t)(chunk * 16 + t) * DM + g * 16 + cq;
                const u32x2 uv = *(const u32x2*)(U + off);
                const float y0 = gelu_tanh(acc[0] + dv[0] * bflo(uv.x)), y1 = gelu_tanh(acc[1] + dv[1] * bfhi(uv.x));
                const float y2 = gelu_tanh(acc[2] + dv[2] * bflo(uv.y)), y3 = gelu_tanh(acc[3] + dv[3] * bfhi(uv.y));
                u32x2 w; w.x = pk2(y0, y1); w.y = pk2(y2, y3);
                *(u32x2*)(YG + off) = w;
                asm volatile("" ::: "memory");
            }
        }
    }
}

constexpr int QK_STRIDE = 4096;
constexpr int KL_STRIDE = 272, VL_STRIDE = 528, VT_OFF = 256 * KL_STRIDE;

__device__ __forceinline__ void attn_a1(ArgsP a, int j, unsigned char* smem) {
    const int tid = tid_l(), G = sg_l(gridDim.x);
    unsigned char* ws = a->ws;
    bf16_t* QKVZ = (bf16_t*)(ws + WS_BIG); const float* rope = (const float*)(ws + WS_ROPE); float* kmean = (float*)(ws + WS_KMEAN);
    if (sg_l(blockIdx.x) == 0) ((unsigned*)(ws + WS_CTL))[tid] = 0u;
    const int seg = tid & 15, rg = tid >> 4;
    const float* qg = a->in[15] + j * 128 + seg * 8; const float* kg = a->in[16] + j * 128 + seg * 8;
    float gq[8], gk[8];
#pragma unroll
    for (int i = 0; i < 8; ++i) { gq[i] = qg[i]; gk[i] = kg[i]; }
    float* red = (float*)(smem + 72 * 1024);
    for (int unit = sg_l(blockIdx.x); unit < 512; unit += G) {
        const int h = unit & 7, b = unit >> 3;
        float ksum[8];
#pragma unroll
        for (int i = 0; i < 8; ++i) ksum[i] = 0.f;
        __syncthreads();
        for (int ps = 0; ps < 8; ++ps) {
            const int t = b * 256 + ps * 32 + rg;
            float cs[8], sn[8];
            if (seg < 4) {
#pragma unroll
                for (int i = 0; i < 8; ++i) { const f32x2 r = *(const f32x2*)(rope + ((size_t)t * 16 + (seg & 1) * 8 + i) * 2); cs[i] = r.x; sn[i] = r.y; }
            }
#pragma unroll
            for (int which = 0; which < 2; ++which) {
                bf16_t* p = QKVZ + (size_t)t * QK_STRIDE + which * 1024 + h * 128 + seg * 8;
                const u32x4 raw = *(const u32x4*)p;
                float x[8];
#pragma unroll
                for (int q = 0; q < 4; ++q) { x[2 * q] = bflo(raw[q]); x[2 * q + 1] = bfhi(raw[q]); }
                float ss = 0.f;
#pragma unroll
                for (int i = 0; i < 8; ++i) ss += x[i] * x[i];
                ss += __shfl_xor(ss, 1); ss += __shfl_xor(ss, 2); ss += __shfl_xor(ss, 4); ss += __shfl_xor(ss, 8);
                const float rstd = rsqrtf(ss * (1.f / 128.f) + NORM_EPS);
#pragma unroll
                for (int i = 0; i < 8; ++i) x[i] = x[i] * rstd * (which == 0 ? gq[i] : gk[i]);
                float y[8];
#pragma unroll
                for (int i = 0; i < 8; ++i) {
                    const float o = __shfl_xor(x[i], 2);
                    y[i] = x[i];
                    if (seg < 2) y[i] = x[i] * cs[i] - o * sn[i];
                    else if (seg < 4) y[i] = x[i] * cs[i] + o * sn[i];
                }
                u32x4 w; w.x = pk2(y[0], y[1]); w.y = pk2(y[2], y[3]); w.z = pk2(y[4], y[5]); w.w = pk2(y[6], y[7]);
                *(u32x4*)p = w;
                if (which == 1) {
#pragma unroll
                    for (int i = 0; i < 8; ++i) ksum[i] += y[i];
                }
            }
            { const int key = ps * 32 + rg; const u32x4 raw = *(const u32x4*)(QKVZ + (size_t)t * QK_STRIDE + 2048 + h * 128 + seg * 8);
              *(u32x4*)(smem + key * KL_STRIDE + seg * 16) = raw; }
        }
#pragma unroll
        for (int i = 0; i < 8; ++i) red[rg * 128 + seg * 8 + i] = ksum[i];
        __syncthreads();
        if (tid < 128) { float s = 0.f;
#pragma unroll
            for (int r = 0; r < 32; ++r) s += red[r * 128 + tid];
            kmean[((size_t)h * 64 + b) * 128 + tid] = s * (1.f / 256.f); }
        for (int e = tid; e < 4096; e += 512) {
            const int d = e & 127, ko = e >> 7, key0 = ko * 8;
            unsigned short v[8];
#pragma unroll
            for (int i = 0; i < 8; ++i) v[i] = *(const unsigned short*)(smem + (key0 + i) * KL_STRIDE + d * 2);
            u32x4 w; w.x = v[0] | ((unsigned)v[1] << 16); w.y = v[2] | ((unsigned)v[3] << 16); w.z = v[4] | ((unsigned)v[5] << 16); w.w = v[6] | ((unsigned)v[7] << 16);
            *(u32x4*)(QKVZ + (size_t)(b * 256 + 2 * d + (key0 >> 7)) * QK_STRIDE + 2048 + h * 128 + (key0 & 127)) = w;
        }
    }
}

__device__ __forceinline__ void attn_a2(ArgsP a, unsigned char* smem) {
    const int tid = tid_l(), G = sg_l(gridDim.x);
    unsigned char* ws = a->ws;
    const bf16_t* QKVZ = (const bf16_t*)(ws + WS_BIG); const float* kmean = (const float*)(ws + WS_KMEAN);
    unsigned* cnt = (unsigned*)(ws + WS_CTL); unsigned short* lists = (unsigned short*)(ws + WS_TAB);
    float* km = (float*)smem;
    const int sub = tid & 3, ql = tid >> 2;
    for (int u0 = sg_l(blockIdx.x), round = 0; u0 < 1024; u0 += G, ++round) {
        {
            const int unit = ((round & 1) && (round + 1) * G <= 1024) ? ((round + 1) * G - 1 - sg_l(blockIdx.x)) : u0;
            const int h = unit & 7, r = unit >> 3, t = r * 128 + ql, own = t >> 8;
            __syncthreads();
            { const f32x4* src = (const f32x4*)(kmean + (size_t)h * 64 * 128); f32x4* dst = (f32x4*)km;
              for (int e = tid; e < 2048; e += 512) dst[e] = src[e]; }
            __syncthreads();
            float q[32];
            { const u32x4* qp = (const u32x4*)(QKVZ + (size_t)t * QK_STRIDE + h * 128 + sub * 32);
#pragma unroll
              for (int v = 0; v < 4; ++v) { const u32x4 w = qp[v];
#pragma unroll
                  for (int c = 0; c < 4; ++c) { q[v * 8 + c * 2] = bflo(w[c]); q[v * 8 + c * 2 + 1] = bfhi(w[c]); } } }
            float v1 = -INFINITY, v2 = -INFINITY, v3 = -INFINITY; int i1 = -1, i2 = -1, i3 = -1;
            for (int n = 0; n < own; ++n) {
                const f32x4* kp = (const f32x4*)(km + n * 128 + sub * 32);
                float s = 0.f;
#pragma unroll
                for (int v = 0; v < 8; ++v) { const f32x4 kv = kp[v]; s += q[v * 4] * kv.x + q[v * 4 + 1] * kv.y + q[v * 4 + 2] * kv.z + q[v * 4 + 3] * kv.w; }
                s += __shfl_xor(s, 1); s += __shfl_xor(s, 2);
                if (s > v1) { v3 = v2; i3 = i2; v2 = v1; i2 = i1; v1 = s; i1 = n; }
                else if (s > v2) { v3 = v2; i3 = i2; v2 = s; i2 = n; }
                else if (s > v3) { v3 = s; i3 = n; }
            }
            if (sub == 0) {
                const int sel[3] = {i1, i2, i3};
#pragma unroll
                for (int jx = 0; jx < 3; ++jx) if (sel[jx] >= 0) {
                    const int n = sel[jx];
                    const unsigned pos = atomicAdd(&cnt[h * 64 + n], 1u);
                    lists[(size_t)h * LIST_PER_HEAD + list_off(n) + pos] = (unsigned short)(t | (jx << 14));
                }
            }
        }
    }
}

__device__ __forceinline__ void load_kv(const bf16_t* QKVZ, int h, int n, unsigned char* smem) {
    const int tid = tid_l();
    for (int e = tid; e < 4096; e += 512) {
        const int key = e >> 4, pc = e & 15;
        *(u32x4*)(smem + key * KL_STRIDE + pc * 16) = *(const u32x4*)(QKVZ + (size_t)(n * 256 + key) * QK_STRIDE + 1024 + h * 128 + pc * 8);
    }
    for (int e = tid; e < 4096; e += 512) {
        const int d = e >> 5, pc = e & 31, key0 = pc * 8;
        *(u32x4*)(smem + VT_OFF + d * VL_STRIDE + pc * 16) = *(const u32x4*)(QKVZ + (size_t)(n * 256 + 2 * d + (key0 >> 7)) * QK_STRIDE + 2048 + h * 128 + (key0 & 127));
    }
}
__device__ __forceinline__ void attn_core(const unsigned char* smem, const bf16x8 (&qf)[8], int nkt, int mask_kt, int qidx, float c1, float c2, f32x16 (&O)[4], float& lsum) {
    const int lane = tid_l() & 63, r = lane & 31, hh = lane >> 5;
    for (int kt = 0; kt < nkt; ++kt) {
        f32x16 S;
#pragma unroll
        for (int i = 0; i < 16; ++i) S[i] = 0.f;
#pragma unroll
        for (int kk = 0; kk < 8; ++kk) { const bf16x8 A = *(const bf16x8*)(smem + (kt * 32 + r) * KL_STRIDE + (kk * 16 + hh * 8) * 2); S = MFMA32(A, qf[kk], S); }
        float p[16];
#pragma unroll
        for (int i = 0; i < 16; ++i) { p[i] = exp2f(S[i] * c1 - c2);
            if (kt == mask_kt) { const int key = kt * 32 + (i & 3) + 8 * (i >> 2) + 4 * hh; if (key > qidx) p[i] = 0.f; }
            lsum += p[i]; }
#pragma unroll
        for (int s = 0; s < 2; ++s) {
            u32x4 pw; pw.x = pk2(p[8 * s], p[8 * s + 1]); pw.y = pk2(p[8 * s + 2], p[8 * s + 3]); pw.z = pk2(p[8 * s + 4], p[8 * s + 5]); pw.w = pk2(p[8 * s + 6], p[8 * s + 7]);
            const bf16x8 pb = __builtin_bit_cast(bf16x8, pw);
#pragma unroll
            for (int dt = 0; dt < 4; ++dt) {
                const unsigned char* vp = smem + VT_OFF + (dt * 32 + r) * VL_STRIDE + (kt * 32 + 16 * s + 4 * hh) * 2;
                const s16x4 lo = *(const s16x4*)vp, hi = *(const s16x4*)(vp + 16);
                const bf16x8 A = __builtin_shufflevector(lo, hi, 0, 1, 2, 3, 4, 5, 6, 7);
                O[dt] = MFMA32(A, pb, O[dt]);
            }
        }
    }
}
__device__ __forceinline__ float attn_ref(ArgsP a, int j) {
    const int lane = tid_l() & 63;
    float mq = fmaxf(fabsf(a->in[15][j * 128 + lane]), fabsf(a->in[15][j * 128 + 64 + lane]));
    float mk = fmaxf(fabsf(a->in[16][j * 128 + lane]), fabsf(a->in[16][j * 128 + 64 + lane]));
#pragma unroll
    for (int o = 1; o < 64; o <<= 1) { mq = fmaxf(mq, __shfl_xor(mq, o)); mk = fmaxf(mk, __shfl_xor(mk, o)); }
    return 11.313708499f * mq * mk;
}

__device__ __forceinline__ void attn_a3(ArgsP a, int j, unsigned char* smem) {
    const int tid = tid_l(), lane = tid & 63, wave = tid >> 6, G = sg_l(gridDim.x), r = lane & 31, hh = lane >> 5;
    unsigned char* ws = a->ws;
    const bf16_t* QKVZ = (const bf16_t*)(ws + WS_BIG);
    const unsigned* cnt = (const unsigned*)(ws + WS_CTL); const unsigned short* lists = (const unsigned short*)(ws + WS_TAB);
    float* lpart = (float*)(ws + WS_LPART);
    int* pre = (int*)(smem + 140 * 1024);
    const float ref = attn_ref(a, j), c1 = 0.08838834764831845f * 1.4426950408889634f, c2 = ref * 1.4426950408889634f;
    __syncthreads();
    { const int c = (int)cnt[tid]; pre[tid] = (c + 255) >> 8; }
    __syncthreads();
    for (int o = 1; o < 512; o <<= 1) { const int v = pre[tid] + (tid >= o ? pre[tid - o] : 0); __syncthreads(); pre[tid] = v; __syncthreads(); }
    const int total = pre[511]; const int bidx = sg_l(blockIdx.x);
    const int t_lo = (int)(((long)total * bidx) / G), t_hi = (int)(((long)total * (bidx + 1)) / G);
    int cur_pr = -1;
    for (int tile = t_lo; tile < t_hi; ++tile) {
        int lo = 0, hi = 511;
        while (lo < hi) { const int mid = (lo + hi) >> 1; if (pre[mid] > tile) hi = mid; else lo = mid + 1; }
        const int pr = lo, h = pr >> 6, n = pr & 63, tl = tile - (pr ? pre[pr - 1] : 0), c = (int)cnt[pr];
        if (pr != cur_pr) { __syncthreads(); load_kv(QKVZ, h, n, smem); __syncthreads(); cur_pr = pr; }
        const int li = tl * 256 + wave * 32 + r; const bool valid = li < c;
        const unsigned e = lists[(size_t)h * LIST_PER_HEAD + list_off(n) + (valid ? li : 0)];
        const int t = e & 0x3fff, slot = e >> 14;
        bf16x8 qf[8];
#pragma unroll
        for (int kk = 0; kk < 8; ++kk) qf[kk] = *(const bf16x8*)(QKVZ + (size_t)t * QK_STRIDE + h * 128 + kk * 16 + hh * 8);
        f32x16 O[4];
#pragma unroll
        for (int dt = 0; dt < 4; ++dt)
#pragma unroll
            for (int i = 0; i < 16; ++i) O[dt][i] = 0.f;
        float lsum = 0.f;
        attn_core(smem, qf, 8, -1, 0, c1, c2, O, lsum);
        lsum += __shfl_xor(lsum, 32);
        if (valid) {
            bf16_t* P = (bf16_t*)(ws + (slot == 0 ? WS_XN : (slot == 1 ? WS_P1 : WS_P2))) + (size_t)t * DM + h * 128;
#pragma unroll
            for (int dt = 0; dt < 4; ++dt)
#pragma unroll
                for (int q4 = 0; q4 < 4; ++q4) { u32x2 w; w.x = pk2(O[dt][4 * q4], O[dt][4 * q4 + 1]); w.y = pk2(O[dt][4 * q4 + 2], O[dt][4 * q4 + 3]);
                    *(u32x2*)(P + dt * 32 + 8 * q4 + 4 * hh) = w; }
            if (hh == 0) lpart[((size_t)slot * L + t) * 8 + h] = lsum;
        }
    }
}
__device__ __forceinline__ void attn_a4(ArgsP a, int j, unsigned char* smem) {
    const int tid = tid_l(), lane = tid & 63, wave = tid >> 6, G = sg_l(gridDim.x), r = lane & 31, hh = lane >> 5;
    unsigned char* ws = a->ws;
    const bf16_t* QKVZ = (const bf16_t*)(ws + WS_BIG); const float* lpart = (const float*)(ws + WS_LPART);
    const float ref = attn_ref(a, j), c1 = 0.08838834764831845f * 1.4426950408889634f, c2 = ref * 1.4426950408889634f;
    for (int unit = sg_l(blockIdx.x); unit < 512; unit += G) {
        const int h = unit & 7, b = unit >> 3;
        __syncthreads(); load_kv(QKVZ, h, b, smem); __syncthreads();
        const int qidx = wave * 32 + r, t = b * 256 + qidx;
        bf16x8 qf[8];
#pragma unroll
        for (int kk = 0; kk < 8; ++kk) qf[kk] = *(const bf16x8*)(QKVZ + (size_t)t * QK_STRIDE + h * 128 + kk * 16 + hh * 8);
        f32x16 O[4];
#pragma unroll
        for (int dt = 0; dt < 4; ++dt)
#pragma unroll
            for (int i = 0; i < 16; ++i) O[dt][i] = 0.f;
        float lsum = 0.f;
        attn_core(smem, qf, wave + 1, wave, qidx, c1, c2, O, lsum);
        lsum += __shfl_xor(lsum, 32);
        const int nsel = b < 3 ? b : 3;
        for (int s = 0; s < nsel; ++s) lsum += lpart[((size_t)s * L + t) * 8 + h];
        const float inv = 1.0f / lsum;
        bf16_t* ATT = (bf16_t*)(ws + WS_XN) + (size_t)t * DM + h * 128;
        const bf16_t* Zp = QKVZ + (size_t)t * QK_STRIDE + 3072 + h * 128;
#pragma unroll
        for (int dt = 0; dt < 4; ++dt)
#pragma unroll
            for (int q4 = 0; q4 < 4; ++q4) {
                const int d0 = dt * 32 + 8 * q4 + 4 * hh;
                float o0 = O[dt][4 * q4], o1 = O[dt][4 * q4 + 1], o2 = O[dt][4 * q4 + 2], o3 = O[dt][4 * q4 + 3];
                for (int s = 0; s < nsel; ++s) {
                    const u32x2 pv = *(const u32x2*)((const bf16_t*)(ws + (s == 0 ? WS_XN : (s == 1 ? WS_P1 : WS_P2))) + (size_t)t * DM + h * 128 + d0);
                    o0 += bflo(pv.x); o1 += bfhi(pv.x); o2 += bflo(pv.y); o3 += bfhi(pv.y);
                }
                const u32x2 zv = *(const u32x2*)(Zp + d0);
                const float z0 = bflo(zv.x), z1 = bfhi(zv.x), z2 = bflo(zv.y), z3 = bfhi(zv.y);
                u32x2 w; w.x = pk2(o0 * inv * z0 * sigmoidf_(z0), o1 * inv * z1 * sigmoidf_(z1)); w.y = pk2(o2 * inv * z2 * sigmoidf_(z2), o3 * inv * z3 * sigmoidf_(z3));
                *(u32x2*)(ATT + d0) = w;
            }
    }
}

#ifndef PH_MASK
#define PH_MASK 0xFFFF
#endif
#define PH(b) ((PH_MASK >> (b)) & 1)
__global__ void __launch_bounds__(512, 2) hybrid_fwd(Args a_unused) {
    extern __shared__ __attribute__((aligned(16))) unsigned char smem[];
    cg::grid_group grid = cg::this_grid();
    LAS unsigned char* lds = (LAS unsigned char*)smem;
    const ArgsP ap = (ArgsP)__builtin_amdgcn_kernarg_segment_ptr();

#define a launder(ap)
#define ws (launder(ap)->ws)
#define Wb ((bf16_t*)(ws + WS_W))
#define XN ((bf16_t*)(ws + WS_XN))
    if (PH(0)) pre0_phase(a);
    grid.sync();
    if (PH(0)) prep_phase(a, 0, a->in[0], smem);
    grid.sync();
#pragma unroll 1
    for (int layer = 0; layer < 4; ++layer) {
        const int j = layer >> 1;
        if ((layer & 1) == 0) {
            if (PH(1)) { pg8::Gemm g{XN, Wb, L, 2048, 1024}; pg8::StaticOrder S; S.init(L, 2048, sg_l(gridDim.x), sg_l(blockIdx.x));
              pg8::EpiStore E{(bf16_t*)(ws + WS_U), 1024, 1024, (size_t)(WS_Z - WS_U) / 2};
              pg8::gemm_phase<pg8::EpiStore, pg8::StaticOrder, true, true>(lds, g, S, E); }
            grid.sync();
            if (PH(2)) ssm_s1(a, smem);
            grid.sync();
            if (PH(3)) ssm_s2(a, j, smem);
            grid.sync();
            if (PH(4)) ssm_s3(a, j, smem);
            grid.sync();
            if (PH(5)) { pg8::Gemm g{(const bf16_t*)(ws + WS_YG), Wb + 2048 * 1024, L, 1024, 1024}; pg8::StaticOrder S; S.init(L, 1024, sg_l(gridDim.x), sg_l(blockIdx.x));
              pg8::EpiGlu E{(const bf16_t*)(ws + WS_YG), (const bf16_t*)(ws + WS_Z), a->in[12] + j * 1024, (bf16_t*)(ws + WS_Y2)};
              pg8::gemm_phase<pg8::EpiGlu, pg8::StaticOrder, true, true>(lds, g, S, E); }
            grid.sync();
            if (PH(6)) { pg8::Gemm g{(const bf16_t*)(ws + WS_Y2), Wb + 3072 * 1024, L, 1024, 1024}; pg8::StaticOrder S; S.init(L, 1024, sg_l(gridDim.x), sg_l(blockIdx.x));
              pg8::EpiRes E{layer == 0 ? a->in[0] : (const float*)a->out, a->out};
              pg8::gemm_phase<pg8::EpiRes, pg8::StaticOrder, true, true>(lds, g, S, E); }
            grid.sync();
        } else {
            if (PH(7)) { pg8::Gemm g{XN, Wb, L, 4096, 1024}; pg8::StaticOrder S; S.init(L, 4096, sg_l(gridDim.x), sg_l(blockIdx.x));
              pg8::EpiStore E{(bf16_t*)(ws + WS_BIG), 4096, 0, 0};
              pg8::gemm_phase<pg8::EpiStore, pg8::StaticOrder, true, true>(lds, g, S, E); }
            grid.sync();
            if (PH(8)) attn_a1(a, j, smem);
            grid.sync();
            if (PH(9)) attn_a2(a, smem);
            grid.sync();
            if (PH(10)) attn_a3(a, j, smem);
            grid.sync();
            if (PH(11)) attn_a4(a, j, smem);
            grid.sync();
            if (PH(12)) { pg8::Gemm g{XN, Wb + 4096 * 1024, L, 1024, 1024}; pg8::StaticOrder S; S.init(L, 1024, sg_l(gridDim.x), sg_l(blockIdx.x));
              pg8::EpiRes E{layer == 0 ? a->in[0] : (const float*)a->out, a->out};
              pg8::gemm_phase<pg8::EpiRes, pg8::StaticOrder, true, true>(lds, g, S, E); }
            grid.sync();
        }
        if (layer < 3) { if (PH(13)) prep_phase(a, layer + 1, a->out, smem); grid.sync(); }
    }
}

#undef a
#undef ws
#undef Wb
#undef XN
extern "C" void kernel_launch(void* const* d_in, const int* in_sizes, int n_in, void* d_out, int out_size, void* d_ws, size_t ws_size, hipStream_t stream) {
    static int grid = 0;
    if (grid == 0) {
        if (n_in != 18 || out_size != L * DM || ws_size < WS_END) { fprintf(stderr, "kernel_launch: unexpected shapes (n_in %d, out %d, ws %zu)\n", n_in, out_size, ws_size); grid = -1; return; }
        int dev = 0, cus = 0, per_cu = 0;
        hipGetDevice(&dev); hipDeviceGetAttribute(&cus, hipDeviceAttributeMultiprocessorCount, dev);
        hipFuncSetAttribute((const void*)hybrid_fwd, hipFuncAttributeMaxDynamicSharedMemorySize, LDS_BYTES);
        hipOccupancyMaxActiveBlocksPerMultiprocessor(&per_cu, (const void*)hybrid_fwd, 512, LDS_BYTES);
        if (per_cu < 1) { fprintf(stderr, "kernel_launch: occupancy query says %d blocks per CU\n", per_cu); per_cu = 1; }
        grid = cus * 1;
        if (grid > 256) grid = 256;
    }
    if (grid < 0) return;
    Args a{};
    for (int i = 0; i < 18; ++i) a.in[i] = (const float*)d_in[i];
    a.out = (float*)d_out; a.ws = (unsigned char*)d_ws;
    void* args[] = {&a};
    hipError_t e = hipLaunchCooperativeKernel((const void*)hybrid_fwd, dim3(grid), dim3(512), args, LDS_BYTES, stream);
    if (e != hipSuccess) fprintf(stderr, "cooperative launch failed: %s (grid %d)\n", hipGetErrorString(e), grid);
}
```

```cpp
#include <hip/hip_runtime.h>
#include <hip/hip_cooperative_groups.h>
#include <cstdio>
#include <cstdint>
namespace cg = cooperative_groups;

#define LAS __attribute__((address_space(3)))
typedef unsigned short bf16_t;
typedef short bf16x8 __attribute__((ext_vector_type(8)));
typedef short s16x4 __attribute__((ext_vector_type(4)));
typedef float f32x2 __attribute__((ext_vector_type(2)));
typedef float f32x4 __attribute__((ext_vector_type(4)));
typedef float f32x16 __attribute__((ext_vector_type(16)));
typedef unsigned u32x2 __attribute__((ext_vector_type(2)));
typedef unsigned u32x4 __attribute__((ext_vector_type(4)));
typedef __bf16 bf16v2 __attribute__((ext_vector_type(2)));

__device__ __forceinline__ unsigned pk2(float lo, float hi) { f32x2 v = {lo, hi}; bf16v2 b = __builtin_convertvector(v, bf16v2); return __builtin_bit_cast(unsigned, b); }
__device__ __forceinline__ float bflo(unsigned w) { return __uint_as_float(w << 16); }
__device__ __forceinline__ float bfhi(unsigned w) { return __uint_as_float(w & 0xffff0000u); }
__device__ __forceinline__ float sigmoidf_(float x) { return 1.0f / (1.0f + __expf(-x)); }
__device__ __forceinline__ float gelu_tanh(float y) { const float t = 0.7978845608028654f * (y + 0.044715f * y * y * y); const float e = __expf(2.0f * t); const float th = 1.0f - 2.0f / (e + 1.0f); return 0.5f * y * (1.0f + th); }

__device__ __forceinline__ int tid_l() { int t = threadIdx.x; asm volatile("" : "+v"(t)); return t; }
__device__ __forceinline__ int sg_l(int v) { v = __builtin_amdgcn_readfirstlane(v); asm volatile("" : "+s"(v)); return v; }
constexpr int L = 16384, DM = 1024, NH = 8, HD = 128, NBLK = 64;
constexpr size_t MiB = 1u << 20;
constexpr size_t WS_CTL = 0, WS_BAR = 16 * 1024, WS_KMEAN = 256 * 1024;
constexpr int LDS_BARST = 146432;
constexpr size_t WS_W = 1 * MiB, WS_TAB = 11 * MiB, WS_XN = 21 * MiB, WS_BIG = 53 * MiB;
constexpr size_t WS_U = WS_BIG, WS_Z = WS_BIG + 32 * MiB, WS_YG = WS_BIG + 64 * MiB, WS_Y2 = WS_BIG + 96 * MiB;
constexpr size_t WS_P1 = 181 * MiB, WS_P2 = 213 * MiB, WS_SLOC = 181 * MiB, WS_SIN = 213 * MiB;
constexpr size_t WS_LPART = 245 * MiB, WS_ROPE = 247 * MiB, WS_EP = 249 * MiB, WS_END = 251 * MiB;
constexpr int EP_STRIDE = 19 * 64 * 2;
constexpr int TAB_STRIDE = 147456;
constexpr int LIST_PER_HEAD = 516096;
__host__ __device__ __forceinline__ int list_off(int n) { return 16128 * n - 128 * n * (n - 1); }
constexpr int LDS_BYTES = 147456;
constexpr float NORM_EPS = 1e-6f;

namespace pg8 {
constexpr int BM = 256, BK = 64, HALF = 128, HTB = HALF * BK * 2, STAGE_BYTES = 8 * HTB, NXCD = 8, WGM = 8;
__host__ __device__ __forceinline__ int lds_byte(int r, int c) { const int st = (r >> 4) * 2 + (c >> 5), rr = r & 15, cc = c & 31, ob = rr * 64 + cc * 2; return st * 1024 + (ob ^ (((ob >> 9) & 1) << 5)); }
__host__ __device__ __forceinline__ void stage_rc(int b, int& R, int& C) { const int st = b / 1024, sb = b % 1024, swz = sb ^ (((sb >> 9) & 1) << 5); R = (st >> 1) * 16 + swz / 64; C = (st & 1) * 32 + (swz % 64) / 2; }
__host__ __device__ __forceinline__ int perm32(int rho) { const int n = rho >> 4, i = rho & 15; return 8 * (i >> 2) + 4 * n + (i & 3); }
struct Unit { int pm, pn; };
struct Gemm { const bf16_t* A; const bf16_t* Bt; int M, N, K; };
struct StaticOrder {
    int nM, nN, nwg, G, c;
    __host__ __device__ void init(int M, int N, int G_, int c_) { nM = M / BM; nN = N / BM; nwg = nM * nN; G = G_; c = c_; }
    __host__ __device__ bool next(int i, Unit& u) const {
        const long Lx = (long)i * G + c; if (Lx >= nwg) return false;
        int wgid = (int)Lx; { const int q = nwg / NXCD, r = nwg % NXCD, xcd = wgid % NXCD, off = wgid / NXCD; wgid = (xcd < r ? xcd * (q + 1) : r * (q + 1) + (xcd - r) * q) + off; }
        const int nig = WGM * nN, gid = wgid / nig, fm = gid * WGM, gsz = (nM - fm) < WGM ? (nM - fm) : WGM;
        u.pm = fm + ((wgid % nig) % gsz); u.pn = (wgid % nig) / gsz; return true;
    }
    __device__ __forceinline__ void a_ready(const Unit&) const {}
    __device__ __forceinline__ void done(const Unit&) const {}
};

struct EpiStore {
    static constexpr bool PERM = true, AFTER_DRAIN = false;
    bf16_t* O; int ldc; int split_cols; size_t split_stride;
    __device__ __forceinline__ void operator()(const f32x4 (&acc)[2][2][4][2], const Unit& u, int wr, int wc, int fr, int fq) const {
        const int row0 = u.pm * BM + wr * 64 + fr; int colt = u.pn * BM; bf16_t* base = O;
        if (split_cols) { const int t = colt / split_cols; base += (size_t)t * split_stride; colt -= t * split_cols; }
        const int col0 = colt + wc * 32 + 8 * fq;
#pragma unroll
        for (int ai = 0; ai < 2; ++ai)
#pragma unroll
            for (int m = 0; m < 4; ++m) { bf16_t* rowp = base + (size_t)(row0 + ai * HALF + m * 16) * ldc + col0;
#pragma unroll
                for (int bj = 0; bj < 2; ++bj) { const f32x4 v0 = acc[ai][bj][m][0], v1 = acc[ai][bj][m][1];
                    u32x4 w; w.x = pk2(v0[0], v0[1]); w.y = pk2(v0[2], v0[3]); w.z = pk2(v1[0], v1[1]); w.w = pk2(v1[2], v1[3]);
                    *(u32x4*)(rowp + bj * HALF) = w; } }
    }
};
struct EpiGlu {
    static constexpr bool PERM = true, AFTER_DRAIN = false;
    const bf16_t* YG; const bf16_t* Z; const float* bias; bf16_t* O;
    __device__ __forceinline__ void operator()(const f32x4 (&acc)[2][2][4][2], const Unit& u, int wr, int wc, int fr, int fq) const {
        const int row0 = u.pm * BM + wr * 64 + fr; const int col0 = u.pn * BM + wc * 32 + 8 * fq;
#pragma unroll
        for (int bj = 0; bj < 2; ++bj) {
            const f32x4 b0 = *(const f32x4*)(bias + col0 + bj * HALF), b1 = *(const f32x4*)(bias + col0 + bj * HALF + 4);
#pragma unroll
            for (int ai = 0; ai < 2; ++ai)
#pragma unroll
                for (int m = 0; m < 4; ++m) {
                    const size_t off = (size_t)(row0 + ai * HALF + m * 16) * DM + col0 + bj * HALF;
                    const u32x4 yv = *(const u32x4*)(YG + off), zv = *(const u32x4*)(Z + off);
                    const f32x4 v0 = acc[ai][bj][m][0] + b0, v1 = acc[ai][bj][m][1] + b1;
                    float r[8];
#pragma unroll
                    for (int q = 0; q < 4; ++q) {
                        const float a0 = q < 2 ? v0[2 * q] : v1[2 * q - 4], a1 = q < 2 ? v0[2 * q + 1] : v1[2 * q - 3];
                        const float y0 = bflo(yv[q]), y1 = bfhi(yv[q]), z0 = bflo(zv[q]), z1 = bfhi(zv[q]);
                        r[2 * q] = y0 * sigmoidf_(a0) * (z0 * sigmoidf_(z0)); r[2 * q + 1] = y1 * sigmoidf_(a1) * (z1 * sigmoidf_(z1));
                    }
                    u32x4 w; w.x = pk2(r[0], r[1]); w.y = pk2(r[2], r[3]); w.z = pk2(r[4], r[5]); w.w = pk2(r[6], r[7]);
                    *(u32x4*)(O + off) = w;
                }
        }
    }
};
struct EpiRes {
    static constexpr bool PERM = true, AFTER_DRAIN = false;
    const float* base; float* out;
    __device__ __forceinline__ void operator()(const f32x4 (&acc)[2][2][4][2], const Unit& u, int wr, int wc, int fr, int fq) const {
        const int row0 = u.pm * BM + wr * 64 + fr; const int col0 = u.pn * BM + wc * 32 + 8 * fq;
#pragma unroll
        for (int ai = 0; ai < 2; ++ai)
#pragma unroll
            for (int m = 0; m < 4; ++m)
#pragma unroll
                for (int bj = 0; bj < 2; ++bj) {
                    const size_t off = (size_t)(row0 + ai * HALF + m * 16) * DM + col0 + bj * HALF;
                    const f32x4 a0 = *(const f32x4*)(base + off), a1 = *(const f32x4*)(base + off + 4);
                    *(f32x4*)(out + off) = a0 + acc[ai][bj][m][0]; *(f32x4*)(out + off + 4) = a1 + acc[ai][bj][m][1];
                }
    }
};

template <class Epi, class Sched, bool ALIGN_EPI = false, bool SP2 = false>
__device__ __forceinline__ void gemm_phase(LAS unsigned char* lds, const Gemm g, const Sched& S, const Epi& E) {
    const int tid = tid_l(), wid = __builtin_amdgcn_readfirstlane(tid >> 6), lane = tid & 63, wr = wid >> 2, wc = wid & 3, fr = lane & 15, fq = lane >> 4;
    const int K = g.K, nt = K / BK;
    unsigned voffA[2], voffB[2];
#pragma unroll
    for (int i = 0; i < 2; ++i) { int R, C; stage_rc(tid * 16 + i * 8192, R, C); const int Rb = Epi::PERM ? ((R & ~31) + perm32(R & 31)) : R;
        voffA[i] = (unsigned)(R * K + C) * 2u; voffB[i] = (unsigned)(Rb * K + C) * 2u; }
    const size_t kstep = (size_t)(BK * 2);
    const size_t hstep = (size_t)HALF * K * 2;
    const size_t tstep = 2 * hstep;
    const unsigned ldsw = (unsigned)wid * 1024u;
    const int aoff = lds_byte(wr * 64 + fr, fq * 8), boff = lds_byte(wc * 32 + fr, fq * 8);
#define PG8_SA(b, h) (((b) * 2 + (h)) * HTB)
#define PG8_SB(b, h) ((4 + (b) * 2 + (h)) * HTB)
#define PG8_STAGE(bufoff, gbase, voff) do { _Pragma("unroll") for (int _i = 0; _i < 2; ++_i) \
        __builtin_amdgcn_global_load_lds((const unsigned*)((const char*)(gbase) + (voff)[_i]), (LAS unsigned*)(lds + (bufoff) + ldsw + _i * 8192), 16, 0, 0); } while (0)
#define PG8_LDA(dst, b, h) do { _Pragma("unroll") for (int m = 0; m < 4; ++m) _Pragma("unroll") for (int k = 0; k < 2; ++k) dst[m][k] = *(const LAS bf16x8*)(lds + PG8_SA(b, h) + aoff + m * 2048 + k * 1024); } while (0)
#define PG8_LDB(dst, b, h) do { _Pragma("unroll") for (int n = 0; n < 2; ++n) _Pragma("unroll") for (int k = 0; k < 2; ++k) dst[n][k] = *(const LAS bf16x8*)(lds + PG8_SB(b, h) + boff + n * 2048 + k * 1024); } while (0)
#define PG8_MMA(ai, bj, At, Bt) do { __builtin_amdgcn_s_setprio(1); _Pragma("unroll") for (int m = 0; m < 4; ++m) _Pragma("unroll") for (int n = 0; n < 2; ++n) _Pragma("unroll") for (int k = 0; k < 2; ++k) \
        acc[ai][bj][m][n] = __builtin_amdgcn_mfma_f32_16x16x32_bf16(Bt[n][k], At[m][k], acc[ai][bj][m][n], 0, 0, 0); __builtin_amdgcn_s_setprio(0); } while (0)
#define PG8_WAIT_V(n) asm volatile("s_waitcnt vmcnt(" #n ")" ::: "memory")
#define PG8_WAIT_L(n) asm volatile("s_waitcnt lgkmcnt(" #n ")" ::: "memory")
#define PG8_BAR __builtin_amdgcn_s_barrier()
#define PG8_SCHED __builtin_amdgcn_sched_barrier(0)
    Unit cur, nxt; int ui = 0;
    if (!S.next(0, cur)) return;
    f32x4 acc[2][2][4][2];
#pragma unroll
    for (int a = 0; a < 2; ++a)
#pragma unroll
        for (int b = 0; b < 2; ++b)
#pragma unroll
            for (int m = 0; m < 4; ++m)
#pragma unroll
                for (int n = 0; n < 2; ++n) acc[a][b][m][n] = (f32x4){0.f, 0.f, 0.f, 0.f};
    bf16x8 At[4][2], B0[2][2], B1[2][2];
    const char* cA = (const char*)g.A + (size_t)cur.pm * tstep; const char* cB = (const char*)g.Bt + (size_t)cur.pn * tstep;
    S.a_ready(cur);
    if constexpr (SP2) {
        PG8_STAGE(PG8_SB(0, 0), cB, voffB); PG8_STAGE(PG8_SB(0, 1), cB + hstep, voffB); PG8_STAGE(PG8_SA(0, 0), cA, voffA); PG8_STAGE(PG8_SA(0, 1), cA + hstep, voffA);
        if (wr == 1) PG8_BAR;
        PG8_WAIT_V(2); PG8_BAR;
        PG8_STAGE(PG8_SB(1, 0), cB + kstep, voffB); PG8_STAGE(PG8_SA(1, 0), cA + kstep, voffA); PG8_STAGE(PG8_SB(1, 1), cB + hstep + kstep, voffB);
        PG8_WAIT_V(6); PG8_BAR;
    } else {
        PG8_STAGE(PG8_SB(0, 0), cB, voffB); PG8_STAGE(PG8_SA(0, 0), cA, voffA); PG8_STAGE(PG8_SB(0, 1), cB + hstep, voffB); PG8_STAGE(PG8_SA(0, 1), cA + hstep, voffA);
        if (wr == 1) PG8_BAR;
        PG8_WAIT_V(4); PG8_BAR;
        PG8_STAGE(PG8_SB(1, 0), cB + kstep, voffB); PG8_STAGE(PG8_SA(1, 0), cA + kstep, voffA); PG8_STAGE(PG8_SB(1, 1), cB + hstep + kstep, voffB);
        PG8_WAIT_V(6); PG8_BAR;
    }
    for (;;) {
        const bool has_next = S.next(ui + 1, nxt);
        const char* nA = has_next ? (const char*)g.A + (size_t)nxt.pm * tstep : cA; const char* nB = has_next ? (const char*)g.Bt + (size_t)nxt.pn * tstep : cB;
        for (int t = 0; t < nt; t += 2) {
            const bool last = (t == nt - 2);
            const char* a1 = cA + (size_t)(t + 1) * kstep;
            const char* a2 = last ? nA : cA + (size_t)(t + 2) * kstep; const char* b2 = last ? nB : cB + (size_t)(t + 2) * kstep;
            const char* a3 = a2 + kstep; const char* b3 = b2 + kstep;
            if (last && has_next) S.a_ready(nxt);
            if constexpr (SP2) {
            PG8_LDB(B0, 0, 0); PG8_LDB(B1, 0, 1); PG8_SCHED; PG8_LDA(At, 0, 0); PG8_STAGE(PG8_SA(1, 1), a1 + hstep, voffA);
            PG8_WAIT_V(8); PG8_WAIT_L(0); PG8_BAR; PG8_MMA(0, 0, At, B0); PG8_MMA(0, 1, At, B1); PG8_BAR; PG8_SCHED;
            PG8_LDA(At, 0, 1); PG8_STAGE(PG8_SB(0, 0), b2, voffB); PG8_STAGE(PG8_SB(0, 1), b2 + hstep, voffB); PG8_STAGE(PG8_SA(0, 0), a2, voffA);
            PG8_WAIT_V(8); PG8_WAIT_L(0); PG8_BAR; PG8_MMA(1, 0, At, B0); PG8_MMA(1, 1, At, B1); PG8_BAR; PG8_SCHED;
            PG8_LDB(B0, 1, 0); PG8_LDB(B1, 1, 1); PG8_SCHED; PG8_LDA(At, 1, 0); PG8_STAGE(PG8_SA(0, 1), a2 + hstep, voffA);
            PG8_WAIT_V(8); PG8_WAIT_L(0); PG8_BAR; PG8_MMA(0, 0, At, B0); PG8_MMA(0, 1, At, B1); PG8_BAR; PG8_SCHED;
            PG8_LDA(At, 1, 1); PG8_STAGE(PG8_SB(1, 0), b3, voffB); PG8_STAGE(PG8_SB(1, 1), b3 + hstep, voffB); PG8_STAGE(PG8_SA(1, 0), a3, voffA);
            PG8_WAIT_V(8); PG8_WAIT_L(0); PG8_BAR; PG8_MMA(1, 0, At, B0); PG8_MMA(1, 1, At, B1); PG8_BAR; PG8_SCHED;
            } else {
            PG8_LDB(B0, 0, 0); PG8_SCHED; PG8_LDA(At, 0, 0); PG8_STAGE(PG8_SA(1, 1), a1 + hstep, voffA);
            PG8_WAIT_L(8); PG8_BAR; PG8_WAIT_L(0); PG8_MMA(0, 0, At, B0); PG8_BAR; PG8_SCHED;
            PG8_LDB(B1, 0, 1); PG8_STAGE(PG8_SB(0, 0), b2, voffB);
            PG8_BAR; PG8_WAIT_L(0); PG8_MMA(0, 1, At, B1); PG8_BAR;
            PG8_LDA(At, 0, 1); PG8_STAGE(PG8_SA(0, 0), a2, voffA);
            PG8_BAR; PG8_WAIT_L(0); PG8_MMA(1, 0, At, B0); PG8_BAR; PG8_SCHED;
            PG8_STAGE(PG8_SB(0, 1), b2 + hstep, voffB);
            PG8_WAIT_V(6); PG8_BAR; PG8_MMA(1, 1, At, B1); PG8_BAR;
            PG8_LDB(B0, 1, 0); PG8_SCHED; PG8_LDA(At, 1, 0); PG8_STAGE(PG8_SA(0, 1), a2 + hstep, voffA);
            PG8_WAIT_L(8); PG8_BAR; PG8_WAIT_L(0); PG8_MMA(0, 0, At, B0); PG8_BAR; PG8_SCHED;
            PG8_LDB(B1, 1, 1); PG8_STAGE(PG8_SB(1, 0), b3, voffB);
            PG8_BAR; PG8_WAIT_L(0); PG8_MMA(0, 1, At, B1); PG8_BAR;
            PG8_LDA(At, 1, 1); PG8_STAGE(PG8_SA(1, 0), a3, voffA);
            PG8_BAR; PG8_WAIT_L(0); PG8_MMA(1, 0, At, B0); PG8_BAR; PG8_SCHED;
            PG8_STAGE(PG8_SB(1, 1), b3 + hstep, voffB);
            PG8_WAIT_V(6); PG8_BAR; PG8_MMA(1, 1, At, B1); PG8_BAR;
            }
        }
        if constexpr (ALIGN_EPI) { if (wr == 0) PG8_BAR; }
        if constexpr (!Epi::AFTER_DRAIN) { E(acc, cur, wr, wc, fr, fq); S.done(cur); }
        if (!has_next) break;
#pragma unroll
        for (int a = 0; a < 2; ++a)
#pragma unroll
            for (int b = 0; b < 2; ++b)
#pragma unroll
                for (int m = 0; m < 4; ++m)
#pragma unroll
                    for (int n = 0; n < 2; ++n) acc[a][b][m][n] = (f32x4){0.f, 0.f, 0.f, 0.f};
        cur = nxt; cA = nA; cB = nB; ++ui;
        if constexpr (ALIGN_EPI) { if (wr == 1) PG8_BAR; }
    }
    PG8_WAIT_V(0);
    if constexpr (!ALIGN_EPI) { if (wr == 0) PG8_BAR; }
    PG8_BAR;
#undef PG8_SA
#undef PG8_SB
#undef PG8_STAGE
#undef PG8_LDA
#undef PG8_LDB
#undef PG8_MMA
#undef PG8_WAIT_V
#undef PG8_WAIT_L
#undef PG8_BAR
#undef PG8_SCHED
}
}

struct Args { const float* in[18]; float* out; unsigned char* ws; };
typedef const __attribute__((address_space(4))) Args* ArgsP;
__device__ __forceinline__ ArgsP launder(ArgsP p) { asm volatile("" : "+s"(p)); return p; }

#define MFMA16(a, b, c) __builtin_amdgcn_mfma_f32_16x16x32_bf16((a), (b), (c), 0, 0, 0)
#define MFMA32(a, b, c) __builtin_amdgcn_mfma_f32_32x32x16_bf16((a), (b), (c), 0, 0, 0)

__device__ __forceinline__ float wave_sum(float v) {
#pragma unroll
    for (int o = 1; o < 64; o <<= 1) v += __shfl_xor(v, o);
    return v;
}

__device__ __forceinline__ void transpose_item(const float* W, int K, int N, bf16_t* WT, float* scr, int item, int lane) {
    const int nblk = N / 32, kb = item / nblk, nb = item % nblk, k0 = 64 * kb, n0 = 32 * nb;
#pragma unroll 8
    for (int i = 0; i < 32; ++i) { const int kk = 2 * i + (lane >> 5); scr[kk * 33 + (lane & 31)] = W[(size_t)(k0 + kk) * N + n0 + (lane & 31)]; }
    __builtin_amdgcn_wave_barrier(); asm volatile("s_waitcnt lgkmcnt(0)" ::: "memory");
    const int c = lane & 7;
#pragma unroll
    for (int j = 0; j < 4; ++j) { const int n = (lane >> 3) + 8 * j; const float* s = scr + (8 * c) * 33 + n;
        u32x4 o; o.x = pk2(s[0 * 33], s[1 * 33]); o.y = pk2(s[2 * 33], s[3 * 33]); o.z = pk2(s[4 * 33], s[5 * 33]); o.w = pk2(s[6 * 33], s[7 * 33]);
        *(u32x4*)(WT + (size_t)(n0 + n) * K + k0 + 8 * c) = o; }
    asm volatile("s_waitcnt lgkmcnt(0)" ::: "memory"); __builtin_amdgcn_wave_barrier();
}

__device__ __forceinline__ void ssm_tables(ArgsP a, int j, int g, unsigned char* smem, unsigned char* tab) {
    float* Epow = (float*)smem;
    float* Bb = Epow + 17 * 64 * 2;
    float* Cc = Bb + 64 * 16 * 2;
    float* Fp = Cc + 16 * 64 * 2;
    float* Km = Fp + 128;
    const int tid = tid_l();
    const float* a_re = a->in[3] + (size_t)(j * 64 + g) * 64; const float* a_im = a->in[4] + (size_t)(j * 64 + g) * 64;
    const float* b_re = a->in[6] + (size_t)(j * 64 + g) * 64 * 16; const float* b_im = a->in[7] + (size_t)(j * 64 + g) * 64 * 16;
    const float* c_re = a->in[8] + (size_t)(j * 64 + g) * 16 * 64; const float* c_im = a->in[9] + (size_t)(j * 64 + g) * 16 * 64;
    { const float* ep = (const float*)(a->ws + WS_EP) + (size_t)(j * 64 + g) * EP_STRIDE;
      for (int e = tid; e < 17 * 64 * 2; e += 512) Epow[e] = ep[e];
      if (tid < 128) Fp[tid] = ep[18 * 128 + tid]; }
    __syncthreads();
    for (int e = tid; e < 1024; e += 512) {
        { const int p = e >> 4; const float fr_ = Fp[p * 2], fi_ = Fp[p * 2 + 1], br = b_re[e], bi = b_im[e];
          Bb[e * 2] = fr_ * br - fi_ * bi; Bb[e * 2 + 1] = fr_ * bi + fi_ * br; }
        Cc[e * 2] = c_re[e]; Cc[e * 2 + 1] = c_im[e];
    }
    __syncthreads();
    for (int e = tid; e < 4096; e += 512) {
        const int d = e >> 8, c = (e >> 4) & 15, c2 = e & 15; float acc = 0.f;
        for (int p = 0; p < 64; ++p) {
            const float ar = Epow[(d * 64 + p) * 2], ai = Epow[(d * 64 + p) * 2 + 1], br = Bb[(p * 16 + c2) * 2], bi = Bb[(p * 16 + c2) * 2 + 1];
            const float gr = ar * br - ai * bi, gi = ar * bi + ai * br;
            acc += Cc[(c * 64 + p) * 2] * gr - Cc[(c * 64 + p) * 2 + 1] * gi;
        }
        Km[e] = acc;
    }
    __syncthreads();
    for (int e = tid; e < 16 * 64; e += 512) {
        const int d = e >> 6, l = e & 63, c = l & 15, ts = l >> 5, c0 = ((l >> 4) & 1) * 8, dd = d - ts; float v[8];
#pragma unroll
        for (int jj = 0; jj < 8; ++jj) v[jj] = dd >= 0 ? Km[(dd * 16 + c) * 16 + c0 + jj] : 0.f;
        u32x4 w; w.x = pk2(v[0], v[1]); w.y = pk2(v[2], v[3]); w.z = pk2(v[4], v[5]); w.w = pk2(v[6], v[7]);
        *(u32x4*)(tab + d * 1024 + l * 16) = w;
    }
    for (int e = tid; e < 64 * 64; e += 512) {
        const int f = e >> 6, l = e & 63, mt = f >> 3, ks = f & 7, m = mt * 16 + (l & 15), p = m >> 1, ri = m & 1, tau = ks * 2 + (l >> 5), c0 = ((l >> 4) & 1) * 8;
        const float ar = Epow[((15 - tau) * 64 + p) * 2], ai = Epow[((15 - tau) * 64 + p) * 2 + 1]; float v[8];
#pragma unroll
        for (int jj = 0; jj < 8; ++jj) { const float br = Bb[(p * 16 + c0 + jj) * 2], bi = Bb[(p * 16 + c0 + jj) * 2 + 1]; v[jj] = ri == 0 ? (ar * br - ai * bi) : (ar * bi + ai * br); }
        u32x4 w; w.x = pk2(v[0], v[1]); w.y = pk2(v[2], v[3]); w.z = pk2(v[4], v[5]); w.w = pk2(v[6], v[7]);
        *(u32x4*)(tab + 16384 + f * 1024 + l * 16) = w;
    }
    for (int e = tid; e < 64 * 64; e += 512) {
        const int f = e >> 6, l = e & 63, t = f >> 2, kk = f & 3, c = l & 15, m0 = kk * 32 + (l >> 4) * 8; float v[8];
#pragma unroll
        for (int jj = 0; jj < 8; ++jj) { const int m = m0 + jj, p = m >> 1, ri = m & 1;
            const float ar = Epow[((t + 1) * 64 + p) * 2], ai = Epow[((t + 1) * 64 + p) * 2 + 1], cr = Cc[(c * 64 + p) * 2], ci = Cc[(c * 64 + p) * 2 + 1];
            v[jj] = ri == 0 ? (cr * ar - ci * ai) : -(cr * ai + ci * ar); }
        u32x4 w; w.x = pk2(v[0], v[1]); w.y = pk2(v[2], v[3]); w.z = pk2(v[4], v[5]); w.w = pk2(v[6], v[7]);
        *(u32x4*)(tab + 16384 + 65536 + f * 1024 + l * 16) = w;
    }
    __syncthreads();
}

__device__ __forceinline__ void pre0_phase(ArgsP a) {
    const int tid = tid_l(), G = sg_l(gridDim.x), bid = sg_l(blockIdx.x);
    unsigned char* ws = a->ws;
    float* rope = (float*)(ws + WS_ROPE);
    for (int e = bid * 512 + tid; e < L * 16; e += G * 512) {
        const int pos = e >> 4, i = e & 15;
        const double invf = exp(-(double)i * (1.0 / 16.0) * 13.122363377404328);
        double ang = (double)pos * invf; ang -= 6.283185307179586476925 * floor(ang / 6.283185307179586476925);
        rope[e * 2] = (float)cos(ang); rope[e * 2 + 1] = (float)sin(ang);
    }
    float* epb = (float*)(ws + WS_EP);
    for (int e = bid * 512 + tid; e < 2 * 64 * 19 * 64; e += G * 512) {
        const int p = e & 63, n = (e >> 6) % 19, jg = (e >> 6) / 19;
        const double dt = exp((double)a->in[5][jg]);
        const double lr = (double)a->in[3][(size_t)jg * 64 + p], li = (double)a->in[4][(size_t)jg * 64 + p];
        const double pw = n <= 16 ? (double)n : (n == 17 ? 512.0 : 1.0);
        const double mag = exp(lr * dt * pw); double ang = li * dt * pw; ang -= 6.283185307179586476925 * floor(ang / 6.283185307179586476925);
        double cr = cos(ang) * mag, ci = sin(ang) * mag;
        if (n == 18) { const double nr = cr - 1.0, ni = ci, den = lr * lr + li * li; cr = (nr * lr + ni * li) / den; ci = (ni * lr - nr * li) / den; }
        epb[(size_t)jg * EP_STRIDE + (n * 64 + p) * 2] = (float)cr; epb[(size_t)jg * EP_STRIDE + (n * 64 + p) * 2 + 1] = (float)ci;
    }
}
__device__ __forceinline__ void prep_phase(ArgsP a, int layer, const float* h, unsigned char* smem) {
    const int tid = tid_l(), lane = tid & 63, wave = tid >> 6, G = sg_l(gridDim.x), bid = sg_l(blockIdx.x);
    unsigned char* ws = a->ws;
    const int j = layer >> 1;
    if ((layer & 1) == 0) {
        for (int g = bid; g < 64; g += G) ssm_tables(a, j, g, smem, ws + WS_TAB + (size_t)g * TAB_STRIDE);
    }
    __syncthreads();
    float* scr = (float*)(smem + wave * 16384);
    const int gw = bid * 8 + wave, NGW = G * 8;
    bf16_t* Wb = (bf16_t*)(ws + WS_W);
    if ((layer & 1) == 0) {
        const float* w_in = a->in[2] + (size_t)j * 1024 * 2048; const float* w_glu = a->in[11] + (size_t)j * 1024 * 1024; const float* w_out = a->in[13] + (size_t)j * 1024 * 1024;
        for (int it = gw; it < 2048; it += NGW) {
            if (it < 1024) transpose_item(w_in, 1024, 2048, Wb, scr, it, lane);
            else if (it < 1536) transpose_item(w_glu, 1024, 1024, Wb + 2048 * 1024, scr, it - 1024, lane);
            else transpose_item(w_out, 1024, 1024, Wb + 3072 * 1024, scr, it - 1536, lane);
        }
    } else {
        const float* w_in = a->in[14] + (size_t)j * 1024 * 4096; const float* w_out = a->in[17] + (size_t)j * 1024 * 1024;
        for (int it = gw; it < 2560; it += NGW) {
            if (it < 2048) transpose_item(w_in, 1024, 4096, Wb, scr, it, lane);
            else transpose_item(w_out, 1024, 1024, Wb + 4096 * 1024, scr, it - 2048, lane);
        }
    }
    const float* gain = a->in[1] + layer * 1024;
    bf16_t* XN = (bf16_t*)(ws + WS_XN);
    f32x4 gv[4];
#pragma unroll
    for (int q = 0; q < 4; ++q) gv[q] = *(const f32x4*)(gain + 4 * lane + 256 * q);
    for (int m = gw; m < L; m += NGW) {
        const f32x4* xr = (const f32x4*)(h + (size_t)m * DM) + lane;
        f32x4 v[4]; float s = 0.f;
#pragma unroll
        for (int q = 0; q < 4; ++q) { v[q] = xr[64 * q]; s += (v[q].x * v[q].x + v[q].y * v[q].y) + (v[q].z * v[q].z + v[q].w * v[q].w); }
        const float rstd = rsqrtf(wave_sum(s) * (1.f / DM) + NORM_EPS);
        u32x2* o8 = (u32x2*)(XN + (size_t)m * DM) + lane;
#pragma unroll
        for (int q = 0; q < 4; ++q) { u32x2 w; w.x = pk2(v[q].x * rstd * gv[q].x, v[q].y * rstd * gv[q].y); w.y = pk2(v[q].z * rstd * gv[q].z, v[q].w * rstd * gv[q].w); o8[64 * q] = w; }
    }
}

__device__ __forceinline__ void ssm_s1(ArgsP a, unsigned char* smem) {
    const int tid = tid_l(), lane = tid & 63, wave = tid >> 6, G = sg_l(gridDim.x);
    unsigned char* ws = a->ws;
    const bf16_t* U = (const bf16_t*)(ws + WS_U); float* SL = (float*)(ws + WS_SLOC);
    for (int unit = sg_l(blockIdx.x); unit < 256; unit += G) {
        const int g = unit >> 2, qtr = unit & 3;
        __syncthreads();
        { const u32x4* src = (const u32x4*)(ws + WS_TAB + (size_t)g * TAB_STRIDE + 16384); u32x4* dst = (u32x4*)smem;
          for (int e = tid; e < 4096; e += 512) dst[e] = src[e]; }
        __syncthreads();
#pragma unroll 1
        for (int nt = 0; nt < 2; ++nt) {
            const int chunk0 = qtr * 256 + wave * 32 + nt * 16, n = lane & 15;
            bf16x8 B[8];
#pragma unroll
            for (int ks = 0; ks < 8; ++ks) B[ks] = *(const bf16x8*)(U + (size_t)((chunk0 + n) * 16 + ks * 2 + (lane >> 5)) * DM + g * 16 + ((lane >> 4) & 1) * 8);
#pragma unroll
            for (int mt = 0; mt < 8; ++mt) {
                f32x4 acc = {0.f, 0.f, 0.f, 0.f};
#pragma unroll
                for (int ks = 0; ks < 8; ++ks) { const bf16x8 A = *(const bf16x8*)(smem + (mt * 8 + ks) * 1024 + lane * 16); acc = MFMA16(A, B[ks], acc); }
                *(f32x4*)(SL + ((size_t)(chunk0 + n) * 64 + g) * 128 + mt * 16 + (lane >> 4) * 4) = acc;
                asm volatile("" ::: "memory");
            }
        }
    }
}
__device__ __forceinline__ void ssm_s2(ArgsP a, int j, unsigned char* smem) {
    const int tid = tid_l(), G = sg_l(gridDim.x);
    unsigned char* ws = a->ws;
    const float* SL = (const float*)(ws + WS_SLOC); unsigned* SIN = (unsigned*)(ws + WS_SIN);
    float* ex = (float*)smem;
    for (int unit = sg_l(blockIdx.x); unit < 256; unit += G) {
        const int seg = tid >> 4, sl = tid & 15, st = unit * 16 + sl, g = st >> 6, p = st & 63;
        const float* ep = (const float*)(ws + WS_EP) + (size_t)(j * 64 + g) * EP_STRIDE;
        const float e16r = ep[(16 * 64 + p) * 2], e16i = ep[(16 * 64 + p) * 2 + 1], eSr = ep[(17 * 64 + p) * 2], eSi = ep[(17 * 64 + p) * 2 + 1];
        const float* src = SL + ((size_t)(seg * 32) * 64 + g) * 128 + 2 * p;
        f32x2 v[32];
#pragma unroll
        for (int i = 0; i < 32; ++i) v[i] = *(const f32x2*)(src + (size_t)i * 8192);
        float sr = 0.f, si = 0.f;
#pragma unroll
        for (int i = 0; i < 32; ++i) { const float nr = e16r * sr - e16i * si + v[i].x, ni = e16r * si + e16i * sr + v[i].y; sr = nr; si = ni; }
        __syncthreads();
        ex[(seg * 16 + sl) * 2] = sr; ex[(seg * 16 + sl) * 2 + 1] = si;
        __syncthreads();
        float cr = 0.f, ci = 0.f;
        for (int s = 0; s < seg; ++s) { const float xr = ex[(s * 16 + sl) * 2], xi = ex[(s * 16 + sl) * 2 + 1]; const float nr = eSr * cr - eSi * ci + xr, ni = eSr * ci + eSi * cr + xi; cr = nr; ci = ni; }
        unsigned* dst = SIN + ((size_t)(seg * 32) * 64 + g) * 64 + p;
#pragma unroll
        for (int i = 0; i < 32; ++i) {
            dst[(size_t)i * 4096] = pk2(cr, ci);
            const float nr = e16r * cr - e16i * ci + v[i].x, ni = e16r * ci + e16i * cr + v[i].y; cr = nr; ci = ni;
        }
    }
}
__device__ __forceinline__ void ssm_s3(ArgsP a, int j, unsigned char* smem) {
    const int tid = tid_l(), lane = tid & 63, wave = tid >> 6, G = sg_l(gridDim.x);
    unsigned char* ws = a->ws;
    const bf16_t* U = (const bf16_t*)(ws + WS_U); const bf16_t* SIN = (const bf16_t*)(ws + WS_SIN); bf16_t* YG = (bf16_t*)(ws + WS_YG);
    const float* dsk = a->in[10] + j * 1024;
    for (int unit = sg_l(blockIdx.x); unit < 256; unit += G) {
        const int g = unit >> 2, qtr = unit & 3;
        __syncthreads();
        { const u32x4* srcF = (const u32x4*)(ws + WS_TAB + (size_t)g * TAB_STRIDE); u32x4* dst = (u32x4*)smem;
          for (int e = tid; e < 1024; e += 512) dst[e] = srcF[e];
          const u32x4* srcC = (const u32x4*)(ws + WS_TAB + (size_t)g * TAB_STRIDE + 16384 + 65536);
          for (int e = tid; e < 4096; e += 512) dst[1024 + e] = srcC[e]; }
        __syncthreads();
        const unsigned char* Fl = smem; const unsigned char* Wl = smem + 16384;
        const int n = lane & 15, cq = (lane >> 4) * 4;
        const f32x4 dv = *(const f32x4*)(dsk + g * 16 + cq);
#pragma unroll 1
        for (int nt = 0; nt < 2; ++nt) {
            const int chunk = qtr * 256 + wave * 32 + nt * 16 + n;
            bf16x8 Bu[8], Bs[4];
#pragma unroll
            for (int ks = 0; ks < 8; ++ks) Bu[ks] = *(const bf16x8*)(U + (size_t)(chunk * 16 + ks * 2 + (lane >> 5)) * DM + g * 16 + ((lane >> 4) & 1) * 8);
#pragma unroll
            for (int kk = 0; kk < 4; ++kk) Bs[kk] = *(const bf16x8*)(SIN + ((size_t)chunk * 64 + g) * 128 + kk * 32 + (lane >> 4) * 8);
#pragma unroll
            for (int t = 0; t < 16; ++t) {
                f32x4 acc = {0.f, 0.f, 0.f, 0.f};
#pragma unroll
                for (int i = 0; i <= t / 2; ++i) { const bf16x8 A = *(const bf16x8*)(Fl + (t - 2 * i) * 1024 + lane * 16); acc = MFMA16(A, Bu[i], acc); }
#pragma unroll
                for (int kk = 0; kk < 4; ++kk) { const bf16x8 A = *(const bf16x8*)(Wl + (t * 4 + kk) * 1024 + lane * 16); acc = MFMA16(A, Bs[kk], acc); }
                const size_t off = (size_t)(chunk * 16 + t) * DM + g * 16 + cq;
                const u32x2 uv = *(const u32x2*)(U + off);
                const float y0 = gelu_tanh(acc[0] + dv[0] * bflo(uv.x)), y1 = gelu_tanh(acc[1] + dv[1] * bfhi(uv.x));
                const float y2 = gelu_tanh(acc[2] + dv[2] * bflo(uv.y)), y3 = gelu_tanh(acc[3] + dv[3] * bfhi(uv.y));
                u32x2 w; w.x = pk2(y0, y1); w.y = pk2(y2, y3);
                *(u32x2*)(YG + off) = w;
                asm volatile("" ::: "memory");
            }
        }
    }
}

constexpr int QK_STRIDE = 4096;
constexpr int KL_STRIDE = 272, VL_STRIDE = 528, VT_OFF = 256 * KL_STRIDE;

__device__ __forceinline__ void attn_a1(ArgsP a, int j, unsigned char* smem) {
    const int tid = tid_l(), G = sg_l(gridDim.x);
    unsigned char* ws = a->ws;
    bf16_t* QKVZ = (bf16_t*)(ws + WS_BIG); const float* rope = (const float*)(ws + WS_ROPE); float* kmean = (float*)(ws + WS_KMEAN);
    if (sg_l(blockIdx.x) == 0) ((unsigned*)(ws + WS_CTL))[tid] = 0u;
    const int seg = tid & 15, rg = tid >> 4;
    const float* qg = a->in[15] + j * 128 + seg * 8; const float* kg = a->in[16] + j * 128 + seg * 8;
    float gq[8], gk[8];
#pragma unroll
    for (int i = 0; i < 8; ++i) { gq[i] = qg[i]; gk[i] = kg[i]; }
    float* red = (float*)(smem + 72 * 1024);
    for (int unit = sg_l(blockIdx.x); unit < 512; unit += G) {
        const int h = unit & 7, b = unit >> 3;
        float ksum[8];
#pragma unroll
        for (int i = 0; i < 8; ++i) ksum[i] = 0.f;
        __syncthreads();
        for (int ps = 0; ps < 8; ++ps) {
            const int t = b * 256 + ps * 32 + rg;
            float cs[8], sn[8];
            if (seg < 4) {
#pragma unroll
                for (int i = 0; i < 8; ++i) { const f32x2 r = *(const f32x2*)(rope + ((size_t)t * 16 + (seg & 1) * 8 + i) * 2); cs[i] = r.x; sn[i] = r.y; }
            }
#pragma unroll
            for (int which = 0; which < 2; ++which) {
                bf16_t* p = QKVZ + (size_t)t * QK_STRIDE + which * 1024 + h * 128 + seg * 8;
                const u32x4 raw = *(const u32x4*)p;
                float x[8];
#pragma unroll
                for (int q = 0; q < 4; ++q) { x[2 * q] = bflo(raw[q]); x[2 * q + 1] = bfhi(raw[q]); }
                float ss = 0.f;
#pragma unroll
                for (int i = 0; i < 8; ++i) ss += x[i] * x[i];
                ss += __shfl_xor(ss, 1); ss += __shfl_xor(ss, 2); ss += __shfl_xor(ss, 4); ss += __shfl_xor(ss, 8);
                const float rstd = rsqrtf(ss * (1.f / 128.f) + NORM_EPS);
#pragma unroll
                for (int i = 0; i < 8; ++i) x[i] = x[i] * rstd * (which == 0 ? gq[i] : gk[i]);
                float y[8];
#pragma unroll
                for (int i = 0; i < 8; ++i) {
                    const float o = __shfl_xor(x[i], 2);
                    y[i] = x[i];
                    if (seg < 2) y[i] = x[i] * cs[i] - o * sn[i];
                    else if (seg < 4) y[i] = x[i] * cs[i] + o * sn[i];
                }
                u32x4 w; w.x = pk2(y[0], y[1]); w.y = pk2(y[2], y[3]); w.z = pk2(y[4], y[5]); w.w = pk2(y[6], y[7]);
                *(u32x4*)p = w;
                if (which == 1) {
#pragma unroll
                    for (int i = 0; i < 8; ++i) ksum[i] += y[i];
                }
            }
            { const int key = ps * 32 + rg; const u32x4 raw = *(const u32x4*)(QKVZ + (size_t)t * QK_STRIDE + 2048 + h * 128 + seg * 8);
              *(u32x4*)(smem + key * KL_STRIDE + seg * 16) = raw; }
        }
#pragma unroll
        for (int i = 0; i < 8; ++i) red[rg * 128 + seg * 8 + i] = ksum[i];
        __syncthreads();
        if (tid < 128) { float s = 0.f;
#pragma unroll
            for (int r = 0; r < 32; ++r) s += red[r * 128 + tid];
            kmean[((size_t)h * 64 + b) * 128 + tid] = s * (1.f / 256.f); }
        for (int e = tid; e < 4096; e += 512) {
            const int d = e & 127, ko = e >> 7, key0 = ko * 8;
            unsigned short v[8];
#pragma unroll
            for (int i = 0; i < 8; ++i) v[i] = *(const unsigned short*)(smem + (key0 + i) * KL_STRIDE + d * 2);
            u32x4 w; w.x = v[0] | ((unsigned)v[1] << 16); w.y = v[2] | ((unsigned)v[3] << 16); w.z = v[4] | ((unsigned)v[5] << 16); w.w = v[6] | ((unsigned)v[7] << 16);
            *(u32x4*)(QKVZ + (size_t)(b * 256 + 2 * d + (key0 >> 7)) * QK_STRIDE + 2048 + h * 128 + (key0 & 127)) = w;
        }
    }
}

__device__ __forceinline__ void attn_a2(ArgsP a, unsigned char* smem) {
    const int tid = tid_l(), G = sg_l(gridDim.x);
    unsigned char* ws = a->ws;
    const bf16_t* QKVZ = (const bf16_t*)(ws + WS_BIG); const float* kmean = (const float*)(ws + WS_KMEAN);
    unsigned* cnt = (unsigned*)(ws + WS_CTL); unsigned short* lists = (unsigned short*)(ws + WS_TAB);
    float* km = (float*)smem;
    const int sub = tid & 3, ql = tid >> 2;
    for (int u0 = sg_l(blockIdx.x), round = 0; u0 < 1024; u0 += G, ++round) {
        {
            const int unit = ((round & 1) && (round + 1) * G <= 1024) ? ((round + 1) * G - 1 - sg_l(blockIdx.x)) : u0;
            const int h = unit & 7, r = unit >> 3, t = r * 128 + ql, own = t >> 8;
            __syncthreads();
            { const f32x4* src = (const f32x4*)(kmean + (size_t)h * 64 * 128); f32x4* dst = (f32x4*)km;
              for (int e = tid; e < 2048; e += 512) dst[e] = src[e]; }
            __syncthreads();
            float q[32];
            { const u32x4* qp = (const u32x4*)(QKVZ + (size_t)t * QK_STRIDE + h * 128 + sub * 32);
#pragma unroll
              for (int v = 0; v < 4; ++v) { const u32x4 w = qp[v];
#pragma unroll
                  for (int c = 0; c < 4; ++c) { q[v * 8 + c * 2] = bflo(w[c]); q[v * 8 + c * 2 + 1] = bfhi(w[c]); } } }
            float v1 = -INFINITY, v2 = -INFINITY, v3 = -INFINITY; int i1 = -1, i2 = -1, i3 = -1;
            for (int n = 0; n < own; ++n) {
                const f32x4* kp = (const f32x4*)(km + n * 128 + sub * 32);
                float s = 0.f;
#pragma unroll
                for (int v = 0; v < 8; ++v) { const f32x4 kv = kp[v]; s += q[v * 4] * kv.x + q[v * 4 + 1] * kv.y + q[v * 4 + 2] * kv.z + q[v * 4 + 3] * kv.w; }
                s += __shfl_xor(s, 1); s += __shfl_xor(s, 2);
                if (s > v1) { v3 = v2; i3 = i2; v2 = v1; i2 = i1; v1 = s; i1 = n; }
                else if (s > v2) { v3 = v2; i3 = i2; v2 = s; i2 = n; }
                else if (s > v3) { v3 = s; i3 = n; }
            }
            if (sub == 0) {
                const int sel[3] = {i1, i2, i3};
#pragma unroll
                for (int jx = 0; jx < 3; ++jx) if (sel[jx] >= 0) {
                    const int n = sel[jx];
                    const unsigned pos = atomicAdd(&cnt[h * 64 + n], 1u);
                    lists[(size_t)h * LIST_PER_HEAD + list_off(n) + pos] = (unsigned short)(t | (jx << 14));
                }
            }
        }
    }
}

__device__ __forceinline__ void load_kv(const bf16_t* QKVZ, int h, int n, unsigned char* smem) {
    const int tid = tid_l();
    for (int e = tid; e < 4096; e += 512) {
        const int key = e >> 4, pc = e & 15;
        *(u32x4*)(smem + key * KL_STRIDE + pc * 16) = *(const u32x4*)(QKVZ + (size_t)(n * 256 + key) * QK_STRIDE + 1024 + h * 128 + pc * 8);
    }
    for (int e = tid; e < 4096; e += 512) {
        const int d = e >> 5, pc = e & 31, key0 = pc * 8;
        *(u32x4*)(smem + VT_OFF + d * VL_STRIDE + pc * 16) = *(const u32x4*)(QKVZ + (size_t)(n * 256 + 2 * d + (key0 >> 7)) * QK_STRIDE + 2048 + h * 128 + (key0 & 127));
    }
}
__device__ __forceinline__ void attn_core(const unsigned char* smem, const bf16x8 (&qf)[8], int nkt, int mask_kt, int qidx, float c1, float c2, f32x16 (&O)[4], float& lsum) {
    const int lane = tid_l() & 63, r = lane & 31, hh = lane >> 5;
    for (int kt = 0; kt < nkt; ++kt) {
        f32x16 S;
#pragma unroll
        for (int i = 0; i < 16; ++i) S[i] = 0.f;
#pragma unroll
        for (int kk = 0; kk < 8; ++kk) { const bf16x8 A = *(const bf16x8*)(smem + (kt * 32 + r) * KL_STRIDE + (kk * 16 + hh * 8) * 2); S = MFMA32(A, qf[kk], S); }
        float p[16];
#pragma unroll
        for (int i = 0; i < 16; ++i) { p[i] = exp2f(S[i] * c1 - c2);
            if (kt == mask_kt) { const int key = kt * 32 + (i & 3) + 8 * (i >> 2) + 4 * hh; if (key > qidx) p[i] = 0.f; }
            lsum += p[i]; }
#pragma unroll
        for (int s = 0; s < 2; ++s) {
            u32x4 pw; pw.x = pk2(p[8 * s], p[8 * s + 1]); pw.y = pk2(p[8 * s + 2], p[8 * s + 3]); pw.z = pk2(p[8 * s + 4], p[8 * s + 5]); pw.w = pk2(p[8 * s + 6], p[8 * s + 7]);
            const bf16x8 pb = __builtin_bit_cast(bf16x8, pw);
#pragma unroll
            for (int dt = 0; dt < 4; ++dt) {
                const unsigned char* vp = smem + VT_OFF + (dt * 32 + r) * VL_STRIDE + (kt * 32 + 16 * s + 4 * hh) * 2;
                const s16x4 lo = *(const s16x4*)vp, hi = *(const s16x4*)(vp + 16);
                const bf16x8 A = __builtin_shufflevector(lo, hi, 0, 1, 2, 3, 4, 5, 6, 7);
                O[dt] = MFMA32(A, pb, O[dt]);
            }
        }
    }
}
__device__ __forceinline__ float attn_ref(ArgsP a, int j) {
    const int lane = tid_l() & 63;
    float mq = fmaxf(fabsf(a->in[15][j * 128 + lane]), fabsf(a->in[15][j * 128 + 64 + lane]));
    float mk = fmaxf(fabsf(a->in[16][j * 128 + lane]), fabsf(a->in[16][j * 128 + 64 + lane]));
#pragma unroll
    for (int o = 1; o < 64; o <<= 1) { mq = fmaxf(mq, __shfl_xor(mq, o)); mk = fmaxf(mk, __shfl_xor(mk, o)); }
    return 11.313708499f * mq * mk;
}

__device__ __forceinline__ void attn_a3(ArgsP a, int j, unsigned char* smem) {
    const int tid = tid_l(), lane = tid & 63, wave = tid >> 6, G = sg_l(gridDim.x), r = lane & 31, hh = lane >> 5;
    unsigned char* ws = a->ws;
    const bf16_t* QKVZ = (const bf16_t*)(ws + WS_BIG);
    const unsigned* cnt = (const unsigned*)(ws + WS_CTL); const unsigned short* lists = (const unsigned short*)(ws + WS_TAB);
    float* lpart = (float*)(ws + WS_LPART);
    int* pre = (int*)(smem + 140 * 1024);
    const float ref = attn_ref(a, j), c1 = 0.08838834764831845f * 1.4426950408889634f, c2 = ref * 1.4426950408889634f;
    __syncthreads();
    { const int c = (int)cnt[tid]; pre[tid] = (c + 255) >> 8; }
    __syncthreads();
    for (int o = 1; o < 512; o <<= 1) { const int v = pre[tid] + (tid >= o ? pre[tid - o] : 0); __syncthreads(); pre[tid] = v; __syncthreads(); }
    const int total = pre[511]; const int bidx = sg_l(blockIdx.x);
    const int t_lo = (int)(((long)total * bidx) / G), t_hi = (int)(((long)total * (bidx + 1)) / G);
    int cur_pr = -1;
    for (int tile = t_lo; tile < t_hi; ++tile) {
        int lo = 0, hi = 511;
        while (lo < hi) { const int mid = (lo + hi) >> 1; if (pre[mid] > tile) hi = mid; else lo = mid + 1; }
        const int pr = lo, h = pr >> 6, n = pr & 63, tl = tile - (pr ? pre[pr - 1] : 0), c = (int)cnt[pr];
        if (pr != cur_pr) { __syncthreads(); load_kv(QKVZ, h, n, smem); __syncthreads(); cur_pr = pr; }
        const int li = tl * 256 + wave * 32 + r; const bool valid = li < c;
        const unsigned e = lists[(size_t)h * LIST_PER_HEAD + list_off(n) + (valid ? li : 0)];
        const int t = e & 0x3fff, slot = e >> 14;
        bf16x8 qf[8];
#pragma unroll
        for (int kk = 0; kk < 8; ++kk) qf[kk] = *(const bf16x8*)(QKVZ + (size_t)t * QK_STRIDE + h * 128 + kk * 16 + hh * 8);
        f32x16 O[4];
#pragma unroll
        for (int dt = 0; dt < 4; ++dt)
#pragma unroll
            for (int i = 0; i < 16; ++i) O[dt][i] = 0.f;
        float lsum = 0.f;
        attn_core(smem, qf, 8, -1, 0, c1, c2, O, lsum);
        lsum += __shfl_xor(lsum, 32);
        if (valid) {
            bf16_t* P = (bf16_t*)(ws + (slot == 0 ? WS_XN : (slot == 1 ? WS_P1 : WS_P2))) + (size_t)t * DM + h * 128;
#pragma unroll
            for (int dt = 0; dt < 4; ++dt)
#pragma unroll
                for (int q4 = 0; q4 < 4; ++q4) { u32x2 w; w.x = pk2(O[dt][4 * q4], O[dt][4 * q4 + 1]); w.y = pk2(O[dt][4 * q4 + 2], O[dt][4 * q4 + 3]);
                    *(u32x2*)(P + dt * 32 + 8 * q4 + 4 * hh) = w; }
            if (hh == 0) lpart[((size_t)slot * L + t) * 8 + h] = lsum;
        }
    }
}
__device__ __forceinline__ void attn_a4(ArgsP a, int j, unsigned char* smem) {
    const int tid = tid_l(), lane = tid & 63, wave = tid >> 6, G = sg_l(gridDim.x), r = lane & 31, hh = lane >> 5;
    unsigned char* ws = a->ws;
    const bf16_t* QKVZ = (const bf16_t*)(ws + WS_BIG); const float* lpart = (const float*)(ws + WS_LPART);
    const float ref = attn_ref(a, j), c1 = 0.08838834764831845f * 1.4426950408889634f, c2 = ref * 1.4426950408889634f;
    for (int unit = sg_l(blockIdx.x); unit < 512; unit += G) {
        const int h = unit & 7, b = unit >> 3;
        __syncthreads(); load_kv(QKVZ, h, b, smem); __syncthreads();
        const int qidx = wave * 32 + r, t = b * 256 + qidx;
        bf16x8 qf[8];
#pragma unroll
        for (int kk = 0; kk < 8; ++kk) qf[kk] = *(const bf16x8*)(QKVZ + (size_t)t * QK_STRIDE + h * 128 + kk * 16 + hh * 8);
        f32x16 O[4];
#pragma unroll
        for (int dt = 0; dt < 4; ++dt)
#pragma unroll
            for (int i = 0; i < 16; ++i) O[dt][i] = 0.f;
        float lsum = 0.f;
        attn_core(smem, qf, wave + 1, wave, qidx, c1, c2, O, lsum);
        lsum += __shfl_xor(lsum, 32);
        const int nsel = b < 3 ? b : 3;
        for (int s = 0; s < nsel; ++s) lsum += lpart[((size_t)s * L + t) * 8 + h];
        const float inv = 1.0f / lsum;
        bf16_t* ATT = (bf16_t*)(ws + WS_XN) + (size_t)t * DM + h * 128;
        const bf16_t* Zp = QKVZ + (size_t)t * QK_STRIDE + 3072 + h * 128;
#pragma unroll
        for (int dt = 0; dt < 4; ++dt)
#pragma unroll
            for (int q4 = 0; q4 < 4; ++q4) {
                const int d0 = dt * 32 + 8 * q4 + 4 * hh;
                float o0 = O[dt][4 * q4], o1 = O[dt][4 * q4 + 1], o2 = O[dt][4 * q4 + 2], o3 = O[dt][4 * q4 + 3];
                for (int s = 0; s < nsel; ++s) {
                    const u32x2 pv = *(const u32x2*)((const bf16_t*)(ws + (s == 0 ? WS_XN : (s == 1 ? WS_P1 : WS_P2))) + (size_t)t * DM + h * 128 + d0);
                    o0 += bflo(pv.x); o1 += bfhi(pv.x); o2 += bflo(pv.y); o3 += bfhi(pv.y);
                }
                const u32x2 zv = *(const u32x2*)(Zp + d0);
                const float z0 = bflo(zv.x), z1 = bfhi(zv.x), z2 = bflo(zv.y), z3 = bfhi(zv.y);
                u32x2 w; w.x = pk2(o0 * inv * z0 * sigmoidf_(z0), o1 * inv * z1 * sigmoidf_(z1)); w.y = pk2(o2 * inv * z2 * sigmoidf_(z2), o3 * inv * z3 * sigmoidf_(z3));
                *(u32x2*)(ATT + d0) = w;
            }
    }
}


#define XB_TMO      128
#define XB_XCNT(j)  (256  + 64 * (j))
#define XB_XSUB(j)  (1280 + 64 * (j))
#define XB_XGEN(j)  (2304 + 64 * (j))
#define XB_TOP      3328
#define XB_TOPGEN   3392
#define XCD_BAR_WORDS 3456
#define XB_SPIN_CAP (1u << 22)
__device__ __forceinline__ unsigned xb_ld(unsigned* p)              { return __hip_atomic_load(p, __ATOMIC_RELAXED, __HIP_MEMORY_SCOPE_AGENT); }
__device__ __forceinline__ unsigned xb_add(unsigned* p, unsigned v) { return __hip_atomic_fetch_add(p, v, __ATOMIC_RELAXED, __HIP_MEMORY_SCOPE_AGENT); }
__device__ __forceinline__ unsigned xb_xcc_id() { return (unsigned)__builtin_amdgcn_s_getreg((3 << 11) | 20) & 0xFu; }
#define XB_SPIN(cond, bar) do { unsigned _sp = 0; while (cond) { __builtin_amdgcn_s_sleep(1); \
    if ((++_sp & 255u) == 0u) { if (xb_ld(&(bar)[XB_TMO])) break; if (_sp > XB_SPIN_CAP) { atomicAdd(&(bar)[XB_TMO], 1u); break; } } } } while (0)
struct XcdBarrier { unsigned* bar; unsigned x; volatile LAS unsigned* st; };
__device__ __forceinline__ XcdBarrier xcd_barrier_post(unsigned* bar, volatile LAS unsigned* st) {
    XcdBarrier b; b.bar = bar; b.x = xb_xcc_id(); b.st = st;
    if (threadIdx.x == 0) (void)xb_add(&bar[XB_XCNT(b.x)], 1u);
    return b;
}
__device__ __forceinline__ void xcd_barrier_complete(unsigned* bar, unsigned x, unsigned& nloc, unsigned& nx) {
    const unsigned G = gridDim.x * gridDim.y * gridDim.z;
    unsigned sum, cnt, mine, sp = 0u;
    for (;;) {
        sum = 0u; cnt = 0u; mine = 0u;
#pragma unroll
        for (unsigned j = 0; j < 16; ++j) { const unsigned c = xb_ld(&bar[XB_XCNT(j)]); sum += c; cnt += (c > 0u) ? 1u : 0u; mine = (j == x) ? c : mine; }
        if (sum == G) break;
        __builtin_amdgcn_s_sleep(1);
        if ((++sp & 255u) == 0u) { if (xb_ld(&bar[XB_TMO])) break; if (sp > XB_SPIN_CAP) { atomicAdd(&bar[XB_TMO], 1u); break; } }
    }
    nloc = mine > 0u ? mine : 1u; nx = cnt > 0u ? cnt : 1u;
}
__device__ __forceinline__ void xcd_barrier(const XcdBarrier& b) {
    asm volatile("s_waitcnt vmcnt(0)" ::: "memory");
    __syncthreads();
    if (threadIdx.x == 0) {
        unsigned* bar = b.bar;
        __builtin_amdgcn_s_waitcnt(0);
        unsigned nloc = b.st[0], nx = b.st[1];
        if (nloc == 0u) { xcd_barrier_complete(bar, b.x, nloc, nx); b.st[0] = nloc; b.st[1] = nx; }
        const unsigned old = xb_add(&bar[XB_XSUB(b.x)], 1u);
        const unsigned gen = old / nloc;
        if (old + 1u == (gen + 1u) * nloc) {
            __builtin_amdgcn_fence(__ATOMIC_RELEASE, "agent");
            asm volatile("s_waitcnt vmcnt(0)" ::: "memory");
            const unsigned og = xb_add(&bar[XB_TOP], 1u);
            const unsigned tg = og / nx;
            if (og + 1u == (tg + 1u) * nx) xb_add(&bar[XB_TOPGEN], 1u);
            else XB_SPIN(xb_ld(&bar[XB_TOPGEN]) == tg, bar);
            __builtin_amdgcn_fence(__ATOMIC_ACQUIRE, "agent");
            xb_add(&bar[XB_XGEN(b.x)], 1u);
            asm volatile("s_waitcnt vmcnt(0)" ::: "memory");
        } else {
            XB_SPIN(xb_ld(&bar[XB_XGEN(b.x)]) == gen, bar);
            __builtin_amdgcn_fence(__ATOMIC_ACQUIRE, "agent");
            asm volatile("s_waitcnt vmcnt(0)" ::: "memory");
        }
    }
    __syncthreads();
}
#ifndef PH_MASK
#define PH_MASK 0xFFFF
#endif
#define PH(b) ((PH_MASK >> (b)) & 1)
#ifndef REP_MASK
#define REP_MASK 0
#endif
#ifndef XSYNC
#define XSYNC 0
#endif
#define REP(b) for (int _r = 0; _r < 1 + ((REP_MASK >> (b)) & 1); ++_r)
__global__ void __launch_bounds__(512, 2) hybrid_fwd(Args a_unused) {
    extern __shared__ __attribute__((aligned(16))) unsigned char smem[];
    cg::grid_group grid = cg::this_grid();
    LAS unsigned char* lds = (LAS unsigned char*)smem;
    const ArgsP ap = (ArgsP)__builtin_amdgcn_kernarg_segment_ptr();
    if (threadIdx.x < 2) ((volatile LAS unsigned*)(lds + LDS_BARST))[threadIdx.x] = 0u;
    __syncthreads();
    const XcdBarrier xbar = xcd_barrier_post((unsigned*)(ap->ws + WS_BAR), (volatile LAS unsigned*)(lds + LDS_BARST));

#define a launder(ap)
#define ws (launder(ap)->ws)
#define Wb ((bf16_t*)(ws + WS_W))
#define XN ((bf16_t*)(ws + WS_XN))
    REP(0) if (PH(0)) pre0_phase(a);
    grid.sync();
    for (int _x = 0; _x < XSYNC; ++_x) xcd_barrier(xbar);
    REP(0) if (PH(0)) prep_phase(a, 0, a->in[0], smem);
    xcd_barrier(xbar);
#pragma unroll 1
    for (int layer = 0; layer < 4; ++layer) {
        const int j = layer >> 1;
        if ((layer & 1) == 0) {
            REP(1) if (PH(1)) { pg8::Gemm g{XN, Wb, L, 2048, 1024}; pg8::StaticOrder S; S.init(L, 2048, sg_l(gridDim.x), sg_l(blockIdx.x));
              pg8::EpiStore E{(bf16_t*)(ws + WS_U), 1024, 1024, (size_t)(WS_Z - WS_U) / 2};
              pg8::gemm_phase<pg8::EpiStore, pg8::StaticOrder, true, true>(lds, g, S, E); }
            xcd_barrier(xbar);
            REP(2) if (PH(2)) ssm_s1(a, smem);
            xcd_barrier(xbar);
            REP(3) if (PH(3)) ssm_s2(a, j, smem);
            xcd_barrier(xbar);
            REP(4) if (PH(4)) ssm_s3(a, j, smem);
            xcd_barrier(xbar);
            REP(5) if (PH(5)) { pg8::Gemm g{(const bf16_t*)(ws + WS_YG), Wb + 2048 * 1024, L, 1024, 1024}; pg8::StaticOrder S; S.init(L, 1024, sg_l(gridDim.x), sg_l(blockIdx.x));
              pg8::EpiGlu E{(const bf16_t*)(ws + WS_YG), (const bf16_t*)(ws + WS_Z), a->in[12] + j * 1024, (bf16_t*)(ws + WS_Y2)};
              pg8::gemm_phase<pg8::EpiGlu, pg8::StaticOrder, true, true>(lds, g, S, E); }
            xcd_barrier(xbar);
            REP(6) if (PH(6)) { pg8::Gemm g{(const bf16_t*)(ws + WS_Y2), Wb + 3072 * 1024, L, 1024, 1024}; pg8::StaticOrder S; S.init(L, 1024, sg_l(gridDim.x), sg_l(blockIdx.x));
              pg8::EpiRes E{layer == 0 ? a->in[0] : (const float*)a->out, a->out};
              pg8::gemm_phase<pg8::EpiRes, pg8::StaticOrder, true, true>(lds, g, S, E); }
            xcd_barrier(xbar);
        } else {
            REP(7) if (PH(7)) { pg8::Gemm g{XN, Wb, L, 4096, 1024}; pg8::StaticOrder S; S.init(L, 4096, sg_l(gridDim.x), sg_l(blockIdx.x));
              pg8::EpiStore E{(bf16_t*)(ws + WS_BIG), 4096, 0, 0};
              pg8::gemm_phase<pg8::EpiStore, pg8::StaticOrder, true, true>(lds, g, S, E); }
            xcd_barrier(xbar);
            REP(8) if (PH(8)) attn_a1(a, j, smem);
            xcd_barrier(xbar);
            REP(9) if (PH(9)) attn_a2(a, smem);
            xcd_barrier(xbar);
            REP(10) if (PH(10)) attn_a3(a, j, smem);
            xcd_barrier(xbar);
            REP(11) if (PH(11)) attn_a4(a, j, smem);
            xcd_barrier(xbar);
            REP(12) if (PH(12)) { pg8::Gemm g{XN, Wb + 4096 * 1024, L, 1024, 1024}; pg8::StaticOrder S; S.init(L, 1024, sg_l(gridDim.x), sg_l(blockIdx.x));
              pg8::EpiRes E{layer == 0 ? a->in[0] : (const float*)a->out, a->out};
              pg8::gemm_phase<pg8::EpiRes, pg8::StaticOrder, true, true>(lds, g, S, E); }
            xcd_barrier(xbar);
        }
        if (layer < 3) { REP(13) if (PH(13)) prep_phase(a, layer + 1, a->out, smem); xcd_barrier(xbar); }
    }
}

#undef a
#undef ws
#undef Wb
#undef XN
extern "C" void kernel_launch(void* const* d_in, const int* in_sizes, int n_in, void* d_out, int out_size, void* d_ws, size_t ws_size, hipStream_t stream) {
    static int grid = 0;
    if (grid == 0) {
        if (n_in != 18 || out_size != L * DM || ws_size < WS_END) { fprintf(stderr, "kernel_launch: unexpected shapes (n_in %d, out %d, ws %zu)\n", n_in, out_size, ws_size); grid = -1; return; }
        int dev = 0, cus = 0, per_cu = 0;
        hipGetDevice(&dev); hipDeviceGetAttribute(&cus, hipDeviceAttributeMultiprocessorCount, dev);
        hipFuncSetAttribute((const void*)hybrid_fwd, hipFuncAttributeMaxDynamicSharedMemorySize, LDS_BYTES);
        hipOccupancyMaxActiveBlocksPerMultiprocessor(&per_cu, (const void*)hybrid_fwd, 512, LDS_BYTES);
        if (per_cu < 1) { fprintf(stderr, "kernel_launch: occupancy query says %d blocks per CU\n", per_cu); per_cu = 1; }
        grid = cus * 1;
        if (grid > 256) grid = 256;
    }
    if (grid < 0) return;
    Args a{};
    for (int i = 0; i < 18; ++i) a.in[i] = (const float*)d_in[i];
    a.out = (float*)d_out; a.ws = (unsigned char*)d_ws;
    hipMemsetAsync((char*)d_ws + WS_BAR, 0, 16 * 1024, stream);
    void* args[] = {&a};
    hipError_t e = hipLaunchCooperativeKernel((const void*)hybrid_fwd, dim3(grid), dim3(512), args, LDS_BYTES, stream);
    if (e != hipSuccess) fprintf(stderr, "cooperative launch failed: %s (grid %d)\n", hipGetErrorString(e), grid);
}
```

```cpp
#include <hip/hip_runtime.h>
#include <hip/hip_cooperative_groups.h>
#include <cstdio>
#include <cstdint>
namespace cg = cooperative_groups;

#define LAS __attribute__((address_space(3)))
typedef unsigned short bf16_t;
typedef short bf16x8 __attribute__((ext_vector_type(8)));
typedef short s16x4 __attribute__((ext_vector_type(4)));
typedef float f32x2 __attribute__((ext_vector_type(2)));
typedef float f32x4 __attribute__((ext_vector_type(4)));
typedef float f32x16 __attribute__((ext_vector_type(16)));
typedef unsigned u32x2 __attribute__((ext_vector_type(2)));
typedef unsigned u32x4 __attribute__((ext_vector_type(4)));
typedef __bf16 bf16v2 __attribute__((ext_vector_type(2)));

__device__ __forceinline__ unsigned pk2(float lo, float hi) { f32x2 v = {lo, hi}; bf16v2 b = __builtin_convertvector(v, bf16v2); return __builtin_bit_cast(unsigned, b); }
__device__ __forceinline__ float bflo(unsigned w) { return __uint_as_float(w << 16); }
__device__ __forceinline__ float bfhi(unsigned w) { return __uint_as_float(w & 0xffff0000u); }
__device__ __forceinline__ float sigmoidf_(float x) { return 1.0f / (1.0f + __expf(-x)); }
__device__ __forceinline__ float gelu_tanh(float y) { const float t = 0.7978845608028654f * (y + 0.044715f * y * y * y); const float e = __expf(2.0f * t); const float th = 1.0f - 2.0f / (e + 1.0f); return 0.5f * y * (1.0f + th); }

__device__ __forceinline__ int tid_l() { int t = threadIdx.x; asm volatile("" : "+v"(t)); return t; }
__device__ __forceinline__ int sg_l(int v) { v = __builtin_amdgcn_readfirstlane(v); asm volatile("" : "+s"(v)); return v; }
constexpr int L = 16384, DM = 1024, NH = 8, HD = 128, NBLK = 64;
constexpr size_t MiB = 1u << 20;
constexpr size_t WS_CTL = 0, WS_BAR = 16 * 1024, WS_KMEAN = 256 * 1024;
constexpr int LDS_BARST = 146432;
constexpr size_t WS_W = 1 * MiB, WS_TAB = 11 * MiB, WS_XN = 21 * MiB, WS_BIG = 53 * MiB;
constexpr size_t WS_U = WS_BIG, WS_Z = WS_BIG + 32 * MiB, WS_YG = WS_BIG + 64 * MiB, WS_Y2 = WS_BIG + 96 * MiB;
constexpr size_t WS_P1 = 181 * MiB, WS_P2 = 213 * MiB, WS_SLOC = 181 * MiB, WS_SIN = 213 * MiB;
constexpr size_t WS_LPART = 245 * MiB, WS_ROPE = 247 * MiB, WS_EP = 249 * MiB, WS_END = 251 * MiB;
constexpr int EP_STRIDE = 19 * 64 * 2;
constexpr int TAB_STRIDE = 147456;
constexpr int LIST_PER_HEAD = 516096;
__host__ __device__ __forceinline__ int list_off(int n) { return 16128 * n - 128 * n * (n - 1); }
constexpr int LDS_BYTES = 147456;
constexpr float NORM_EPS = 1e-6f;

namespace pg8 {
constexpr int BM = 256, BK = 64, HALF = 128, HTB = HALF * BK * 2, STAGE_BYTES = 8 * HTB, NXCD = 8, WGM = 8;
__host__ __device__ __forceinline__ int lds_byte(int r, int c) { const int st = (r >> 4) * 2 + (c >> 5), rr = r & 15, cc = c & 31, ob = rr * 64 + cc * 2; return st * 1024 + (ob ^ (((ob >> 9) & 1) << 5)); }
__host__ __device__ __forceinline__ void stage_rc(int b, int& R, int& C) { const int st = b / 1024, sb = b % 1024, swz = sb ^ (((sb >> 9) & 1) << 5); R = (st >> 1) * 16 + swz / 64; C = (st & 1) * 32 + (swz % 64) / 2; }
__host__ __device__ __forceinline__ int perm32(int rho) { const int n = rho >> 4, i = rho & 15; return 8 * (i >> 2) + 4 * n + (i & 3); }
struct Unit { int pm, pn; };
struct Gemm { const bf16_t* A; const bf16_t* Bt; int M, N, K; };
struct StaticOrder {
    int nM, nN, nwg, G, c;
    __host__ __device__ void init(int M, int N, int G_, int c_) { nM = M / BM; nN = N / BM; nwg = nM * nN; G = G_; c = c_; }
    __host__ __device__ bool next(int i, Unit& u) const {
        const long Lx = (long)i * G + c; if (Lx >= nwg) return false;
        int wgid = (int)Lx; { const int q = nwg / NXCD, r = nwg % NXCD, xcd = wgid % NXCD, off = wgid / NXCD; wgid = (xcd < r ? xcd * (q + 1) : r * (q + 1) + (xcd - r) * q) + off; }
        const int nig = WGM * nN, gid = wgid / nig, fm = gid * WGM, gsz = (nM - fm) < WGM ? (nM - fm) : WGM;
        u.pm = fm + ((wgid % nig) % gsz); u.pn = (wgid % nig) / gsz; return true;
    }
    __device__ __forceinline__ void a_ready(const Unit&) const {}
    __device__ __forceinline__ void done(const Unit&) const {}
};

struct EpiStore {
    static constexpr bool PERM = true, AFTER_DRAIN = false;
    bf16_t* O; int ldc; int split_cols; size_t split_stride;
    __device__ __forceinline__ void operator()(const f32x4 (&acc)[2][2][4][2], const Unit& u, int wr, int wc, int fr, int fq) const {
        const int row0 = u.pm * BM + wr * 64 + fr; int colt = u.pn * BM; bf16_t* base = O;
        if (split_cols) { const int t = colt / split_cols; base += (size_t)t * split_stride; colt -= t * split_cols; }
        const int col0 = colt + wc * 32 + 8 * fq;
#pragma unroll
        for (int ai = 0; ai < 2; ++ai)
#pragma unroll
            for (int m = 0; m < 4; ++m) { bf16_t* rowp = base + (size_t)(row0 + ai * HALF + m * 16) * ldc + col0;
#pragma unroll
                for (int bj = 0; bj < 2; ++bj) { const f32x4 v0 = acc[ai][bj][m][0], v1 = acc[ai][bj][m][1];
                    u32x4 w; w.x = pk2(v0[0], v0[1]); w.y = pk2(v0[2], v0[3]); w.z = pk2(v1[0], v1[1]); w.w = pk2(v1[2], v1[3]);
                    *(u32x4*)(rowp + bj * HALF) = w; } }
    }
};
struct EpiGlu {
    static constexpr bool PERM = true, AFTER_DRAIN = false;
    const bf16_t* YG; const bf16_t* Z; const float* bias; bf16_t* O;
    __device__ __forceinline__ void operator()(const f32x4 (&acc)[2][2][4][2], const Unit& u, int wr, int wc, int fr, int fq) const {
        const int row0 = u.pm * BM + wr * 64 + fr; const int col0 = u.pn * BM + wc * 32 + 8 * fq;
#pragma unroll
        for (int bj = 0; bj < 2; ++bj) {
            const f32x4 b0 = *(const f32x4*)(bias + col0 + bj * HALF), b1 = *(const f32x4*)(bias + col0 + bj * HALF + 4);
#pragma unroll
            for (int ai = 0; ai < 2; ++ai)
#pragma unroll
                for (int m = 0; m < 4; ++m) {
                    const size_t off = (size_t)(row0 + ai * HALF + m * 16) * DM + col0 + bj * HALF;
                    const u32x4 yv = *(const u32x4*)(YG + off), zv = *(const u32x4*)(Z + off);
                    const f32x4 v0 = acc[ai][bj][m][0] + b0, v1 = acc[ai][bj][m][1] + b1;
                    float r[8];
#pragma unroll
                    for (int q = 0; q < 4; ++q) {
                        const float a0 = q < 2 ? v0[2 * q] : v1[2 * q - 4], a1 = q < 2 ? v0[2 * q + 1] : v1[2 * q - 3];
                        const float y0 = bflo(yv[q]), y1 = bfhi(yv[q]), z0 = bflo(zv[q]), z1 = bfhi(zv[q]);
                        r[2 * q] = y0 * sigmoidf_(a0) * (z0 * sigmoidf_(z0)); r[2 * q + 1] = y1 * sigmoidf_(a1) * (z1 * sigmoidf_(z1));
                    }
                    u32x4 w; w.x = pk2(r[0], r[1]); w.y = pk2(r[2], r[3]); w.z = pk2(r[4], r[5]); w.w = pk2(r[6], r[7]);
                    *(u32x4*)(O + off) = w;
                }
        }
    }
};
struct EpiRes {
    static constexpr bool PERM = true, AFTER_DRAIN = false;
    const float* base; float* out;
    __device__ __forceinline__ void operator()(const f32x4 (&acc)[2][2][4][2], const Unit& u, int wr, int wc, int fr, int fq) const {
        const int row0 = u.pm * BM + wr * 64 + fr; const int col0 = u.pn * BM + wc * 32 + 8 * fq;
#pragma unroll
        for (int ai = 0; ai < 2; ++ai)
#pragma unroll
            for (int m = 0; m < 4; ++m)
#pragma unroll
                for (int bj = 0; bj < 2; ++bj) {
                    const size_t off = (size_t)(row0 + ai * HALF + m * 16) * DM + col0 + bj * HALF;
                    const f32x4 a0 = *(const f32x4*)(base + off), a1 = *(const f32x4*)(base + off + 4);
                    *(f32x4*)(out + off) = a0 + acc[ai][bj][m][0]; *(f32x4*)(out + off + 4) = a1 + acc[ai][bj][m][1];
                }
    }
};

template <class Epi, class Sched, bool ALIGN_EPI = false, bool SP2 = false>
__device__ __forceinline__ void gemm_phase(LAS unsigned char* lds, const Gemm g, const Sched& S, const Epi& E) {
    const int tid = tid_l(), wid = __builtin_amdgcn_readfirstlane(tid >> 6), lane = tid & 63, wr = wid >> 2, wc = wid & 3, fr = lane & 15, fq = lane >> 4;
    const int K = g.K, nt = K / BK;
    unsigned voffA[2], voffB[2];
#pragma unroll
    for (int i = 0; i < 2; ++i) { int R, C; stage_rc(tid * 16 + i * 8192, R, C); const int Rb = Epi::PERM ? ((R & ~31) + perm32(R & 31)) : R;
        voffA[i] = (unsigned)(R * K + C) * 2u; voffB[i] = (unsigned)(Rb * K + C) * 2u; }
    const size_t kstep = (size_t)(BK * 2);
    const size_t hstep = (size_t)HALF * K * 2;
    const size_t tstep = 2 * hstep;
    const unsigned ldsw = (unsigned)wid * 1024u;
    const int aoff = lds_byte(wr * 64 + fr, fq * 8), boff = lds_byte(wc * 32 + fr, fq * 8);
#define PG8_SA(b, h) (((b) * 2 + (h)) * HTB)
#define PG8_SB(b, h) ((4 + (b) * 2 + (h)) * HTB)
#define PG8_STAGE(bufoff, gbase, voff) do { _Pragma("unroll") for (int _i = 0; _i < 2; ++_i) \
        __builtin_amdgcn_global_load_lds((const unsigned*)((const char*)(gbase) + (voff)[_i]), (LAS unsigned*)(lds + (bufoff) + ldsw + _i * 8192), 16, 0, 0); } while (0)
#define PG8_LDA(dst, b, h) do { _Pragma("unroll") for (int m = 0; m < 4; ++m) _Pragma("unroll") for (int k = 0; k < 2; ++k) dst[m][k] = *(const LAS bf16x8*)(lds + PG8_SA(b, h) + aoff + m * 2048 + k * 1024); } while (0)
#define PG8_LDB(dst, b, h) do { _Pragma("unroll") for (int n = 0; n < 2; ++n) _Pragma("unroll") for (int k = 0; k < 2; ++k) dst[n][k] = *(const LAS bf16x8*)(lds + PG8_SB(b, h) + boff + n * 2048 + k * 1024); } while (0)
#define PG8_MMA(ai, bj, At, Bt) do { __builtin_amdgcn_s_setprio(1); _Pragma("unroll") for (int m = 0; m < 4; ++m) _Pragma("unroll") for (int n = 0; n < 2; ++n) _Pragma("unroll") for (int k = 0; k < 2; ++k) \
        acc[ai][bj][m][n] = __builtin_amdgcn_mfma_f32_16x16x32_bf16(Bt[n][k], At[m][k], acc[ai][bj][m][n], 0, 0, 0); __builtin_amdgcn_s_setprio(0); } while (0)
#define PG8_WAIT_V(n) asm volatile("s_waitcnt vmcnt(" #n ")" ::: "memory")
#define PG8_WAIT_L(n) asm volatile("s_waitcnt lgkmcnt(" #n ")" ::: "memory")
#define PG8_BAR __builtin_amdgcn_s_barrier()
#define PG8_SCHED __builtin_amdgcn_sched_barrier(0)
    Unit cur, nxt; int ui = 0;
    if (!S.next(0, cur)) return;
    f32x4 acc[2][2][4][2];
#pragma unroll
    for (int a = 0; a < 2; ++a)
#pragma unroll
        for (int b = 0; b < 2; ++b)
#pragma unroll
            for (int m = 0; m < 4; ++m)
#pragma unroll
                for (int n = 0; n < 2; ++n) acc[a][b][m][n] = (f32x4){0.f, 0.f, 0.f, 0.f};
    bf16x8 At[4][2], B0[2][2], B1[2][2];
    const char* cA = (const char*)g.A + (size_t)cur.pm * tstep; const char* cB = (const char*)g.Bt + (size_t)cur.pn * tstep;
    S.a_ready(cur);
    if constexpr (SP2) {
        PG8_STAGE(PG8_SB(0, 0), cB, voffB); PG8_STAGE(PG8_SB(0, 1), cB + hstep, voffB); PG8_STAGE(PG8_SA(0, 0), cA, voffA); PG8_STAGE(PG8_SA(0, 1), cA + hstep, voffA);
        if (wr == 1) PG8_BAR;
        PG8_WAIT_V(2); PG8_BAR;
        PG8_STAGE(PG8_SB(1, 0), cB + kstep, voffB); PG8_STAGE(PG8_SA(1, 0), cA + kstep, voffA); PG8_STAGE(PG8_SB(1, 1), cB + hstep + kstep, voffB);
        PG8_WAIT_V(6); PG8_BAR;
    } else {
        PG8_STAGE(PG8_SB(0, 0), cB, voffB); PG8_STAGE(PG8_SA(0, 0), cA, voffA); PG8_STAGE(PG8_SB(0, 1), cB + hstep, voffB); PG8_STAGE(PG8_SA(0, 1), cA + hstep, voffA);
        if (wr == 1) PG8_BAR;
        PG8_WAIT_V(4); PG8_BAR;
        PG8_STAGE(PG8_SB(1, 0), cB + kstep, voffB); PG8_STAGE(PG8_SA(1, 0), cA + kstep, voffA); PG8_STAGE(PG8_SB(1, 1), cB + hstep + kstep, voffB);
        PG8_WAIT_V(6); PG8_BAR;
    }
    for (;;) {
        const bool has_next = S.next(ui + 1, nxt);
        const char* nA = has_next ? (const char*)g.A + (size_t)nxt.pm * tstep : cA; const char* nB = has_next ? (const char*)g.Bt + (size_t)nxt.pn * tstep : cB;
        for (int t = 0; t < nt; t += 2) {
            const bool last = (t == nt - 2);
            const char* a1 = cA + (size_t)(t + 1) * kstep;
            const char* a2 = last ? nA : cA + (size_t)(t + 2) * kstep; const char* b2 = last ? nB : cB + (size_t)(t + 2) * kstep;
            const char* a3 = a2 + kstep; const char* b3 = b2 + kstep;
            if (last && has_next) S.a_ready(nxt);
            if constexpr (SP2) {
            PG8_LDB(B0, 0, 0); PG8_LDB(B1, 0, 1); PG8_SCHED; PG8_LDA(At, 0, 0); PG8_STAGE(PG8_SA(1, 1), a1 + hstep, voffA);
            PG8_WAIT_V(8); PG8_WAIT_L(0); PG8_BAR; PG8_MMA(0, 0, At, B0); PG8_MMA(0, 1, At, B1); PG8_BAR; PG8_SCHED;
            PG8_LDA(At, 0, 1); PG8_STAGE(PG8_SB(0, 0), b2, voffB); PG8_STAGE(PG8_SB(0, 1), b2 + hstep, voffB); PG8_STAGE(PG8_SA(0, 0), a2, voffA);
            PG8_WAIT_V(8); PG8_WAIT_L(0); PG8_BAR; PG8_MMA(1, 0, At, B0); PG8_MMA(1, 1, At, B1); PG8_BAR; PG8_SCHED;
            PG8_LDB(B0, 1, 0); PG8_LDB(B1, 1, 1); PG8_SCHED; PG8_LDA(At, 1, 0); PG8_STAGE(PG8_SA(0, 1), a2 + hstep, voffA);
            PG8_WAIT_V(8); PG8_WAIT_L(0); PG8_BAR; PG8_MMA(0, 0, At, B0); PG8_MMA(0, 1, At, B1); PG8_BAR; PG8_SCHED;
            PG8_LDA(At, 1, 1); PG8_STAGE(PG8_SB(1, 0), b3, voffB); PG8_STAGE(PG8_SB(1, 1), b3 + hstep, voffB); PG8_STAGE(PG8_SA(1, 0), a3, voffA);
            PG8_WAIT_V(8); PG8_WAIT_L(0); PG8_BAR; PG8_MMA(1, 0, At, B0); PG8_MMA(1, 1, At, B1); PG8_BAR; PG8_SCHED;
            } else {
            PG8_LDB(B0, 0, 0); PG8_SCHED; PG8_LDA(At, 0, 0); PG8_STAGE(PG8_SA(1, 1), a1 + hstep, voffA);
            PG8_WAIT_L(8); PG8_BAR; PG8_WAIT_L(0); PG8_MMA(0, 0, At, B0); PG8_BAR; PG8_SCHED;
            PG8_LDB(B1, 0, 1); PG8_STAGE(PG8_SB(0, 0), b2, voffB);
            PG8_BAR; PG8_WAIT_L(0); PG8_MMA(0, 1, At, B1); PG8_BAR;
            PG8_LDA(At, 0, 1); PG8_STAGE(PG8_SA(0, 0), a2, voffA);
            PG8_BAR; PG8_WAIT_L(0); PG8_MMA(1, 0, At, B0); PG8_BAR; PG8_SCHED;
            PG8_STAGE(PG8_SB(0, 1), b2 + hstep, voffB);
            PG8_WAIT_V(6); PG8_BAR; PG8_MMA(1, 1, At, B1); PG8_BAR;
            PG8_LDB(B0, 1, 0); PG8_SCHED; PG8_LDA(At, 1, 0); PG8_STAGE(PG8_SA(0, 1), a2 + hstep, voffA);
            PG8_WAIT_L(8); PG8_BAR; PG8_WAIT_L(0); PG8_MMA(0, 0, At, B0); PG8_BAR; PG8_SCHED;
            PG8_LDB(B1, 1, 1); PG8_STAGE(PG8_SB(1, 0), b3, voffB);
            PG8_BAR; PG8_WAIT_L(0); PG8_MMA(0, 1, At, B1); PG8_BAR;
            PG8_LDA(At, 1, 1); PG8_STAGE(PG8_SA(1, 0), a3, voffA);
            PG8_BAR; PG8_WAIT_L(0); PG8_MMA(1, 0, At, B0); PG8_BAR; PG8_SCHED;
            PG8_STAGE(PG8_SB(1, 1), b3 + hstep, voffB);
            PG8_WAIT_V(6); PG8_BAR; PG8_MMA(1, 1, At, B1); PG8_BAR;
            }
        }
        if constexpr (ALIGN_EPI) { if (wr == 0) PG8_BAR; }
        if constexpr (!Epi::AFTER_DRAIN) { E(acc, cur, wr, wc, fr, fq); S.done(cur); }
        if (!has_next) break;
#pragma unroll
        for (int a = 0; a < 2; ++a)
#pragma unroll
            for (int b = 0; b < 2; ++b)
#pragma unroll
                for (int m = 0; m < 4; ++m)
#pragma unroll
                    for (int n = 0; n < 2; ++n) acc[a][b][m][n] = (f32x4){0.f, 0.f, 0.f, 0.f};
        cur = nxt; cA = nA; cB = nB; ++ui;
        if constexpr (ALIGN_EPI) { if (wr == 1) PG8_BAR; }
    }
    PG8_WAIT_V(0);
    if constexpr (!ALIGN_EPI) { if (wr == 0) PG8_BAR; }
    PG8_BAR;
#undef PG8_SA
#undef PG8_SB
#undef PG8_STAGE
#undef PG8_LDA
#undef PG8_LDB
#undef PG8_MMA
#undef PG8_WAIT_V
#undef PG8_WAIT_L
#undef PG8_BAR
#undef PG8_SCHED
}
}

struct Args { const float* in[18]; float* out; unsigned char* ws; };
typedef const __attribute__((address_space(4))) Args* ArgsP;
__device__ __forceinline__ ArgsP launder(ArgsP p) { asm volatile("" : "+s"(p)); return p; }

#define MFMA16(a, b, c) __builtin_amdgcn_mfma_f32_16x16x32_bf16((a), (b), (c), 0, 0, 0)
#define MFMA32(a, b, c) __builtin_amdgcn_mfma_f32_32x32x16_bf16((a), (b), (c), 0, 0, 0)

__device__ __forceinline__ float wave_sum(float v) {
#pragma unroll
    for (int o = 1; o < 64; o <<= 1) v += __shfl_xor(v, o);
    return v;
}

__device__ __forceinline__ int head_perm(int x) { const int pos = x & 127; return (x & ~127) + (pos & 3) * 32 + (pos >> 2); }
template <int MODE>
__device__ __forceinline__ void transpose_item(const float* W, int K, int N, bf16_t* WT, float* scr, int item, int lane) {
    const int nblk = N / 32, kb = item / nblk, nb = item % nblk, k0 = 64 * kb, n0 = 32 * nb;
#pragma unroll 8
    for (int i = 0; i < 32; ++i) { const int kk = 2 * i + (lane >> 5); int sk = k0 + kk, sn = n0 + (lane & 31);
        if (MODE == 1 && sn >= 3072) sn = head_perm(sn);
        if (MODE == 2) sk = head_perm(sk);
        scr[kk * 33 + (lane & 31)] = W[(size_t)sk * N + sn]; }
    __builtin_amdgcn_wave_barrier(); asm volatile("s_waitcnt lgkmcnt(0)" ::: "memory");
    const int c = lane & 7;
#pragma unroll
    for (int j = 0; j < 4; ++j) { const int n = (lane >> 3) + 8 * j; const float* s = scr + (8 * c) * 33 + n;
        u32x4 o; o.x = pk2(s[0 * 33], s[1 * 33]); o.y = pk2(s[2 * 33], s[3 * 33]); o.z = pk2(s[4 * 33], s[5 * 33]); o.w = pk2(s[6 * 33], s[7 * 33]);
        *(u32x4*)(WT + (size_t)(n0 + n) * K + k0 + 8 * c) = o; }
    asm volatile("s_waitcnt lgkmcnt(0)" ::: "memory"); __builtin_amdgcn_wave_barrier();
}

__device__ __forceinline__ void ssm_tables(ArgsP a, int j, int g, unsigned char* smem, unsigned char* tab) {
    float* Epow = (float*)smem;
    float* Bb = Epow + 17 * 64 * 2;
    float* Cc = Bb + 64 * 16 * 2;
    float* Fp = Cc + 16 * 64 * 2;
    float* Km = Fp + 128;
    const int tid = tid_l();
    const float* a_re = a->in[3] + (size_t)(j * 64 + g) * 64; const float* a_im = a->in[4] + (size_t)(j * 64 + g) * 64;
    const float* b_re = a->in[6] + (size_t)(j * 64 + g) * 64 * 16; const float* b_im = a->in[7] + (size_t)(j * 64 + g) * 64 * 16;
    const float* c_re = a->in[8] + (size_t)(j * 64 + g) * 16 * 64; const float* c_im = a->in[9] + (size_t)(j * 64 + g) * 16 * 64;
    { const float* ep = (const float*)(a->ws + WS_EP) + (size_t)(j * 64 + g) * EP_STRIDE;
      for (int e = tid; e < 17 * 64 * 2; e += 512) Epow[e] = ep[e];
      if (tid < 128) Fp[tid] = ep[18 * 128 + tid]; }
    __syncthreads();
    for (int e = tid; e < 1024; e += 512) {
        { const int p = e >> 4; const float fr_ = Fp[p * 2], fi_ = Fp[p * 2 + 1], br = b_re[e], bi = b_im[e];
          Bb[e * 2] = fr_ * br - fi_ * bi; Bb[e * 2 + 1] = fr_ * bi + fi_ * br; }
        Cc[e * 2] = c_re[e]; Cc[e * 2 + 1] = c_im[e];
    }
    __syncthreads();
    for (int e = tid; e < 4096; e += 512) {
        const int d = e >> 8, c = (e >> 4) & 15, c2 = e & 15; float acc = 0.f;
        for (int p = 0; p < 64; ++p) {
            const float ar = Epow[(d * 64 + p) * 2], ai = Epow[(d * 64 + p) * 2 + 1], br = Bb[(p * 16 + c2) * 2], bi = Bb[(p * 16 + c2) * 2 + 1];
            const float gr = ar * br - ai * bi, gi = ar * bi + ai * br;
            acc += Cc[(c * 64 + p) * 2] * gr - Cc[(c * 64 + p) * 2 + 1] * gi;
        }
        Km[e] = acc;
    }
    __syncthreads();
    for (int e = tid; e < 16 * 64; e += 512) {
        const int d = e >> 6, l = e & 63, c = l & 15, ts = l >> 5, c0 = ((l >> 4) & 1) * 8, dd = d - ts; float v[8];
#pragma unroll
        for (int jj = 0; jj < 8; ++jj) v[jj] = dd >= 0 ? Km[(dd * 16 + c) * 16 + c0 + jj] : 0.f;
        u32x4 w; w.x = pk2(v[0], v[1]); w.y = pk2(v[2], v[3]); w.z = pk2(v[4], v[5]); w.w = pk2(v[6], v[7]);
        *(u32x4*)(tab + d * 1024 + l * 16) = w;
    }
    for (int e = tid; e < 64 * 64; e += 512) {
        const int f = e >> 6, l = e & 63, mt = f >> 3, ks = f & 7, m = mt * 16 + (l & 15), p = m >> 1, ri = m & 1, tau = ks * 2 + (l >> 5), c0 = ((l >> 4) & 1) * 8;
        const float ar = Epow[((15 - tau) * 64 + p) * 2], ai = Epow[((15 - tau) * 64 + p) * 2 + 1]; float v[8];
#pragma unroll
        for (int jj = 0; jj < 8; ++jj) { const float br = Bb[(p * 16 + c0 + jj) * 2], bi = Bb[(p * 16 + c0 + jj) * 2 + 1]; v[jj] = ri == 0 ? (ar * br - ai * bi) : (ar * bi + ai * br); }
        u32x4 w; w.x = pk2(v[0], v[1]); w.y = pk2(v[2], v[3]); w.z = pk2(v[4], v[5]); w.w = pk2(v[6], v[7]);
        *(u32x4*)(tab + 16384 + f * 1024 + l * 16) = w;
    }
    for (int e = tid; e < 64 * 64; e += 512) {
        const int f = e >> 6, l = e & 63, t = f >> 2, kk = f & 3, c = l & 15, m0 = kk * 32 + (l >> 4) * 8; float v[8];
#pragma unroll
        for (int jj = 0; jj < 8; ++jj) { const int m = m0 + jj, p = m >> 1, ri = m & 1;
            const float ar = Epow[((t + 1) * 64 + p) * 2], ai = Epow[((t + 1) * 64 + p) * 2 + 1], cr = Cc[(c * 64 + p) * 2], ci = Cc[(c * 64 + p) * 2 + 1];
            v[jj] = ri == 0 ? (cr * ar - ci * ai) : -(cr * ai + ci * ar); }
        u32x4 w; w.x = pk2(v[0], v[1]); w.y = pk2(v[2], v[3]); w.z = pk2(v[4], v[5]); w.w = pk2(v[6], v[7]);
        *(u32x4*)(tab + 16384 + 65536 + f * 1024 + l * 16) = w;
    }
    __syncthreads();
}

__device__ __forceinline__ void pre0_phase(ArgsP a) {
    const int tid = tid_l(), G = sg_l(gridDim.x), bid = sg_l(blockIdx.x);
    unsigned char* ws = a->ws;
    float* rope = (float*)(ws + WS_ROPE);
    for (int e = bid * 512 + tid; e < L * 16; e += G * 512) {
        const int pos = e >> 4, i = e & 15;
        const double invf = exp(-(double)i * (1.0 / 16.0) * 13.122363377404328);
        double ang = (double)pos * invf; ang -= 6.283185307179586476925 * floor(ang / 6.283185307179586476925);
        rope[e * 2] = (float)cos(ang); rope[e * 2 + 1] = (float)sin(ang);
    }
    float* epb = (float*)(ws + WS_EP);
    for (int e = bid * 512 + tid; e < 2 * 64 * 19 * 64; e += G * 512) {
        const int p = e & 63, n = (e >> 6) % 19, jg = (e >> 6) / 19;
        const double dt = exp((double)a->in[5][jg]);
        const double lr = (double)a->in[3][(size_t)jg * 64 + p], li = (double)a->in[4][(size_t)jg * 64 + p];
        const double pw = n <= 16 ? (double)n : (n == 17 ? 512.0 : 1.0);
        const double mag = exp(lr * dt * pw); double ang = li * dt * pw; ang -= 6.283185307179586476925 * floor(ang / 6.283185307179586476925);
        double cr = cos(ang) * mag, ci = sin(ang) * mag;
        if (n == 18) { const double nr = cr - 1.0, ni = ci, den = lr * lr + li * li; cr = (nr * lr + ni * li) / den; ci = (ni * lr - nr * li) / den; }
        epb[(size_t)jg * EP_STRIDE + (n * 64 + p) * 2] = (float)cr; epb[(size_t)jg * EP_STRIDE + (n * 64 + p) * 2 + 1] = (float)ci;
    }
}
__device__ __forceinline__ void prep_phase(ArgsP a, int layer, const float* h, unsigned char* smem) {
    const int tid = tid_l(), lane = tid & 63, wave = tid >> 6, G = sg_l(gridDim.x), bid = sg_l(blockIdx.x);
    unsigned char* ws = a->ws;
    const int j = layer >> 1;
    if ((layer & 1) == 0) {
        for (int g = bid; g < 64; g += G) ssm_tables(a, j, g, smem, ws + WS_TAB + (size_t)g * TAB_STRIDE);
    }
    __syncthreads();
    float* scr = (float*)(smem + wave * 16384);
    const int gw = bid * 8 + wave, NGW = G * 8;
    bf16_t* Wb = (bf16_t*)(ws + WS_W);
    if ((layer & 1) == 0) {
        const float* w_in = a->in[2] + (size_t)j * 1024 * 2048; const float* w_glu = a->in[11] + (size_t)j * 1024 * 1024; const float* w_out = a->in[13] + (size_t)j * 1024 * 1024;
        for (int it = gw; it < 2048; it += NGW) {
            if (it < 1024) transpose_item<0>(w_in, 1024, 2048, Wb, scr, it, lane);
            else if (it < 1536) transpose_item<0>(w_glu, 1024, 1024, Wb + 2048 * 1024, scr, it - 1024, lane);
            else transpose_item<0>(w_out, 1024, 1024, Wb + 3072 * 1024, scr, it - 1536, lane);
        }
    } else {
        const float* w_in = a->in[14] + (size_t)j * 1024 * 4096; const float* w_out = a->in[17] + (size_t)j * 1024 * 1024;
        for (int it = gw; it < 2560; it += NGW) {
            if (it < 2048) transpose_item<1>(w_in, 1024, 4096, Wb, scr, it, lane);
            else transpose_item<2>(w_out, 1024, 1024, Wb + 4096 * 1024, scr, it - 2048, lane);
        }
    }
    const float* gain = a->in[1] + layer * 1024;
    bf16_t* XN = (bf16_t*)(ws + WS_XN);
    f32x4 gv[4];
#pragma unroll
    for (int q = 0; q < 4; ++q) gv[q] = *(const f32x4*)(gain + 4 * lane + 256 * q);
    for (int m = gw; m < L; m += NGW) {
        const f32x4* xr = (const f32x4*)(h + (size_t)m * DM) + lane;
        f32x4 v[4]; float s = 0.f;
#pragma unroll
        for (int q = 0; q < 4; ++q) { v[q] = xr[64 * q]; s += (v[q].x * v[q].x + v[q].y * v[q].y) + (v[q].z * v[q].z + v[q].w * v[q].w); }
        const float rstd = rsqrtf(wave_sum(s) * (1.f / DM) + NORM_EPS);
        u32x2* o8 = (u32x2*)(XN + (size_t)m * DM) + lane;
#pragma unroll
        for (int q = 0; q < 4; ++q) { u32x2 w; w.x = pk2(v[q].x * rstd * gv[q].x, v[q].y * rstd * gv[q].y); w.y = pk2(v[q].z * rstd * gv[q].z, v[q].w * rstd * gv[q].w); o8[64 * q] = w; }
    }
}

__device__ __forceinline__ void ssm_s1(ArgsP a, unsigned char* smem) {
    const int tid = tid_l(), lane = tid & 63, wave = tid >> 6, G = sg_l(gridDim.x);
    unsigned char* ws = a->ws;
    const bf16_t* U = (const bf16_t*)(ws + WS_U); float* SL = (float*)(ws + WS_SLOC);
    for (int unit = sg_l(blockIdx.x); unit < 256; unit += G) {
        const int g = unit >> 2, qtr = unit & 3;
        __syncthreads();
        { const u32x4* src = (const u32x4*)(ws + WS_TAB + (size_t)g * TAB_STRIDE + 16384); u32x4* dst = (u32x4*)smem;
          for (int e = tid; e < 4096; e += 512) dst[e] = src[e]; }
        __syncthreads();
#pragma unroll 1
        for (int nt = 0; nt < 2; ++nt) {
            const int chunk0 = qtr * 256 + wave * 32 + nt * 16, n = lane & 15;
            bf16x8 B[8];
#pragma unroll
            for (int ks = 0; ks < 8; ++ks) B[ks] = *(const bf16x8*)(U + (size_t)((chunk0 + n) * 16 + ks * 2 + (lane >> 5)) * DM + g * 16 + ((lane >> 4) & 1) * 8);
#pragma unroll
            for (int mt = 0; mt < 8; ++mt) {
                f32x4 acc = {0.f, 0.f, 0.f, 0.f};
#pragma unroll
                for (int ks = 0; ks < 8; ++ks) { const bf16x8 A = *(const bf16x8*)(smem + (mt * 8 + ks) * 1024 + lane * 16); acc = MFMA16(A, B[ks], acc); }
                *(f32x4*)(SL + ((size_t)(chunk0 + n) * 64 + g) * 128 + mt * 16 + (lane >> 4) * 4) = acc;
                asm volatile("" ::: "memory");
            }
        }
    }
}
__device__ __forceinline__ void ssm_s2(ArgsP a, int j, unsigned char* smem) {
    const int tid = tid_l(), G = sg_l(gridDim.x);
    unsigned char* ws = a->ws;
    const float* SL = (const float*)(ws + WS_SLOC); unsigned* SIN = (unsigned*)(ws + WS_SIN);
    float* ex = (float*)smem;
    for (int unit = sg_l(blockIdx.x); unit < 256; unit += G) {
        const int seg = tid >> 4, sl = tid & 15, st = unit * 16 + sl, g = st >> 6, p = st & 63;
        const float* ep = (const float*)(ws + WS_EP) + (size_t)(j * 64 + g) * EP_STRIDE;
        const float e16r = ep[(16 * 64 + p) * 2], e16i = ep[(16 * 64 + p) * 2 + 1], eSr = ep[(17 * 64 + p) * 2], eSi = ep[(17 * 64 + p) * 2 + 1];
        const float* src = SL + ((size_t)(seg * 32) * 64 + g) * 128 + 2 * p;
        f32x2 v[32];
#pragma unroll
        for (int i = 0; i < 32; ++i) v[i] = *(const f32x2*)(src + (size_t)i * 8192);
        float sr = 0.f, si = 0.f;
#pragma unroll
        for (int i = 0; i < 32; ++i) { const float nr = e16r * sr - e16i * si + v[i].x, ni = e16r * si + e16i * sr + v[i].y; sr = nr; si = ni; }
        __syncthreads();
        ex[(seg * 16 + sl) * 2] = sr; ex[(seg * 16 + sl) * 2 + 1] = si;
        __syncthreads();
        float cr = 0.f, ci = 0.f;
        for (int s = 0; s < seg; ++s) { const float xr = ex[(s * 16 + sl) * 2], xi = ex[(s * 16 + sl) * 2 + 1]; const float nr = eSr * cr - eSi * ci + xr, ni = eSr * ci + eSi * cr + xi; cr = nr; ci = ni; }
        unsigned* dst = SIN + ((size_t)(seg * 32) * 64 + g) * 64 + p;
#pragma unroll
        for (int i = 0; i < 32; ++i) {
            dst[(size_t)i * 4096] = pk2(cr, ci);
            const float nr = e16r * cr - e16i * ci + v[i].x, ni = e16r * ci + e16i * cr + v[i].y; cr = nr; ci = ni;
        }
    }
}
__device__ __forceinline__ void ssm_s3(ArgsP a, int j, unsigned char* smem) {
    const int tid = tid_l(), lane = tid & 63, wave = tid >> 6, G = sg_l(gridDim.x);
    unsigned char* ws = a->ws;
    const bf16_t* U = (const bf16_t*)(ws + WS_U); const bf16_t* SIN = (const bf16_t*)(ws + WS_SIN); bf16_t* YG = (bf16_t*)(ws + WS_YG);
    const float* dsk = a->in[10] + j * 1024;
    for (int unit = sg_l(blockIdx.x); unit < 256; unit += G) {
        const int g = unit >> 2, qtr = unit & 3;
        __syncthreads();
        { const u32x4* srcF = (const u32x4*)(ws + WS_TAB + (size_t)g * TAB_STRIDE); u32x4* dst = (u32x4*)smem;
          for (int e = tid; e < 1024; e += 512) dst[e] = srcF[e];
          const u32x4* srcC = (const u32x4*)(ws + WS_TAB + (size_t)g * TAB_STRIDE + 16384 + 65536);
          for (int e = tid; e < 4096; e += 512) dst[1024 + e] = srcC[e]; }
        __syncthreads();
        const unsigned char* Fl = smem; const unsigned char* Wl = smem + 16384;
        const int n = lane & 15, cq = (lane >> 4) * 4;
        const f32x4 dv = *(const f32x4*)(dsk + g * 16 + cq);
#pragma unroll 1
        for (int nt = 0; nt < 2; ++nt) {
            const int chunk = qtr * 256 + wave * 32 + nt * 16 + n;
            bf16x8 Bu[8], Bs[4];
#pragma unroll
            for (int ks = 0; ks < 8; ++ks) Bu[ks] = *(const bf16x8*)(U + (size_t)(chunk * 16 + ks * 2 + (lane >> 5)) * DM + g * 16 + ((lane >> 4) & 1) * 8);
#pragma unroll
            for (int kk = 0; kk < 4; ++kk) Bs[kk] = *(const bf16x8*)(SIN + ((size_t)chunk * 64 + g) * 128 + kk * 32 + (lane >> 4) * 8);
#pragma unroll
            for (int t = 0; t < 16; ++t) {
                f32x4 acc = {0.f, 0.f, 0.f, 0.f};
#pragma unroll
                for (int i = 0; i <= t / 2; ++i) { const bf16x8 A = *(const bf16x8*)(Fl + (t - 2 * i) * 1024 + lane * 16); acc = MFMA16(A, Bu[i], acc); }
#pragma unroll
                for (int kk = 0; kk < 4; ++kk) { const bf16x8 A = *(const bf16x8*)(Wl + (t * 4 + kk) * 1024 + lane * 16); acc = MFMA16(A, Bs[kk], acc); }
                const size_t off = (size_t)(chunk * 16 + t) * DM + g * 16 + cq;
                const u32x2 uv = *(const u32x2*)(U + off);
                const float y0 = gelu_tanh(acc[0] + dv[0] * bflo(uv.x)), y1 = gelu_tanh(acc[1] + dv[1] * bfhi(uv.x));
                const float y2 = gelu_tanh(acc[2] + dv[2] * bflo(uv.y)), y3 = gelu_tanh(acc[3] + dv[3] * bfhi(uv.y));
                u32x2 w; w.x = pk2(y0, y1); w.y = pk2(y2, y3);
                *(u32x2*)(YG + off) = w;
                asm volatile("" ::: "memory");
            }
        }
    }
}

constexpr int QK_STRIDE = 4096;
constexpr int KL_STRIDE = 272, VL_STRIDE = 520, VT_OFF = 256 * KL_STRIDE;

__device__ __forceinline__ void attn_a1(ArgsP a, int j, unsigned char* smem, int dry) {
    const int tid = tid_l(), G = sg_l(gridDim.x);
    unsigned char* ws = a->ws;
    bf16_t* QKVZ = (bf16_t*)(ws + WS_BIG); const float* rope = (const float*)(ws + WS_ROPE); float* kmean = (float*)(ws + WS_KMEAN);
    if (sg_l(blockIdx.x) == 0) ((unsigned*)(ws + WS_CTL))[tid] = 0u;
    const int seg = tid & 15, rg = tid >> 4;
    const float* qg = a->in[15] + j * 128 + seg * 8; const float* kg = a->in[16] + j * 128 + seg * 8;
    float gq[8], gk[8];
#pragma unroll
    for (int i = 0; i < 8; ++i) { gq[i] = qg[i]; gk[i] = kg[i]; }
    float* red = (float*)(smem + 72 * 1024);
    for (int unit = sg_l(blockIdx.x); unit < 512; unit += G) {
        const int h = unit & 7, b = unit >> 3;
        float ksum[8];
#pragma unroll
        for (int i = 0; i < 8; ++i) ksum[i] = 0.f;
        __syncthreads();
        for (int ps = 0; ps < 8; ++ps) {
            const int t = b * 256 + ps * 32 + rg;
            float cs[8], sn[8];
            if (seg < 4) {
#pragma unroll
                for (int i = 0; i < 8; ++i) { const f32x2 r = *(const f32x2*)(rope + ((size_t)t * 16 + (seg & 1) * 8 + i) * 2); cs[i] = r.x; sn[i] = r.y; }
            }
#pragma unroll
            for (int which = 0; which < 2; ++which) {
                bf16_t* p = QKVZ + (size_t)t * QK_STRIDE + which * 1024 + h * 128 + seg * 8;
                const u32x4 raw = *(const u32x4*)p;
                float x[8];
#pragma unroll
                for (int q = 0; q < 4; ++q) { x[2 * q] = bflo(raw[q]); x[2 * q + 1] = bfhi(raw[q]); }
                float ss = 0.f;
#pragma unroll
                for (int i = 0; i < 8; ++i) ss += x[i] * x[i];
                ss += __shfl_xor(ss, 1); ss += __shfl_xor(ss, 2); ss += __shfl_xor(ss, 4); ss += __shfl_xor(ss, 8);
                const float rstd = rsqrtf(ss * (1.f / 128.f) + NORM_EPS);
#pragma unroll
                for (int i = 0; i < 8; ++i) x[i] = x[i] * rstd * (which == 0 ? gq[i] : gk[i]);
                float y[8];
#pragma unroll
                for (int i = 0; i < 8; ++i) {
                    const float o = __shfl_xor(x[i], 2);
                    y[i] = x[i];
                    if (seg < 2) y[i] = x[i] * cs[i] - o * sn[i];
                    else if (seg < 4) y[i] = x[i] * cs[i] + o * sn[i];
                }
                u32x4 w; w.x = pk2(y[0], y[1]); w.y = pk2(y[2], y[3]); w.z = pk2(y[4], y[5]); w.w = pk2(y[6], y[7]);
                if (!dry) *(u32x4*)p = w;
                if (which == 1) {
#pragma unroll
                    for (int i = 0; i < 8; ++i) ksum[i] += y[i];
                }
            }
            { const int key = ps * 32 + rg; const u32x4 raw = *(const u32x4*)(QKVZ + (size_t)t * QK_STRIDE + 2048 + h * 128 + seg * 8);
              *(u32x4*)(smem + key * KL_STRIDE + seg * 16) = raw; }
        }
#pragma unroll
        for (int i = 0; i < 8; ++i) red[rg * 128 + seg * 8 + i] = ksum[i];
        __syncthreads();
        if (tid < 128) { float s = 0.f;
#pragma unroll
            for (int r = 0; r < 32; ++r) s += red[r * 128 + tid];
            if (!dry) kmean[((size_t)h * 64 + b) * 128 + tid] = s * (1.f / 256.f); }
        for (int e = tid; e < 4096; e += 512) {
            const int d = e & 127, ko = e >> 7, key0 = ko * 8;
            unsigned short v[8];
#pragma unroll
            for (int i = 0; i < 8; ++i) v[i] = *(const unsigned short*)(smem + (key0 + i) * KL_STRIDE + d * 2);
            u32x4 w; w.x = v[0] | ((unsigned)v[1] << 16); w.y = v[2] | ((unsigned)v[3] << 16); w.z = v[4] | ((unsigned)v[5] << 16); w.w = v[6] | ((unsigned)v[7] << 16);
            if (!dry) *(u32x4*)(QKVZ + (size_t)(b * 256 + 2 * d + (key0 >> 7)) * QK_STRIDE + 2048 + h * 128 + (key0 & 127)) = w;
        }
    }
}

__device__ __forceinline__ bool gate_better(float v, int i, float w, int k) { return v > w || (v == w && i < k); }
#define TOP3_INSERT(s_, n_) do { const float _s = (s_); const int _n = (n_); \
    const bool _b1 = gate_better(_s, _n, v1, i1), _b2 = gate_better(_s, _n, v2, i2), _b3 = gate_better(_s, _n, v3, i3); \
    const float _nv3 = _b2 ? v2 : (_b3 ? _s : v3); const int _ni3 = _b2 ? i2 : (_b3 ? _n : i3); \
    const float _nv2 = _b1 ? v1 : (_b2 ? _s : v2); const int _ni2 = _b1 ? i1 : (_b2 ? _n : i2); \
    const float _nv1 = _b1 ? _s : v1; const int _ni1 = _b1 ? _n : i1; \
    v1 = _nv1; i1 = _ni1; v2 = _nv2; i2 = _ni2; v3 = _nv3; i3 = _ni3; } while (0)
__device__ __forceinline__ void attn_a2(ArgsP a, unsigned char* smem, int dry) {
    const int tid = tid_l(), lane = tid & 63, wave = tid >> 6, G = sg_l(gridDim.x), r = lane & 31, hh = lane >> 5;
    unsigned char* ws = a->ws;
    const bf16_t* QKVZ = (const bf16_t*)(ws + WS_BIG); const float* kmean = (const float*)(ws + WS_KMEAN);
    unsigned* cnt = (unsigned*)(ws + WS_CTL); unsigned short* lists = (unsigned short*)(ws + WS_TAB);
    unsigned* cntl = (unsigned*)smem; unsigned* basel = cntl + 64;
    int cur_h = -1;
    bf16x8 Khi[2][8], Klo[2][8];
    for (int unit = sg_l(blockIdx.x); unit < 512; unit += G) {
        const int h = unit & 7, b = unit >> 3;
        if (b == 0) continue;
        if (h != cur_h) {
            cur_h = h;
#pragma unroll
            for (int tl = 0; tl < 2; ++tl)
#pragma unroll
                for (int kk = 0; kk < 8; ++kk) {
                    const float* kp = kmean + ((size_t)h * 64 + tl * 32 + r) * 128 + kk * 16 + hh * 8;
                    const f32x4 x0 = *(const f32x4*)kp, x1 = *(const f32x4*)(kp + 4);
                    u32x4 hi; hi.x = pk2(x0[0], x0[1]); hi.y = pk2(x0[2], x0[3]); hi.z = pk2(x1[0], x1[1]); hi.w = pk2(x1[2], x1[3]);
                    u32x4 lo; lo.x = pk2(x0[0] - bflo(hi.x), x0[1] - bfhi(hi.x)); lo.y = pk2(x0[2] - bflo(hi.y), x0[3] - bfhi(hi.y));
                    lo.z = pk2(x1[0] - bflo(hi.z), x1[1] - bfhi(hi.z)); lo.w = pk2(x1[2] - bflo(hi.w), x1[3] - bfhi(hi.w));
                    Khi[tl][kk] = __builtin_bit_cast(bf16x8, hi); Klo[tl][kk] = __builtin_bit_cast(bf16x8, lo);
                }
        }
        const int t = b * 256 + wave * 32 + r;
        bf16x8 qf[8];
#pragma unroll
        for (int kk = 0; kk < 8; ++kk) qf[kk] = *(const bf16x8*)(QKVZ + (size_t)t * QK_STRIDE + h * 128 + kk * 16 + hh * 8);
        float v1 = -INFINITY, v2 = -INFINITY, v3 = -INFINITY; int i1 = 1 << 20, i2 = 1 << 20, i3 = 1 << 20;
#pragma unroll
        for (int tl = 0; tl < 2; ++tl) {
            if (tl == 1 && b <= 32) break;
            f32x16 Gt;
#pragma unroll
            for (int i = 0; i < 16; ++i) Gt[i] = 0.f;
#pragma unroll
            for (int kk = 0; kk < 8; ++kk) { Gt = MFMA32(Khi[tl][kk], qf[kk], Gt); Gt = MFMA32(Klo[tl][kk], qf[kk], Gt); }
#pragma unroll
            for (int i = 0; i < 16; ++i) { const int n = tl * 32 + (i & 3) + 8 * (i >> 2) + 4 * hh; if (n < b) TOP3_INSERT(Gt[i], n); }
        }
        {
            const float w1 = __shfl_xor(v1, 32), w2 = __shfl_xor(v2, 32), w3 = __shfl_xor(v3, 32);
            const int k1 = __shfl_xor(i1, 32), k2 = __shfl_xor(i2, 32), k3 = __shfl_xor(i3, 32);
            TOP3_INSERT(w1, k1); TOP3_INSERT(w2, k2); TOP3_INSERT(w3, k3);
        }
        __syncthreads();
        if (tid < 64) cntl[tid] = 0u;
        __syncthreads();
        unsigned lp1 = 0u, lp2 = 0u, lp3 = 0u;
        if (hh == 0) {
            if (i1 < 64) lp1 = atomicAdd(&cntl[i1], 1u);
            if (i2 < 64) lp2 = atomicAdd(&cntl[i2], 1u);
            if (i3 < 64) lp3 = atomicAdd(&cntl[i3], 1u);
        }
        __syncthreads();
        if (tid < 64) { const unsigned c = cntl[tid]; basel[tid] = (c && !dry) ? atomicAdd(&cnt[h * 64 + tid], c) : 0u; }
        __syncthreads();
        if (hh == 0 && !dry) {
            unsigned short* lh = lists + (size_t)h * LIST_PER_HEAD;
            if (i1 < 64) lh[list_off(i1) + basel[i1] + lp1] = (unsigned short)(t);
            if (i2 < 64) lh[list_off(i2) + basel[i2] + lp2] = (unsigned short)(t | (1 << 14));
            if (i3 < 64) lh[list_off(i3) + basel[i3] + lp3] = (unsigned short)(t | (2 << 14));
        }
    }
}

__device__ __forceinline__ void load_kv(const bf16_t* QKVZ, int h, int n, unsigned char* smem) {
    const int tid = tid_l();
    for (int e = tid; e < 4096; e += 512) {
        const int key = e >> 4, pc = e & 15;
        *(u32x4*)(smem + key * KL_STRIDE + pc * 16) = *(const u32x4*)(QKVZ + (size_t)(n * 256 + key) * QK_STRIDE + 1024 + h * 128 + pc * 8);
    }
    for (int e = tid; e < 4096; e += 512) {
        const int d = e >> 5, pc = e & 31, key0 = pc * 8;
        const u32x4 v = *(const u32x4*)(QKVZ + (size_t)(n * 256 + 2 * d + (key0 >> 7)) * QK_STRIDE + 2048 + h * 128 + (key0 & 127));
        u32x2* dst = (u32x2*)(smem + VT_OFF + d * VL_STRIDE + pc * 16);
        dst[0] = (u32x2){v.x, v.y}; dst[1] = (u32x2){v.z, v.w};
    }
}
__device__ __forceinline__ void attn_core(const unsigned char* smem, const bf16x8 (&qf)[8], int nkt, int mask_kt, int qidx, float c1, float c2, f32x16 (&O)[4], float& lsum) {
    const int lane = tid_l() & 63, r = lane & 31, hh = lane >> 5;
    for (int kt = 0; kt < nkt; ++kt) {
        f32x16 S;
#pragma unroll
        for (int i = 0; i < 16; ++i) S[i] = 0.f;
#pragma unroll
        for (int kk = 0; kk < 8; ++kk) { const bf16x8 A = *(const bf16x8*)(smem + (kt * 32 + r) * KL_STRIDE + (kk * 16 + hh * 8) * 2); S = MFMA32(A, qf[kk], S); }
        float p[16];
#pragma unroll
        for (int i = 0; i < 16; ++i) { p[i] = exp2f(S[i] * c1 - c2);
            if (kt == mask_kt) { const int key = kt * 32 + (i & 3) + 8 * (i >> 2) + 4 * hh; if (key > qidx) p[i] = 0.f; }
            lsum += p[i]; }
#pragma unroll
        for (int s = 0; s < 2; ++s) {
            u32x4 pw; pw.x = pk2(p[8 * s], p[8 * s + 1]); pw.y = pk2(p[8 * s + 2], p[8 * s + 3]); pw.z = pk2(p[8 * s + 4], p[8 * s + 5]); pw.w = pk2(p[8 * s + 6], p[8 * s + 7]);
            const bf16x8 pa = __builtin_bit_cast(bf16x8, pw);
#pragma unroll
            for (int dt = 0; dt < 4; ++dt) {
                const unsigned char* vp = smem + VT_OFF + (dt * 32 + r) * VL_STRIDE + (kt * 32 + 16 * s + 4 * hh) * 2;
                const s16x4 lo = *(const s16x4*)vp, hi = *(const s16x4*)(vp + 16);
                const bf16x8 Bv = __builtin_shufflevector(lo, hi, 0, 1, 2, 3, 4, 5, 6, 7);
                O[dt] = MFMA32(pa, Bv, O[dt]);
            }
        }
    }
}
__device__ __forceinline__ float attn_ref(ArgsP a, int j) {
    const int lane = tid_l() & 63;
    float mq = fmaxf(fabsf(a->in[15][j * 128 + lane]), fabsf(a->in[15][j * 128 + 64 + lane]));
    float mk = fmaxf(fabsf(a->in[16][j * 128 + lane]), fabsf(a->in[16][j * 128 + 64 + lane]));
#pragma unroll
    for (int o = 1; o < 64; o <<= 1) { mq = fmaxf(mq, __shfl_xor(mq, o)); mk = fmaxf(mk, __shfl_xor(mk, o)); }
    return 11.313708499f * mq * mk;
}
constexpr int LDS_LQ = 141312;

__device__ __forceinline__ void attn_a3(ArgsP a, int j, unsigned char* smem) {
    const int tid = tid_l(), lane = tid & 63, wave = tid >> 6, G = sg_l(gridDim.x), r = lane & 31, hh = lane >> 5;
    unsigned char* ws = a->ws;
    const bf16_t* QKVZ = (const bf16_t*)(ws + WS_BIG);
    const unsigned* cnt = (const unsigned*)(ws + WS_CTL); const unsigned short* lists = (const unsigned short*)(ws + WS_TAB);
    float* lpart = (float*)(ws + WS_LPART);
    int* pre = (int*)(smem + 140 * 1024);
    const float ref = attn_ref(a, j), c1 = 0.08838834764831845f * 1.4426950408889634f, c2 = ref * 1.4426950408889634f;
    __syncthreads();
    { const int c = (int)cnt[tid]; pre[tid] = (c + 255) >> 8; }
    __syncthreads();
    for (int o = 1; o < 512; o <<= 1) { const int v = pre[tid] + (tid >= o ? pre[tid - o] : 0); __syncthreads(); pre[tid] = v; __syncthreads(); }
    const int total = pre[511]; const int bidx = sg_l(blockIdx.x);
    const int t_lo = (int)(((long)total * bidx) / G), t_hi = (int)(((long)total * (bidx + 1)) / G);
    int cur_pr = -1;
    int e_cur = -1; bf16x8 qf[8];
    auto tile_info = [&](int tile, int& pr, int& tl) { int lo = 0, hi = 511; while (lo < hi) { const int mid = (lo + hi) >> 1; if (pre[mid] > tile) hi = mid; else lo = mid + 1; } pr = lo; tl = tile - (pr ? pre[pr - 1] : 0); };
    auto load_entry = [&](int tile) -> int { int pr, tl; tile_info(tile, pr, tl); const int h = pr >> 6, n = pr & 63, c = (int)cnt[pr]; const int li = tl * 256 + wave * 32 + r; const bool valid = li < c;
        const unsigned e = lists[(size_t)h * LIST_PER_HEAD + list_off(n) + (valid ? li : 0)]; return (int)e | (valid ? 0x10000 : 0); };
    if (t_lo < t_hi) { e_cur = load_entry(t_lo); int pr, tl; tile_info(t_lo, pr, tl); const int h = pr >> 6;
#pragma unroll
        for (int kk = 0; kk < 8; ++kk) qf[kk] = *(const bf16x8*)(QKVZ + (size_t)(e_cur & 0x3fff) * QK_STRIDE + h * 128 + kk * 16 + hh * 8); }
    for (int tile = t_lo; tile < t_hi; ++tile) {
        int pr, tl; tile_info(tile, pr, tl);
        const int h = pr >> 6, n = pr & 63;
        if (pr != cur_pr) { __syncthreads(); load_kv(QKVZ, h, n, smem); __syncthreads(); cur_pr = pr; }
        int e_nxt = -1; bf16x8 qn[8];
        if (tile + 1 < t_hi) { e_nxt = load_entry(tile + 1); int pr2, tl2; tile_info(tile + 1, pr2, tl2); const int h2 = pr2 >> 6;
#pragma unroll
            for (int kk = 0; kk < 8; ++kk) qn[kk] = *(const bf16x8*)(QKVZ + (size_t)(e_nxt & 0x3fff) * QK_STRIDE + h2 * 128 + kk * 16 + hh * 8); }
        else {
#pragma unroll
            for (int kk = 0; kk < 8; ++kk) qn[kk] = qf[kk];
        }
        f32x16 O[4];
#pragma unroll
        for (int dt = 0; dt < 4; ++dt)
#pragma unroll
            for (int i = 0; i < 16; ++i) O[dt][i] = 0.f;
        float lsum = 0.f;
        attn_core(smem, qf, 8, -1, 0, c1, c2, O, lsum);
        lsum += __shfl_xor(lsum, 32);
        if (hh == 0 && (e_cur & 0x10000)) lpart[((size_t)((e_cur >> 14) & 3) * L + (e_cur & 0x3fff)) * 8 + h] = lsum;
#pragma unroll
        for (int i = 0; i < 16; ++i) {
            const int ei = __shfl(e_cur, (i & 3) + 8 * (i >> 2) + 4 * hh);
            if (ei & 0x10000) {
                const int slot = (ei >> 14) & 3, ti = ei & 0x3fff;
                bf16_t* P = (bf16_t*)(ws + (slot == 0 ? WS_XN : (slot == 1 ? WS_P1 : WS_P2))) + (size_t)ti * DM + h * 128 + r * 4;
                u32x2 w; w.x = pk2(O[0][i], O[1][i]); w.y = pk2(O[2][i], O[3][i]);
                *(u32x2*)P = w;
            }
        }
        e_cur = e_nxt;
#pragma unroll
        for (int kk = 0; kk < 8; ++kk) qf[kk] = qn[kk];
    }
}
__device__ __forceinline__ void attn_a4(ArgsP a, int j, unsigned char* smem, int dry) {
    const int tid = tid_l(), lane = tid & 63, wave = tid >> 6, G = sg_l(gridDim.x), r = lane & 31, hh = lane >> 5;
    unsigned char* ws = a->ws;
    const bf16_t* QKVZ = (const bf16_t*)(ws + WS_BIG); const float* lpart = (const float*)(ws + WS_LPART);
    const float ref = attn_ref(a, j), c1 = 0.08838834764831845f * 1.4426950408889634f, c2 = ref * 1.4426950408889634f;
    float* lq = (float*)(smem + LDS_LQ) + wave * 32;
    const int qt = wave < 4 ? wave : 11 - wave;
    for (int unit = sg_l(blockIdx.x); unit < 512; unit += G) {
        const int h = unit & 7, b = unit >> 3;
        __syncthreads(); load_kv(QKVZ, h, b, smem); __syncthreads();
        const int qidx = qt * 32 + r, t = b * 256 + qidx;
        bf16x8 qf[8];
#pragma unroll
        for (int kk = 0; kk < 8; ++kk) qf[kk] = *(const bf16x8*)(QKVZ + (size_t)t * QK_STRIDE + h * 128 + kk * 16 + hh * 8);
        f32x16 O[4];
#pragma unroll
        for (int dt = 0; dt < 4; ++dt)
#pragma unroll
            for (int i = 0; i < 16; ++i) O[dt][i] = 0.f;
        float lsum = 0.f;
        attn_core(smem, qf, qt + 1, qt, qidx, c1, c2, O, lsum);
        lsum += __shfl_xor(lsum, 32);
        const int nsel = b < 3 ? b : 3;
        for (int s = 0; s < nsel; ++s) lsum += lpart[((size_t)s * L + t) * 8 + h];
        if (hh == 0) lq[r] = 1.0f / lsum;
        __builtin_amdgcn_wave_barrier(); asm volatile("s_waitcnt lgkmcnt(0)" ::: "memory");
#pragma unroll
        for (int i = 0; i < 16; ++i) {
            const int qi = (i & 3) + 8 * (i >> 2) + 4 * hh; const size_t ti = (size_t)(b * 256 + qt * 32 + qi);
            const float inv = lq[qi];
            float o0 = O[0][i], o1 = O[1][i], o2 = O[2][i], o3 = O[3][i];
            for (int s = 0; s < nsel; ++s) {
                const u32x2 pv = *(const u32x2*)((const bf16_t*)(ws + (s == 0 ? WS_XN : (s == 1 ? WS_P1 : WS_P2))) + ti * DM + h * 128 + r * 4);
                o0 += bflo(pv.x); o1 += bfhi(pv.x); o2 += bflo(pv.y); o3 += bfhi(pv.y);
            }
            const u32x2 zv = *(const u32x2*)(QKVZ + ti * QK_STRIDE + 3072 + h * 128 + r * 4);
            const float z0 = bflo(zv.x), z1 = bfhi(zv.x), z2 = bflo(zv.y), z3 = bfhi(zv.y);
            u32x2 w; w.x = pk2(o0 * inv * z0 * sigmoidf_(z0), o1 * inv * z1 * sigmoidf_(z1)); w.y = pk2(o2 * inv * z2 * sigmoidf_(z2), o3 * inv * z3 * sigmoidf_(z3));
            if (!dry) *(u32x2*)((bf16_t*)(ws + WS_XN) + ti * DM + h * 128 + r * 4) = w;
        }
        __builtin_amdgcn_wave_barrier();
    }
}

#define XB_TMO      128
#define XB_XCNT(j)  (256  + 64 * (j))
#define XB_XSUB(j)  (1280 + 64 * (j))
#define XB_XGEN(j)  (2304 + 64 * (j))
#define XB_TOP      3328
#define XB_TOPGEN   3392
#define XCD_BAR_WORDS 3456
#define XB_SPIN_CAP (1u << 22)
__device__ __forceinline__ unsigned xb_ld(unsigned* p)              { return __hip_atomic_load(p, __ATOMIC_RELAXED, __HIP_MEMORY_SCOPE_AGENT); }
__device__ __forceinline__ unsigned xb_add(unsigned* p, unsigned v) { return __hip_atomic_fetch_add(p, v, __ATOMIC_RELAXED, __HIP_MEMORY_SCOPE_AGENT); }
__device__ __forceinline__ unsigned xb_xcc_id() { return (unsigned)__builtin_amdgcn_s_getreg((3 << 11) | 20) & 0xFu; }
#define XB_SPIN(cond, bar) do { unsigned _sp = 0; while (cond) { __builtin_amdgcn_s_sleep(1); \
    if ((++_sp & 255u) == 0u) { if (xb_ld(&(bar)[XB_TMO])) break; if (_sp > XB_SPIN_CAP) { atomicAdd(&(bar)[XB_TMO], 1u); break; } } } } while (0)
struct XcdBarrier { unsigned* bar; unsigned x; volatile LAS unsigned* st; };
__device__ __forceinline__ XcdBarrier xcd_barrier_post(unsigned* bar, volatile LAS unsigned* st) {
    XcdBarrier b; b.bar = bar; b.x = xb_xcc_id(); b.st = st;
    if (threadIdx.x == 0) (void)xb_add(&bar[XB_XCNT(b.x)], 1u);
    return b;
}
__device__ __forceinline__ void xcd_barrier_complete(unsigned* bar, unsigned x, unsigned& nloc, unsigned& nx) {
    const unsigned G = gridDim.x * gridDim.y * gridDim.z;
    unsigned sum, cnt, mine, sp = 0u;
    for (;;) {
        sum = 0u; cnt = 0u; mine = 0u;
#pragma unroll
        for (unsigned j = 0; j < 16; ++j) { const unsigned c = xb_ld(&bar[XB_XCNT(j)]); sum += c; cnt += (c > 0u) ? 1u : 0u; mine = (j == x) ? c : mine; }
        if (sum == G) break;
        __builtin_amdgcn_s_sleep(1);
        if ((++sp & 255u) == 0u) { if (xb_ld(&bar[XB_TMO])) break; if (sp > XB_SPIN_CAP) { atomicAdd(&bar[XB_TMO], 1u); break; } }
    }
    nloc = mine > 0u ? mine : 1u; nx = cnt > 0u ? cnt : 1u;
}
__device__ __forceinline__ void xcd_barrier(const XcdBarrier& b) {
    asm volatile("s_waitcnt vmcnt(0)" ::: "memory");
    __syncthreads();
    if (threadIdx.x == 0) {
        unsigned* bar = b.bar;
        __builtin_amdgcn_s_waitcnt(0);
        unsigned nloc = b.st[0], nx = b.st[1];
        if (nloc == 0u) { xcd_barrier_complete(bar, b.x, nloc, nx); b.st[0] = nloc; b.st[1] = nx; }
        const unsigned old = xb_add(&bar[XB_XSUB(b.x)], 1u);
        const unsigned gen = old / nloc;
        if (old + 1u == (gen + 1u) * nloc) {
            __builtin_amdgcn_fence(__ATOMIC_RELEASE, "agent");
            asm volatile("s_waitcnt vmcnt(0)" ::: "memory");
            const unsigned og = xb_add(&bar[XB_TOP], 1u);
            const unsigned tg = og / nx;
            if (og + 1u == (tg + 1u) * nx) xb_add(&bar[XB_TOPGEN], 1u);
            else XB_SPIN(xb_ld(&bar[XB_TOPGEN]) == tg, bar);
            __builtin_amdgcn_fence(__ATOMIC_ACQUIRE, "agent");
            xb_add(&bar[XB_XGEN(b.x)], 1u);
            asm volatile("s_waitcnt vmcnt(0)" ::: "memory");
        } else {
            XB_SPIN(xb_ld(&bar[XB_XGEN(b.x)]) == gen, bar);
            __builtin_amdgcn_fence(__ATOMIC_ACQUIRE, "agent");
            asm volatile("s_waitcnt vmcnt(0)" ::: "memory");
        }
    }
    __syncthreads();
}
#ifndef PH_MASK
#define PH_MASK 0xFFFF
#endif
#define PH(b) ((PH_MASK >> (b)) & 1)
#ifndef REP_MASK
#define REP_MASK 0
#endif
#ifndef XSYNC
#define XSYNC 0
#endif
#define REP(b) for (int _r = 0; _r < 1 + ((REP_MASK >> (b)) & 1); ++_r)
__global__ void __launch_bounds__(512, 2) hybrid_fwd(Args a_unused) {
    extern __shared__ __attribute__((aligned(16))) unsigned char smem[];
    cg::grid_group grid = cg::this_grid();
    LAS unsigned char* lds = (LAS unsigned char*)smem;
    const ArgsP ap = (ArgsP)__builtin_amdgcn_kernarg_segment_ptr();
    if (threadIdx.x < 2) ((volatile LAS unsigned*)(lds + LDS_BARST))[threadIdx.x] = 0u;
    __syncthreads();
    const XcdBarrier xbar = xcd_barrier_post((unsigned*)(ap->ws + WS_BAR), (volatile LAS unsigned*)(lds + LDS_BARST));

#define a launder(ap)
#define ws (launder(ap)->ws)
#define Wb ((bf16_t*)(ws + WS_W))
#define XN ((bf16_t*)(ws + WS_XN))
    REP(0) if (PH(0)) pre0_phase(a);
    grid.sync();
    for (int _x = 0; _x < XSYNC; ++_x) xcd_barrier(xbar);
    REP(0) if (PH(0)) prep_phase(a, 0, a->in[0], smem);
    xcd_barrier(xbar);
#pragma unroll 1
    for (int layer = 0; layer < 4; ++layer) {
        const int j = layer >> 1;
        if ((layer & 1) == 0) {
            REP(1) if (PH(1)) { pg8::Gemm g{XN, Wb, L, 2048, 1024}; pg8::StaticOrder S; S.init(L, 2048, sg_l(gridDim.x), sg_l(blockIdx.x));
              pg8::EpiStore E{(bf16_t*)(ws + WS_U), 1024, 1024, (size_t)(WS_Z - WS_U) / 2};
              pg8::gemm_phase<pg8::EpiStore, pg8::StaticOrder, true, true>(lds, g, S, E); }
            xcd_barrier(xbar);
            REP(2) if (PH(2)) ssm_s1(a, smem);
            xcd_barrier(xbar);
            REP(3) if (PH(3)) ssm_s2(a, j, smem);
            xcd_barrier(xbar);
            REP(4) if (PH(4)) ssm_s3(a, j, smem);
            xcd_barrier(xbar);
            REP(5) if (PH(5)) { pg8::Gemm g{(const bf16_t*)(ws + WS_YG), Wb + 2048 * 1024, L, 1024, 1024}; pg8::StaticOrder S; S.init(L, 1024, sg_l(gridDim.x), sg_l(blockIdx.x));
              pg8::EpiGlu E{(const bf16_t*)(ws + WS_YG), (const bf16_t*)(ws + WS_Z), a->in[12] + j * 1024, (bf16_t*)(ws + WS_Y2)};
              pg8::gemm_phase<pg8::EpiGlu, pg8::StaticOrder, true, true>(lds, g, S, E); }
            xcd_barrier(xbar);
            REP(6) if (PH(6)) { pg8::Gemm g{(const bf16_t*)(ws + WS_Y2), Wb + 3072 * 1024, L, 1024, 1024}; pg8::StaticOrder S; S.init(L, 1024, sg_l(gridDim.x), sg_l(blockIdx.x));
              pg8::EpiRes E{layer == 0 ? a->in[0] : (const float*)a->out, a->out};
              pg8::gemm_phase<pg8::EpiRes, pg8::StaticOrder, true, true>(lds, g, S, E); }
            xcd_barrier(xbar);
        } else {
            REP(7) if (PH(7)) { pg8::Gemm g{XN, Wb, L, 4096, 1024}; pg8::StaticOrder S; S.init(L, 4096, sg_l(gridDim.x), sg_l(blockIdx.x));
              pg8::EpiStore E{(bf16_t*)(ws + WS_BIG), 4096, 0, 0};
              pg8::gemm_phase<pg8::EpiStore, pg8::StaticOrder, true, true>(lds, g, S, E); }
            xcd_barrier(xbar);
            REP(8) if (PH(8)) attn_a1(a, j, smem, sg_l(_r == 0 && ((REP_MASK >> 8) & 1)));
            xcd_barrier(xbar);
            REP(9) if (PH(9)) attn_a2(a, smem, sg_l(_r == 0 && ((REP_MASK >> 9) & 1)));
            xcd_barrier(xbar);
            REP(10) if (PH(10)) attn_a3(a, j, smem);
            xcd_barrier(xbar);
            REP(11) if (PH(11)) attn_a4(a, j, smem, sg_l(_r == 0 && ((REP_MASK >> 11) & 1)));
            xcd_barrier(xbar);
            REP(12) if (PH(12)) { pg8::Gemm g{XN, Wb + 4096 * 1024, L, 1024, 1024}; pg8::StaticOrder S; S.init(L, 1024, sg_l(gridDim.x), sg_l(blockIdx.x));
              pg8::EpiRes E{layer == 0 ? a->in[0] : (const float*)a->out, a->out};
              pg8::gemm_phase<pg8::EpiRes, pg8::StaticOrder, true, true>(lds, g, S, E); }
            xcd_barrier(xbar);
        }
        if (layer < 3) { REP(13) if (PH(13)) prep_phase(a, layer + 1, a->out, smem); xcd_barrier(xbar); }
    }
}

#undef a
#undef ws
#undef Wb
#undef XN
extern "C" void kernel_launch(void* const* d_in, const int* in_sizes, int n_in, void* d_out, int out_size, void* d_ws, size_t ws_size, hipStream_t stream) {
    static int grid = 0;
    if (grid == 0) {
        if (n_in != 18 || out_size != L * DM || ws_size < WS_END) { fprintf(stderr, "kernel_launch: unexpected shapes (n_in %d, out %d, ws %zu)\n", n_in, out_size, ws_size); grid = -1; return; }
        int dev = 0, cus = 0, per_cu = 0;
        hipGetDevice(&dev); hipDeviceGetAttribute(&cus, hipDeviceAttributeMultiprocessorCount, dev);
        hipFuncSetAttribute((const void*)hybrid_fwd, hipFuncAttributeMaxDynamicSharedMemorySize, LDS_BYTES);
        hipOccupancyMaxActiveBlocksPerMultiprocessor(&per_cu, (const void*)hybrid_fwd, 512, LDS_BYTES);
        if (per_cu < 1) { fprintf(stderr, "kernel_launch: occupancy query says %d blocks per CU\n", per_cu); per_cu = 1; }
        grid = cus * 1;
        if (grid > 256) grid = 256;
    }
    if (grid < 0) return;
    Args a{};
    for (int i = 0; i < 18; ++i) a.in[i] = (const float*)d_in[i];
    a.out = (float*)d_out; a.ws = (unsigned char*)d_ws;
    hipMemsetAsync((char*)d_ws + WS_BAR, 0, 16 * 1024, stream);
    void* args[] = {&a};
    hipError_t e = hipLaunchCooperativeKernel((const void*)hybrid_fwd, dim3(grid), dim3(512), args, LDS_BYTES, stream);
    if (e != hipSuccess) fprintf(stderr, "cooperative launch failed: %s (grid %d)\n", hipGetErrorString(e), grid);
}
```

```cpp
#include <hip/hip_runtime.h>
#include <hip/hip_cooperative_groups.h>
#include <cstdio>
#include <cstdint>
namespace cg = cooperative_groups;

#define LAS __attribute__((address_space(3)))
typedef unsigned short bf16_t;
typedef short bf16x8 __attribute__((ext_vector_type(8)));
typedef short s16x4 __attribute__((ext_vector_type(4)));
typedef float f32x2 __attribute__((ext_vector_type(2)));
typedef float f32x4 __attribute__((ext_vector_type(4)));
typedef float f32x16 __attribute__((ext_vector_type(16)));
typedef unsigned u32x2 __attribute__((ext_vector_type(2)));
typedef unsigned u32x4 __attribute__((ext_vector_type(4)));
typedef __bf16 bf16v2 __attribute__((ext_vector_type(2)));

__device__ __forceinline__ unsigned pk2(float lo, float hi) { f32x2 v = {lo, hi}; bf16v2 b = __builtin_convertvector(v, bf16v2); return __builtin_bit_cast(unsigned, b); }
__device__ __forceinline__ float bflo(unsigned w) { return __uint_as_float(w << 16); }
__device__ __forceinline__ float bfhi(unsigned w) { return __uint_as_float(w & 0xffff0000u); }
__device__ __forceinline__ float sigmoidf_(float x) { return 1.0f / (1.0f + __expf(-x)); }
__device__ __forceinline__ float gelu_tanh(float y) { const float t = 0.7978845608028654f * (y + 0.044715f * y * y * y); const float e = __expf(2.0f * t); const float th = 1.0f - 2.0f / (e + 1.0f); return 0.5f * y * (1.0f + th); }

__device__ __forceinline__ int tid_l() { int t = threadIdx.x; asm volatile("" : "+v"(t)); return t; }
__device__ __forceinline__ int sg_l(int v) { v = __builtin_amdgcn_readfirstlane(v); asm volatile("" : "+s"(v)); return v; }
constexpr int L = 16384, DM = 1024, NH = 8, HD = 128, NBLK = 64;
constexpr size_t MiB = 1u << 20;
constexpr size_t WS_CTL = 0, WS_BAR = 16 * 1024, WS_KMEAN = 256 * 1024, WS_ROWSQ = 512 * 1024;
constexpr int LDS_BARST = 146432;
constexpr size_t WS_W = 1 * MiB, WS_TAB = 11 * MiB, WS_XN = 21 * MiB, WS_BIG = 53 * MiB;
constexpr size_t WS_U = WS_BIG, WS_Z = WS_BIG + 32 * MiB, WS_YG = WS_BIG + 64 * MiB, WS_Y2 = WS_BIG + 96 * MiB;
constexpr size_t WS_P1 = 181 * MiB, WS_P2 = 213 * MiB, WS_SLOC = 181 * MiB, WS_SIN = 213 * MiB;
constexpr size_t WS_LPART = 245 * MiB, WS_ROPE = 247 * MiB, WS_EP = 249 * MiB, WS_END = 251 * MiB;
constexpr int EP_STRIDE = 19 * 64 * 2;
constexpr int TAB_STRIDE = 147456;
constexpr int LIST_PER_HEAD = 516096;
__host__ __device__ __forceinline__ int list_off(int n) { return 16128 * n - 128 * n * (n - 1); }
constexpr int LDS_BYTES = 147456;
constexpr float NORM_EPS = 1e-6f;

namespace pg8 {
constexpr int BM = 256, BK = 64, HALF = 128, HTB = HALF * BK * 2, STAGE_BYTES = 8 * HTB, NXCD = 8, WGM = 8;
__host__ __device__ __forceinline__ int lds_byte(int r, int c) { const int st = (r >> 4) * 2 + (c >> 5), rr = r & 15, cc = c & 31, ob = rr * 64 + cc * 2; return st * 1024 + (ob ^ (((ob >> 9) & 1) << 5)); }
__host__ __device__ __forceinline__ void stage_rc(int b, int& R, int& C) { const int st = b / 1024, sb = b % 1024, swz = sb ^ (((sb >> 9) & 1) << 5); R = (st >> 1) * 16 + swz / 64; C = (st & 1) * 32 + (swz % 64) / 2; }
__host__ __device__ __forceinline__ int perm32(int rho) { const int n = rho >> 4, i = rho & 15; return 8 * (i >> 2) + 4 * n + (i & 3); }
struct Unit { int pm, pn; };
struct Gemm { const bf16_t* A; const bf16_t* Bt; int M, N, K; };
struct StaticOrder {
    int nM, nN, nwg, G, c;
    __host__ __device__ void init(int M, int N, int G_, int c_) { nM = M / BM; nN = N / BM; nwg = nM * nN; G = G_; c = c_; }
    __host__ __device__ bool next(int i, Unit& u) const {
        const long Lx = (long)i * G + c; if (Lx >= nwg) return false;
        int wgid = (int)Lx; { const int q = nwg / NXCD, r = nwg % NXCD, xcd = wgid % NXCD, off = wgid / NXCD; wgid = (xcd < r ? xcd * (q + 1) : r * (q + 1) + (xcd - r) * q) + off; }
        const int nig = WGM * nN, gid = wgid / nig, fm = gid * WGM, gsz = (nM - fm) < WGM ? (nM - fm) : WGM;
        u.pm = fm + ((wgid % nig) % gsz); u.pn = (wgid % nig) / gsz; return true;
    }
    __device__ __forceinline__ void a_ready(const Unit&) const {}
    __device__ __forceinline__ void done(const Unit&) const {}
};

struct EpiStore {
    static constexpr bool PERM = true, AFTER_DRAIN = false;
    bf16_t* O; int ldc; int split_cols; size_t split_stride; const float* rowsq;
    __device__ __forceinline__ void operator()(const f32x4 (&acc)[2][2][4][2], const Unit& u, int wr, int wc, int fr, int fq) const {
        const int row0 = u.pm * BM + wr * 64 + fr; int colt = u.pn * BM; bf16_t* base = O;
        if (split_cols) { const int t = colt / split_cols; base += (size_t)t * split_stride; colt -= t * split_cols; }
        const int col0 = colt + wc * 32 + 8 * fq;
#pragma unroll
        for (int ai = 0; ai < 2; ++ai)
#pragma unroll
            for (int m = 0; m < 4; ++m) { bf16_t* rowp = base + (size_t)(row0 + ai * HALF + m * 16) * ldc + col0;
                const float rs = rsqrtf(rowsq[row0 + ai * HALF + m * 16] * (1.f / 1024.f) + NORM_EPS);
#pragma unroll
                for (int bj = 0; bj < 2; ++bj) { const f32x4 v0 = acc[ai][bj][m][0] * rs, v1 = acc[ai][bj][m][1] * rs;
                    u32x4 w; w.x = pk2(v0[0], v0[1]); w.y = pk2(v0[2], v0[3]); w.z = pk2(v1[0], v1[1]); w.w = pk2(v1[2], v1[3]);
                    *(u32x4*)(rowp + bj * HALF) = w; } }
    }
};
struct EpiGlu {
    static constexpr bool PERM = true, AFTER_DRAIN = false;
    const bf16_t* YG; const bf16_t* Z; const float* bias; bf16_t* O;
    __device__ __forceinline__ void operator()(const f32x4 (&acc)[2][2][4][2], const Unit& u, int wr, int wc, int fr, int fq) const {
        const int row0 = u.pm * BM + wr * 64 + fr; const int col0 = u.pn * BM + wc * 32 + 8 * fq;
#pragma unroll
        for (int bj = 0; bj < 2; ++bj) {
            const f32x4 b0 = *(const f32x4*)(bias + col0 + bj * HALF), b1 = *(const f32x4*)(bias + col0 + bj * HALF + 4);
#pragma unroll
            for (int ai = 0; ai < 2; ++ai)
#pragma unroll
                for (int m = 0; m < 4; ++m) {
                    const size_t off = (size_t)(row0 + ai * HALF + m * 16) * DM + col0 + bj * HALF;
                    const u32x4 yv = *(const u32x4*)(YG + off), zv = *(const u32x4*)(Z + off);
                    const f32x4 v0 = acc[ai][bj][m][0] + b0, v1 = acc[ai][bj][m][1] + b1;
                    float r[8];
#pragma unroll
                    for (int q = 0; q < 4; ++q) {
                        const float a0 = q < 2 ? v0[2 * q] : v1[2 * q - 4], a1 = q < 2 ? v0[2 * q + 1] : v1[2 * q - 3];
                        const float y0 = bflo(yv[q]), y1 = bfhi(yv[q]), z0 = bflo(zv[q]), z1 = bfhi(zv[q]);
                        r[2 * q] = y0 * sigmoidf_(a0) * (z0 * sigmoidf_(z0)); r[2 * q + 1] = y1 * sigmoidf_(a1) * (z1 * sigmoidf_(z1));
                    }
                    u32x4 w; w.x = pk2(r[0], r[1]); w.y = pk2(r[2], r[3]); w.z = pk2(r[4], r[5]); w.w = pk2(r[6], r[7]);
                    *(u32x4*)(O + off) = w;
                }
        }
    }
};
struct EpiRes {
    static constexpr bool PERM = true, AFTER_DRAIN = false;
    const float* base; float* out; bf16_t* xn; float* rowsq;
    __device__ __forceinline__ void operator()(const f32x4 (&acc)[2][2][4][2], const Unit& u, int wr, int wc, int fr, int fq) const {
        const int row0 = u.pm * BM + wr * 64 + fr; const int col0 = u.pn * BM + wc * 32 + 8 * fq;
#pragma unroll
        for (int ai = 0; ai < 2; ++ai)
#pragma unroll
            for (int m = 0; m < 4; ++m) {
                float ss = 0.f;
#pragma unroll
                for (int bj = 0; bj < 2; ++bj) {
                    const size_t off = (size_t)(row0 + ai * HALF + m * 16) * DM + col0 + bj * HALF;
                    const f32x4 v0 = *(const f32x4*)(base + off) + acc[ai][bj][m][0], v1 = *(const f32x4*)(base + off + 4) + acc[ai][bj][m][1];
                    *(f32x4*)(out + off) = v0; *(f32x4*)(out + off + 4) = v1;
                    if (xn) {
                        u32x4 w; w.x = pk2(v0[0], v0[1]); w.y = pk2(v0[2], v0[3]); w.z = pk2(v1[0], v1[1]); w.w = pk2(v1[2], v1[3]);
                        *(u32x4*)(xn + off) = w;
                        ss += (v0[0] * v0[0] + v0[1] * v0[1]) + (v0[2] * v0[2] + v0[3] * v0[3]) + (v1[0] * v1[0] + v1[1] * v1[1]) + (v1[2] * v1[2] + v1[3] * v1[3]);
                    }
                }
                if (xn) { ss += __shfl_xor(ss, 16); ss += __shfl_xor(ss, 32); if (fq == 0) atomicAdd(rowsq + row0 + ai * HALF + m * 16, ss); }
            }
    }
};

template <class Epi, class Sched, bool ALIGN_EPI = false, bool SP2 = false>
__device__ __forceinline__ void gemm_phase(LAS unsigned char* lds, const Gemm g, const Sched& S, const Epi& E) {
    const int tid = tid_l(), wid = __builtin_amdgcn_readfirstlane(tid >> 6), lane = tid & 63, wr = wid >> 2, wc = wid & 3, fr = lane & 15, fq = lane >> 4;
    const int K = g.K, nt = K / BK;
    unsigned voffA[2], voffB[2];
#pragma unroll
    for (int i = 0; i < 2; ++i) { int R, C; stage_rc(tid * 16 + i * 8192, R, C); const int Rb = Epi::PERM ? ((R & ~31) + perm32(R & 31)) : R;
        voffA[i] = (unsigned)(R * K + C) * 2u; voffB[i] = (unsigned)(Rb * K + C) * 2u; }
    const size_t kstep = (size_t)(BK * 2);
    const size_t hstep = (size_t)HALF * K * 2;
    const size_t tstep = 2 * hstep;
    const unsigned ldsw = (unsigned)wid * 1024u;
    const int aoff = lds_byte(wr * 64 + fr, fq * 8), boff = lds_byte(wc * 32 + fr, fq * 8);
#define PG8_SA(b, h) (((b) * 2 + (h)) * HTB)
#define PG8_SB(b, h) ((4 + (b) * 2 + (h)) * HTB)
#define PG8_STAGE(bufoff, gbase, voff) do { _Pragma("unroll") for (int _i = 0; _i < 2; ++_i) \
        __builtin_amdgcn_global_load_lds((const unsigned*)((const char*)(gbase) + (voff)[_i]), (LAS unsigned*)(lds + (bufoff) + ldsw + _i * 8192), 16, 0, 0); } while (0)
#define PG8_LDA(dst, b, h) do { _Pragma("unroll") for (int m = 0; m < 4; ++m) _Pragma("unroll") for (int k = 0; k < 2; ++k) dst[m][k] = *(const LAS bf16x8*)(lds + PG8_SA(b, h) + aoff + m * 2048 + k * 1024); } while (0)
#define PG8_LDB(dst, b, h) do { _Pragma("unroll") for (int n = 0; n < 2; ++n) _Pragma("unroll") for (int k = 0; k < 2; ++k) dst[n][k] = *(const LAS bf16x8*)(lds + PG8_SB(b, h) + boff + n * 2048 + k * 1024); } while (0)
#define PG8_MMA(ai, bj, At, Bt) do { __builtin_amdgcn_s_setprio(1); _Pragma("unroll") for (int m = 0; m < 4; ++m) _Pragma("unroll") for (int n = 0; n < 2; ++n) _Pragma("unroll") for (int k = 0; k < 2; ++k) \
        acc[ai][bj][m][n] = __builtin_amdgcn_mfma_f32_16x16x32_bf16(Bt[n][k], At[m][k], acc[ai][bj][m][n], 0, 0, 0); __builtin_amdgcn_s_setprio(0); } while (0)
#define PG8_WAIT_V(n) asm volatile("s_waitcnt vmcnt(" #n ")" ::: "memory")
#define PG8_WAIT_L(n) asm volatile("s_waitcnt lgkmcnt(" #n ")" ::: "memory")
#define PG8_BAR __builtin_amdgcn_s_barrier()
#define PG8_SCHED __builtin_amdgcn_sched_barrier(0)
    Unit cur, nxt; int ui = 0;
    if (!S.next(0, cur)) return;
    f32x4 acc[2][2][4][2];
#pragma unroll
    for (int a = 0; a < 2; ++a)
#pragma unroll
        for (int b = 0; b < 2; ++b)
#pragma unroll
            for (int m = 0; m < 4; ++m)
#pragma unroll
                for (int n = 0; n < 2; ++n) acc[a][b][m][n] = (f32x4){0.f, 0.f, 0.f, 0.f};
    bf16x8 At[4][2], B0[2][2], B1[2][2];
    const char* cA = (const char*)g.A + (size_t)cur.pm * tstep; const char* cB = (const char*)g.Bt + (size_t)cur.pn * tstep;
    S.a_ready(cur);
    if constexpr (SP2) {
        PG8_STAGE(PG8_SB(0, 0), cB, voffB); PG8_STAGE(PG8_SB(0, 1), cB + hstep, voffB); PG8_STAGE(PG8_SA(0, 0), cA, voffA); PG8_STAGE(PG8_SA(0, 1), cA + hstep, voffA);
        if (wr == 1) PG8_BAR;
        PG8_WAIT_V(2); PG8_BAR;
        PG8_STAGE(PG8_SB(1, 0), cB + kstep, voffB); PG8_STAGE(PG8_SA(1, 0), cA + kstep, voffA); PG8_STAGE(PG8_SB(1, 1), cB + hstep + kstep, voffB);
        PG8_WAIT_V(6); PG8_BAR;
    } else {
        PG8_STAGE(PG8_SB(0, 0), cB, voffB); PG8_STAGE(PG8_SA(0, 0), cA, voffA); PG8_STAGE(PG8_SB(0, 1), cB + hstep, voffB); PG8_STAGE(PG8_SA(0, 1), cA + hstep, voffA);
        if (wr == 1) PG8_BAR;
        PG8_WAIT_V(4); PG8_BAR;
        PG8_STAGE(PG8_SB(1, 0), cB + kstep, voffB); PG8_STAGE(PG8_SA(1, 0), cA + kstep, voffA); PG8_STAGE(PG8_SB(1, 1), cB + hstep + kstep, voffB);
        PG8_WAIT_V(6); PG8_BAR;
    }
    for (;;) {
        const bool has_next = S.next(ui + 1, nxt);
        const char* nA = has_next ? (const char*)g.A + (size_t)nxt.pm * tstep : cA; const char* nB = has_next ? (const char*)g.Bt + (size_t)nxt.pn * tstep : cB;
        for (int t = 0; t < nt; t += 2) {
            const bool last = (t == nt - 2);
            const char* a1 = cA + (size_t)(t + 1) * kstep;
            const char* a2 = last ? nA : cA + (size_t)(t + 2) * kstep; const char* b2 = last ? nB : cB + (size_t)(t + 2) * kstep;
            const char* a3 = a2 + kstep; const char* b3 = b2 + kstep;
            if (last && has_next) S.a_ready(nxt);
            if constexpr (SP2) {
            PG8_LDB(B0, 0, 0); PG8_LDB(B1, 0, 1); PG8_SCHED; PG8_LDA(At, 0, 0); PG8_STAGE(PG8_SA(1, 1), a1 + hstep, voffA);
            PG8_WAIT_V(8); PG8_WAIT_L(0); PG8_BAR; PG8_MMA(0, 0, At, B0); PG8_MMA(0, 1, At, B1); PG8_BAR; PG8_SCHED;
            PG8_LDA(At, 0, 1); PG8_STAGE(PG8_SB(0, 0), b2, voffB); PG8_STAGE(PG8_SB(0, 1), b2 + hstep, voffB); PG8_STAGE(PG8_SA(0, 0), a2, voffA);
            PG8_WAIT_V(8); PG8_WAIT_L(0); PG8_BAR; PG8_MMA(1, 0, At, B0); PG8_MMA(1, 1, At, B1); PG8_BAR; PG8_SCHED;
            PG8_LDB(B0, 1, 0); PG8_LDB(B1, 1, 1); PG8_SCHED; PG8_LDA(At, 1, 0); PG8_STAGE(PG8_SA(0, 1), a2 + hstep, voffA);
            PG8_WAIT_V(8); PG8_WAIT_L(0); PG8_BAR; PG8_MMA(0, 0, At, B0); PG8_MMA(0, 1, At, B1); PG8_BAR; PG8_SCHED;
            PG8_LDA(At, 1, 1); PG8_STAGE(PG8_SB(1, 0), b3, voffB); PG8_STAGE(PG8_SB(1, 1), b3 + hstep, voffB); PG8_STAGE(PG8_SA(1, 0), a3, voffA);
            PG8_WAIT_V(8); PG8_WAIT_L(0); PG8_BAR; PG8_MMA(1, 0, At, B0); PG8_MMA(1, 1, At, B1); PG8_BAR; PG8_SCHED;
            } else {
            PG8_LDB(B0, 0, 0); PG8_SCHED; PG8_LDA(At, 0, 0); PG8_STAGE(PG8_SA(1, 1), a1 + hstep, voffA);
            PG8_WAIT_L(8); PG8_BAR; PG8_WAIT_L(0); PG8_MMA(0, 0, At, B0); PG8_BAR; PG8_SCHED;
            PG8_LDB(B1, 0, 1); PG8_STAGE(PG8_SB(0, 0), b2, voffB);
            PG8_BAR; PG8_WAIT_L(0); PG8_MMA(0, 1, At, B1); PG8_BAR;
            PG8_LDA(At, 0, 1); PG8_STAGE(PG8_SA(0, 0), a2, voffA);
            PG8_BAR; PG8_WAIT_L(0); PG8_MMA(1, 0, At, B0); PG8_BAR; PG8_SCHED;
            PG8_STAGE(PG8_SB(0, 1), b2 + hstep, voffB);
            PG8_WAIT_V(6); PG8_BAR; PG8_MMA(1, 1, At, B1); PG8_BAR;
            PG8_LDB(B0, 1, 0); PG8_SCHED; PG8_LDA(At, 1, 0); PG8_STAGE(PG8_SA(0, 1), a2 + hstep, voffA);
            PG8_WAIT_L(8); PG8_BAR; PG8_WAIT_L(0); PG8_MMA(0, 0, At, B0); PG8_BAR; PG8_SCHED;
            PG8_LDB(B1, 1, 1); PG8_STAGE(PG8_SB(1, 0), b3, voffB);
            PG8_BAR; PG8_WAIT_L(0); PG8_MMA(0, 1, At, B1); PG8_BAR;
            PG8_LDA(At, 1, 1); PG8_STAGE(PG8_SA(1, 0), a3, voffA);
            PG8_BAR; PG8_WAIT_L(0); PG8_MMA(1, 0, At, B0); PG8_BAR; PG8_SCHED;
            PG8_STAGE(PG8_SB(1, 1), b3 + hstep, voffB);
            PG8_WAIT_V(6); PG8_BAR; PG8_MMA(1, 1, At, B1); PG8_BAR;
            }
        }
        if constexpr (ALIGN_EPI) { if (wr == 0) PG8_BAR; }
        if constexpr (!Epi::AFTER_DRAIN) { E(acc, cur, wr, wc, fr, fq); S.done(cur); }
        if (!has_next) break;
#pragma unroll
        for (int a = 0; a < 2; ++a)
#pragma unroll
            for (int b = 0; b < 2; ++b)
#pragma unroll
                for (int m = 0; m < 4; ++m)
#pragma unroll
                    for (int n = 0; n < 2; ++n) acc[a][b][m][n] = (f32x4){0.f, 0.f, 0.f, 0.f};
        cur = nxt; cA = nA; cB = nB; ++ui;
        if constexpr (ALIGN_EPI) { if (wr == 1) PG8_BAR; }
    }
    PG8_WAIT_V(0);
    if constexpr (!ALIGN_EPI) { if (wr == 0) PG8_BAR; }
    PG8_BAR;
#undef PG8_SA
#undef PG8_SB
#undef PG8_STAGE
#undef PG8_LDA
#undef PG8_LDB
#undef PG8_MMA
#undef PG8_WAIT_V
#undef PG8_WAIT_L
#undef PG8_BAR
#undef PG8_SCHED
}
}

struct Args { const float* in[18]; float* out; unsigned char* ws; };
typedef const __attribute__((address_space(4))) Args* ArgsP;
__device__ __forceinline__ ArgsP launder(ArgsP p) { asm volatile("" : "+s"(p)); return p; }

#define MFMA16(a, b, c) __builtin_amdgcn_mfma_f32_16x16x32_bf16((a), (b), (c), 0, 0, 0)
#define MFMA32(a, b, c) __builtin_amdgcn_mfma_f32_32x32x16_bf16((a), (b), (c), 0, 0, 0)

__device__ __forceinline__ float wave_sum(float v) {
#pragma unroll
    for (int o = 1; o < 64; o <<= 1) v += __shfl_xor(v, o);
    return v;
}

__device__ __forceinline__ int head_perm(int x) { const int pos = x & 127; return (x & ~127) + (pos & 3) * 32 + (pos >> 2); }
template <int MODE, bool GAIN>
__device__ __forceinline__ void transpose_item(const float* W, int K, int N, bf16_t* WT, float* scr, int item, int lane, const float* gain = nullptr) {
    const int nblk = N / 32, kb = item / nblk, nb = item % nblk, k0 = 64 * kb, n0 = 32 * nb;
#pragma unroll 8
    for (int i = 0; i < 32; ++i) { const int kk = 2 * i + (lane >> 5); int sk = k0 + kk, sn = n0 + (lane & 31);
        if (MODE == 1 && sn >= 3072) sn = head_perm(sn);
        if (MODE == 2) sk = head_perm(sk);
        scr[kk * 33 + (lane & 31)] = W[(size_t)sk * N + sn] * (GAIN ? gain[sk] : 1.f); }
    __builtin_amdgcn_wave_barrier(); asm volatile("s_waitcnt lgkmcnt(0)" ::: "memory");
    const int c = lane & 7;
#pragma unroll
    for (int j = 0; j < 4; ++j) { const int n = (lane >> 3) + 8 * j; const float* s = scr + (8 * c) * 33 + n;
        u32x4 o; o.x = pk2(s[0 * 33], s[1 * 33]); o.y = pk2(s[2 * 33], s[3 * 33]); o.z = pk2(s[4 * 33], s[5 * 33]); o.w = pk2(s[6 * 33], s[7 * 33]);
        *(u32x4*)(WT + (size_t)(n0 + n) * K + k0 + 8 * c) = o; }
    asm volatile("s_waitcnt lgkmcnt(0)" ::: "memory"); __builtin_amdgcn_wave_barrier();
}

__device__ __forceinline__ void ssm_tables(ArgsP a, int j, int g, unsigned char* smem, unsigned char* tab) {
    float* Epow = (float*)smem;
    float* Bb = Epow + 17 * 64 * 2;
    float* Cc = Bb + 64 * 16 * 2;
    float* Fp = Cc + 16 * 64 * 2;
    float* Km = Fp + 128;
    const int tid = tid_l();
    const float* a_re = a->in[3] + (size_t)(j * 64 + g) * 64; const float* a_im = a->in[4] + (size_t)(j * 64 + g) * 64;
    const float* b_re = a->in[6] + (size_t)(j * 64 + g) * 64 * 16; const float* b_im = a->in[7] + (size_t)(j * 64 + g) * 64 * 16;
    const float* c_re = a->in[8] + (size_t)(j * 64 + g) * 16 * 64; const float* c_im = a->in[9] + (size_t)(j * 64 + g) * 16 * 64;
    { const float* ep = (const float*)(a->ws + WS_EP) + (size_t)(j * 64 + g) * EP_STRIDE;
      for (int e = tid; e < 17 * 64 * 2; e += 512) Epow[e] = ep[e];
      if (tid < 128) Fp[tid] = ep[18 * 128 + tid]; }
    __syncthreads();
    for (int e = tid; e < 1024; e += 512) {
        { const int p = e >> 4; const float fr_ = Fp[p * 2], fi_ = Fp[p * 2 + 1], br = b_re[e], bi = b_im[e];
          Bb[e * 2] = fr_ * br - fi_ * bi; Bb[e * 2 + 1] = fr_ * bi + fi_ * br; }
        Cc[e * 2] = c_re[e]; Cc[e * 2 + 1] = c_im[e];
    }
    __syncthreads();
    for (int e = tid; e < 4096; e += 512) {
        const int d = e >> 8, c = (e >> 4) & 15, c2 = e & 15; float acc = 0.f;
        for (int p = 0; p < 64; ++p) {
            const float ar = Epow[(d * 64 + p) * 2], ai = Epow[(d * 64 + p) * 2 + 1], br = Bb[(p * 16 + c2) * 2], bi = Bb[(p * 16 + c2) * 2 + 1];
            const float gr = ar * br - ai * bi, gi = ar * bi + ai * br;
            acc += Cc[(c * 64 + p) * 2] * gr - Cc[(c * 64 + p) * 2 + 1] * gi;
        }
        Km[e] = acc;
    }
    __syncthreads();
    for (int e = tid; e < 16 * 64; e += 512) {
        const int d = e >> 6, l = e & 63, c = l & 15, ts = l >> 5, c0 = ((l >> 4) & 1) * 8, dd = d - ts; float v[8];
#pragma unroll
        for (int jj = 0; jj < 8; ++jj) v[jj] = dd >= 0 ? Km[(dd * 16 + c) * 16 + c0 + jj] : 0.f;
        u32x4 w; w.x = pk2(v[0], v[1]); w.y = pk2(v[2], v[3]); w.z = pk2(v[4], v[5]); w.w = pk2(v[6], v[7]);
        *(u32x4*)(tab + d * 1024 + l * 16) = w;
    }
    for (int e = tid; e < 64 * 64; e += 512) {
        const int f = e >> 6, l = e & 63, mt = f >> 3, ks = f & 7, m = mt * 16 + (l & 15), p = m >> 1, ri = m & 1, tau = ks * 2 + (l >> 5), c0 = ((l >> 4) & 1) * 8;
        const float ar = Epow[((15 - tau) * 64 + p) * 2], ai = Epow[((15 - tau) * 64 + p) * 2 + 1]; float v[8];
#pragma unroll
        for (int jj = 0; jj < 8; ++jj) { const float br = Bb[(p * 16 + c0 + jj) * 2], bi = Bb[(p * 16 + c0 + jj) * 2 + 1]; v[jj] = ri == 0 ? (ar * br - ai * bi) : (ar * bi + ai * br); }
        u32x4 w; w.x = pk2(v[0], v[1]); w.y = pk2(v[2], v[3]); w.z = pk2(v[4], v[5]); w.w = pk2(v[6], v[7]);
        *(u32x4*)(tab + 16384 + f * 1024 + l * 16) = w;
    }
    for (int e = tid; e < 64 * 64; e += 512) {
        const int f = e >> 6, l = e & 63, t = f >> 2, kk = f & 3, c = l & 15, m0 = kk * 32 + (l >> 4) * 8; float v[8];
#pragma unroll
        for (int jj = 0; jj < 8; ++jj) { const int m = m0 + jj, p = m >> 1, ri = m & 1;
            const float ar = Epow[((t + 1) * 64 + p) * 2], ai = Epow[((t + 1) * 64 + p) * 2 + 1], cr = Cc[(c * 64 + p) * 2], ci = Cc[(c * 64 + p) * 2 + 1];
            v[jj] = ri == 0 ? (cr * ar - ci * ai) : -(cr * ai + ci * ar); }
        u32x4 w; w.x = pk2(v[0], v[1]); w.y = pk2(v[2], v[3]); w.z = pk2(v[4], v[5]); w.w = pk2(v[6], v[7]);
        *(u32x4*)(tab + 16384 + 65536 + f * 1024 + l * 16) = w;
    }
    __syncthreads();
}

__device__ __forceinline__ void pre0_phase(ArgsP a) {
    const int tid = tid_l(), G = sg_l(gridDim.x), bid = sg_l(blockIdx.x);
    unsigned char* ws = a->ws;
    float* rope = (float*)(ws + WS_ROPE);
    for (int e = bid * 512 + tid; e < L * 16; e += G * 512) {
        const int pos = e >> 4, i = e & 15;
        const double invf = exp(-(double)i * (1.0 / 16.0) * 13.122363377404328);
        double ang = (double)pos * invf; ang -= 6.283185307179586476925 * floor(ang / 6.283185307179586476925);
        rope[e * 2] = (float)cos(ang); rope[e * 2 + 1] = (float)sin(ang);
    }
    float* epb = (float*)(ws + WS_EP);
    for (int e = bid * 512 + tid; e < 2 * 64 * 19 * 64; e += G * 512) {
        const int p = e & 63, n = (e >> 6) % 19, jg = (e >> 6) / 19;
        const double dt = exp((double)a->in[5][jg]);
        const double lr = (double)a->in[3][(size_t)jg * 64 + p], li = (double)a->in[4][(size_t)jg * 64 + p];
        const double pw = n <= 16 ? (double)n : (n == 17 ? 512.0 : 1.0);
        const double mag = exp(lr * dt * pw); double ang = li * dt * pw; ang -= 6.283185307179586476925 * floor(ang / 6.283185307179586476925);
        double cr = cos(ang) * mag, ci = sin(ang) * mag;
        if (n == 18) { const double nr = cr - 1.0, ni = ci, den = lr * lr + li * li; cr = (nr * lr + ni * li) / den; ci = (ni * lr - nr * li) / den; }
        epb[(size_t)jg * EP_STRIDE + (n * 64 + p) * 2] = (float)cr; epb[(size_t)jg * EP_STRIDE + (n * 64 + p) * 2 + 1] = (float)ci;
    }
}
__device__ __forceinline__ void prep_phase(ArgsP a, int layer, const float* h, unsigned char* smem) {
    const int tid = tid_l(), lane = tid & 63, wave = tid >> 6, G = sg_l(gridDim.x), bid = sg_l(blockIdx.x);
    unsigned char* ws = a->ws;
    const int j = layer >> 1;
    if ((layer & 1) == 0) {
        for (int g = bid; g < 64; g += G) ssm_tables(a, j, g, smem, ws + WS_TAB + (size_t)g * TAB_STRIDE);
    }
    __syncthreads();
    float* scr = (float*)(smem + wave * 16384);
    const int gw = bid * 8 + wave, NGW = G * 8;
    bf16_t* Wb = (bf16_t*)(ws + WS_W);
    const float* gain = a->in[1] + layer * 1024;
    if ((layer & 1) == 0) {
        const float* w_in = a->in[2] + (size_t)j * 1024 * 2048; const float* w_glu = a->in[11] + (size_t)j * 1024 * 1024; const float* w_out = a->in[13] + (size_t)j * 1024 * 1024;
        for (int it = gw; it < 2048; it += NGW) {
            if (it < 1024) transpose_item<0, true>(w_in, 1024, 2048, Wb, scr, it, lane, gain);
            else if (it < 1536) transpose_item<0, false>(w_glu, 1024, 1024, Wb + 2048 * 1024, scr, it - 1024, lane);
            else transpose_item<0, false>(w_out, 1024, 1024, Wb + 3072 * 1024, scr, it - 1536, lane);
        }
    } else {
        const float* w_in = a->in[14] + (size_t)j * 1024 * 4096; const float* w_out = a->in[17] + (size_t)j * 1024 * 1024;
        for (int it = gw; it < 2560; it += NGW) {
            if (it < 2048) transpose_item<1, true>(w_in, 1024, 4096, Wb, scr, it, lane, gain);
            else transpose_item<2, false>(w_out, 1024, 1024, Wb + 4096 * 1024, scr, it - 2048, lane);
        }
    }
    if (layer == 0) {
        bf16_t* XN = (bf16_t*)(ws + WS_XN); float* rowsq = (float*)(ws + WS_ROWSQ);
        for (int m = gw; m < L; m += NGW) {
            const f32x4* xr = (const f32x4*)(h + (size_t)m * DM) + lane;
            f32x4 v[4]; float s = 0.f;
#pragma unroll
            for (int q = 0; q < 4; ++q) { v[q] = xr[64 * q]; s += (v[q].x * v[q].x + v[q].y * v[q].y) + (v[q].z * v[q].z + v[q].w * v[q].w); }
            s = wave_sum(s);
            if (lane == 0) rowsq[m] = s;
            u32x2* o8 = (u32x2*)(XN + (size_t)m * DM) + lane;
#pragma unroll
            for (int q = 0; q < 4; ++q) { u32x2 w; w.x = pk2(v[q].x, v[q].y); w.y = pk2(v[q].z, v[q].w); o8[64 * q] = w; }
        }
    }
}

__device__ __forceinline__ void ssm_s1(ArgsP a, unsigned char* smem) {
    const int tid = tid_l(), lane = tid & 63, wave = tid >> 6, G = sg_l(gridDim.x);
    unsigned char* ws = a->ws;
    const bf16_t* U = (const bf16_t*)(ws + WS_U); float* SL = (float*)(ws + WS_SLOC);
    { float* rowsq = (float*)(ws + WS_ROWSQ); for (int e = sg_l(blockIdx.x) * 512 + tid; e < L; e += G * 512) rowsq[e] = 0.f; }
    for (int unit = sg_l(blockIdx.x); unit < 256; unit += G) {
        const int g = unit >> 2, qtr = unit & 3;
        __syncthreads();
        { const u32x4* src = (const u32x4*)(ws + WS_TAB + (size_t)g * TAB_STRIDE + 16384); u32x4* dst = (u32x4*)smem;
          for (int e = tid; e < 4096; e += 512) dst[e] = src[e]; }
        __syncthreads();
#pragma unroll 1
        for (int nt = 0; nt < 2; ++nt) {
            const int chunk0 = qtr * 256 + wave * 32 + nt * 16, n = lane & 15;
            bf16x8 B[8];
#pragma unroll
            for (int ks = 0; ks < 8; ++ks) B[ks] = *(const bf16x8*)(U + (size_t)((chunk0 + n) * 16 + ks * 2 + (lane >> 5)) * DM + g * 16 + ((lane >> 4) & 1) * 8);
#pragma unroll
            for (int mt = 0; mt < 8; ++mt) {
                f32x4 acc = {0.f, 0.f, 0.f, 0.f};
#pragma unroll
                for (int ks = 0; ks < 8; ++ks) { const bf16x8 A = *(const bf16x8*)(smem + (mt * 8 + ks) * 1024 + lane * 16); acc = MFMA16(A, B[ks], acc); }
                *(f32x4*)(SL + ((size_t)(chunk0 + n) * 64 + g) * 128 + mt * 16 + (lane >> 4) * 4) = acc;
                asm volatile("" ::: "memory");
            }
        }
    }
}
__device__ __forceinline__ void ssm_s2(ArgsP a, int j, unsigned char* smem) {
    const int tid = tid_l(), G = sg_l(gridDim.x);
    unsigned char* ws = a->ws;
    const float* SL = (const float*)(ws + WS_SLOC); unsigned* SIN = (unsigned*)(ws + WS_SIN);
    float* ex = (float*)smem;
    for (int unit = sg_l(blockIdx.x); unit < 256; unit += G) {
        const int seg = tid >> 4, sl = tid & 15, st = unit * 16 + sl, g = st >> 6, p = st & 63;
        const float* ep = (const float*)(ws + WS_EP) + (size_t)(j * 64 + g) * EP_STRIDE;
        const float e16r = ep[(16 * 64 + p) * 2], e16i = ep[(16 * 64 + p) * 2 + 1], eSr = ep[(17 * 64 + p) * 2], eSi = ep[(17 * 64 + p) * 2 + 1];
        const float* src = SL + ((size_t)(seg * 32) * 64 + g) * 128 + 2 * p;
        f32x2 v[32];
#pragma unroll
        for (int i = 0; i < 32; ++i) v[i] = *(const f32x2*)(src + (size_t)i * 8192);
        float sr = 0.f, si = 0.f;
#pragma unroll
        for (int i = 0; i < 32; ++i) { const float nr = e16r * sr - e16i * si + v[i].x, ni = e16r * si + e16i * sr + v[i].y; sr = nr; si = ni; }
        __syncthreads();
        ex[(seg * 16 + sl) * 2] = sr; ex[(seg * 16 + sl) * 2 + 1] = si;
        __syncthreads();
        float cr = 0.f, ci = 0.f;
        for (int s = 0; s < seg; ++s) { const float xr = ex[(s * 16 + sl) * 2], xi = ex[(s * 16 + sl) * 2 + 1]; const float nr = eSr * cr - eSi * ci + xr, ni = eSr * ci + eSi * cr + xi; cr = nr; ci = ni; }
        unsigned* dst = SIN + ((size_t)(seg * 32) * 64 + g) * 64 + p;
#pragma unroll
        for (int i = 0; i < 32; ++i) {
            dst[(size_t)i * 4096] = pk2(cr, ci);
            const float nr = e16r * cr - e16i * ci + v[i].x, ni = e16r * ci + e16i * cr + v[i].y; cr = nr; ci = ni;
        }
    }
}
__device__ __forceinline__ void ssm_s3(ArgsP a, int j, unsigned char* smem) {
    const int tid = tid_l(), lane = tid & 63, wave = tid >> 6, G = sg_l(gridDim.x);
    unsigned char* ws = a->ws;
    const bf16_t* U = (const bf16_t*)(ws + WS_U); const bf16_t* SIN = (const bf16_t*)(ws + WS_SIN); bf16_t* YG = (bf16_t*)(ws + WS_YG);
    const float* dsk = a->in[10] + j * 1024;
    for (int unit = sg_l(blockIdx.x); unit < 256; unit += G) {
        const int g = unit >> 2, qtr = unit & 3;
        __syncthreads();
        { const u32x4* srcF = (const u32x4*)(ws + WS_TAB + (size_t)g * TAB_STRIDE); u32x4* dst = (u32x4*)smem;
          for (int e = tid; e < 1024; e += 512) dst[e] = srcF[e];
          const u32x4* srcC = (const u32x4*)(ws + WS_TAB + (size_t)g * TAB_STRIDE + 16384 + 65536);
          for (int e = tid; e < 4096; e += 512) dst[1024 + e] = srcC[e]; }
        __syncthreads();
        const unsigned char* Fl = smem; const unsigned char* Wl = smem + 16384;
        const int n = lane & 15, cq = (lane >> 4) * 4;
        const f32x4 dv = *(const f32x4*)(dsk + g * 16 + cq);
#pragma unroll 1
        for (int nt = 0; nt < 2; ++nt) {
            const int chunk = qtr * 256 + wave * 32 + nt * 16 + n;
            bf16x8 Bu[8], Bs[4];
#pragma unroll
            for (int ks = 0; ks < 8; ++ks) Bu[ks] = *(const bf16x8*)(U + (size_t)(chunk * 16 + ks * 2 + (lane >> 5)) * DM + g * 16 + ((lane >> 4) & 1) * 8);
#pragma unroll
            for (int kk = 0; kk < 4; ++kk) Bs[kk] = *(const bf16x8*)(SIN + ((size_t)chunk * 64 + g) * 128 + kk * 32 + (lane >> 4) * 8);
#pragma unroll
            for (int t = 0; t < 16; ++t) {
                f32x4 acc = {0.f, 0.f, 0.f, 0.f};
#pragma unroll
                for (int i = 0; i <= t / 2; ++i) { const bf16x8 A = *(const bf16x8*)(Fl + (t - 2 * i) * 1024 + lane * 16); acc = MFMA16(A, Bu[i], acc); }
#pragma unroll
                for (int kk = 0; kk < 4; ++kk) { const bf16x8 A = *(const bf16x8*)(Wl + (t * 4 + kk) * 1024 + lane * 16); acc = MFMA16(A, Bs[kk], acc); }
                const size_t off = (size_t)(chunk * 16 + t) * DM + g * 16 + cq;
                const u32x2 uv = *(const u32x2*)(U + off);
                const float y0 = gelu_tanh(acc[0] + dv[0] * bflo(uv.x)), y1 = gelu_tanh(acc[1] + dv[1] * bfhi(uv.x));
                const float y2 = gelu_tanh(acc[2] + dv[2] * bflo(uv.y)), y3 = gelu_tanh(acc[3] + dv[3] * bfhi(uv.y));
                u32x2 w; w.x = pk2(y0, y1); w.y = pk2(y2, y3);
                *(u32x2*)(YG + off) = w;
                asm volatile("" ::: "memory");
            }
        }
    }
}

constexpr int QK_STRIDE = 4096;
constexpr int KL_STRIDE = 272, VL_STRIDE = 520, VT_OFF = 256 * KL_STRIDE;

__device__ __forceinline__ void attn_a1(ArgsP a, int j, unsigned char* smem, int dry) {
    const int tid = tid_l(), G = sg_l(gridDim.x);
    unsigned char* ws = a->ws;
    bf16_t* QKVZ = (bf16_t*)(ws + WS_BIG); const float* rope = (const float*)(ws + WS_ROPE); float* kmean = (float*)(ws + WS_KMEAN);
    if (sg_l(blockIdx.x) == 0) ((unsigned*)(ws + WS_CTL))[tid] = 0u;
    if (!dry) { float* rowsq = (float*)(ws + WS_ROWSQ); for (int e = sg_l(blockIdx.x) * 512 + tid; e < L; e += G * 512) rowsq[e] = 0.f; }
    const int seg = tid & 15, rg = tid >> 4;
    const float* qg = a->in[15] + j * 128 + seg * 8; const float* kg = a->in[16] + j * 128 + seg * 8;
    float gq[8], gk[8];
#pragma unroll
    for (int i = 0; i < 8; ++i) { gq[i] = qg[i]; gk[i] = kg[i]; }
    float* red = (float*)(smem + 72 * 1024);
    for (int unit = sg_l(blockIdx.x); unit < 512; unit += G) {
        const int h = unit & 7, b = unit >> 3;
        float ksum[8];
#pragma unroll
        for (int i = 0; i < 8; ++i) ksum[i] = 0.f;
        __syncthreads();
#pragma unroll 1
        for (int pb = 0; pb < 2; ++pb) {
            u32x4 rq[4], rk[4], rv[4]; f32x2 rp[4][8];
#pragma unroll
            for (int p4 = 0; p4 < 4; ++p4) {
                const int t = b * 256 + (pb * 4 + p4) * 32 + rg;
                const bf16_t* p = QKVZ + (size_t)t * QK_STRIDE + h * 128 + seg * 8;
                rq[p4] = *(const u32x4*)p; rk[p4] = *(const u32x4*)(p + 1024); rv[p4] = *(const u32x4*)(p + 2048);
#pragma unroll
                for (int i = 0; i < 8; ++i) rp[p4][i] = *(const f32x2*)(rope + ((size_t)t * 16 + (seg & 1) * 8 + i) * 2);
            }
#pragma unroll
            for (int p4 = 0; p4 < 4; ++p4) {
                const int ps = pb * 4 + p4, t = b * 256 + ps * 32 + rg;
#pragma unroll
                for (int which = 0; which < 2; ++which) {
                    bf16_t* p = QKVZ + (size_t)t * QK_STRIDE + which * 1024 + h * 128 + seg * 8;
                    const u32x4 raw = which == 0 ? rq[p4] : rk[p4];
                    float x[8];
#pragma unroll
                    for (int q = 0; q < 4; ++q) { x[2 * q] = bflo(raw[q]); x[2 * q + 1] = bfhi(raw[q]); }
                    float ss = 0.f;
#pragma unroll
                    for (int i = 0; i < 8; ++i) ss += x[i] * x[i];
                    ss += __shfl_xor(ss, 1); ss += __shfl_xor(ss, 2); ss += __shfl_xor(ss, 4); ss += __shfl_xor(ss, 8);
                    const float rstd = rsqrtf(ss * (1.f / 128.f) + NORM_EPS);
#pragma unroll
                    for (int i = 0; i < 8; ++i) x[i] = x[i] * rstd * (which == 0 ? gq[i] : gk[i]);
                    float y[8];
#pragma unroll
                    for (int i = 0; i < 8; ++i) {
                        const float o = __shfl_xor(x[i], 2);
                        y[i] = x[i];
                        if (seg < 2) y[i] = x[i] * rp[p4][i].x - o * rp[p4][i].y;
                        else if (seg < 4) y[i] = x[i] * rp[p4][i].x + o * rp[p4][i].y;
                    }
                    u32x4 w; w.x = pk2(y[0], y[1]); w.y = pk2(y[2], y[3]); w.z = pk2(y[4], y[5]); w.w = pk2(y[6], y[7]);
                    if (!dry) *(u32x4*)p = w;
                    if (which == 1) {
#pragma unroll
                        for (int i = 0; i < 8; ++i) ksum[i] += y[i];
                    }
                }
                { const int key = ps * 32 + rg; *(u32x4*)(smem + key * 256 + ((seg ^ ((key >> 3) & 15)) * 16)) = rv[p4]; }
            }
        }
#pragma unroll
        for (int i = 0; i < 8; ++i) red[rg * 128 + seg * 8 + i] = ksum[i];
        __syncthreads();
        if (tid < 128) { float s = 0.f;
#pragma unroll
            for (int r = 0; r < 32; ++r) s += red[r * 128 + tid];
            if (!dry) kmean[((size_t)h * 64 + b) * 128 + tid] = s * (1.f / 256.f); }
        for (int e = tid; e < 4096; e += 512) {
            const int ko = e & 31, d = e >> 5, key0 = ko * 8;
            unsigned short v[8];
#pragma unroll
            for (int i = 0; i < 8; ++i) v[i] = *(const unsigned short*)(smem + (key0 + i) * 256 + (((d >> 3) ^ (ko & 15)) * 16) + (d & 7) * 2);
            u32x4 w; w.x = v[0] | ((unsigned)v[1] << 16); w.y = v[2] | ((unsigned)v[3] << 16); w.z = v[4] | ((unsigned)v[5] << 16); w.w = v[6] | ((unsigned)v[7] << 16);
            if (!dry) *(u32x4*)(QKVZ + (size_t)(b * 256 + 2 * d + (key0 >> 7)) * QK_STRIDE + 2048 + h * 128 + (key0 & 127)) = w;
        }
    }
}

__device__ __forceinline__ bool gate_better(float v, int i, float w, int k) { return v > w || (v == w && i < k); }
#define TOP3_INSERT(s_, n_) do { const float _s = (s_); const int _n = (n_); \
    const bool _b1 = gate_better(_s, _n, v1, i1), _b2 = gate_better(_s, _n, v2, i2), _b3 = gate_better(_s, _n, v3, i3); \
    const float _nv3 = _b2 ? v2 : (_b3 ? _s : v3); const int _ni3 = _b2 ? i2 : (_b3 ? _n : i3); \
    const float _nv2 = _b1 ? v1 : (_b2 ? _s : v2); const int _ni2 = _b1 ? i1 : (_b2 ? _n : i2); \
    const float _nv1 = _b1 ? _s : v1; const int _ni1 = _b1 ? _n : i1; \
    v1 = _nv1; i1 = _ni1; v2 = _nv2; i2 = _ni2; v3 = _nv3; i3 = _ni3; } while (0)
__device__ __forceinline__ void attn_a2(ArgsP a, unsigned char* smem, int dry) {
    const int tid = tid_l(), lane = tid & 63, wave = tid >> 6, G = sg_l(gridDim.x), r = lane & 31, hh = lane >> 5;
    unsigned char* ws = a->ws;
    const bf16_t* QKVZ = (const bf16_t*)(ws + WS_BIG); const float* kmean = (const float*)(ws + WS_KMEAN);
    unsigned* cnt = (unsigned*)(ws + WS_CTL); unsigned short* lists = (unsigned short*)(ws + WS_TAB);
    unsigned* cntl = (unsigned*)smem; unsigned* basel = cntl + 64;
    int cur_h = -1;
    bf16x8 Khi[2][8], Klo[2][8];
    for (int unit = sg_l(blockIdx.x); unit < 512; unit += G) {
        const int h = unit & 7, b = unit >> 3;
        if (b == 0) continue;
        if (h != cur_h) {
            cur_h = h;
#pragma unroll
            for (int tl = 0; tl < 2; ++tl)
#pragma unroll
                for (int kk = 0; kk < 8; ++kk) {
                    const float* kp = kmean + ((size_t)h * 64 + tl * 32 + r) * 128 + kk * 16 + hh * 8;
                    const f32x4 x0 = *(const f32x4*)kp, x1 = *(const f32x4*)(kp + 4);
                    u32x4 hi; hi.x = pk2(x0[0], x0[1]); hi.y = pk2(x0[2], x0[3]); hi.z = pk2(x1[0], x1[1]); hi.w = pk2(x1[2], x1[3]);
                    u32x4 lo; lo.x = pk2(x0[0] - bflo(hi.x), x0[1] - bfhi(hi.x)); lo.y = pk2(x0[2] - bflo(hi.y), x0[3] - bfhi(hi.y));
                    lo.z = pk2(x1[0] - bflo(hi.z), x1[1] - bfhi(hi.z)); lo.w = pk2(x1[2] - bflo(hi.w), x1[3] - bfhi(hi.w));
                    Khi[tl][kk] = __builtin_bit_cast(bf16x8, hi); Klo[tl][kk] = __builtin_bit_cast(bf16x8, lo);
                }
        }
        const int t = b * 256 + wave * 32 + r;
        bf16x8 qf[8];
#pragma unroll
        for (int kk = 0; kk < 8; ++kk) qf[kk] = *(const bf16x8*)(QKVZ + (size_t)t * QK_STRIDE + h * 128 + kk * 16 + hh * 8);
        float v1 = -INFINITY, v2 = -INFINITY, v3 = -INFINITY; int i1 = 1 << 20, i2 = 1 << 20, i3 = 1 << 20;
#pragma unroll
        for (int tl = 0; tl < 2; ++tl) {
            if (tl == 1 && b <= 32) break;
            f32x16 Gt;
#pragma unroll
            for (int i = 0; i < 16; ++i) Gt[i] = 0.f;
#pragma unroll
            for (int kk = 0; kk < 8; ++kk) { Gt = MFMA32(Khi[tl][kk], qf[kk], Gt); Gt = MFMA32(Klo[tl][kk], qf[kk], Gt); }
#pragma unroll
            for (int i = 0; i < 16; ++i) { const int n = tl * 32 + (i & 3) + 8 * (i >> 2) + 4 * hh; if (n < b) TOP3_INSERT(Gt[i], n); }
        }
        {
            const float w1 = __shfl_xor(v1, 32), w2 = __shfl_xor(v2, 32), w3 = __shfl_xor(v3, 32);
            const int k1 = __shfl_xor(i1, 32), k2 = __shfl_xor(i2, 32), k3 = __shfl_xor(i3, 32);
            TOP3_INSERT(w1, k1); TOP3_INSERT(w2, k2); TOP3_INSERT(w3, k3);
        }
        __syncthreads();
        if (tid < 64) cntl[tid] = 0u;
        __syncthreads();
        unsigned lp1 = 0u, lp2 = 0u, lp3 = 0u;
        if (hh == 0) {
            if (i1 < 64) lp1 = atomicAdd(&cntl[i1], 1u);
            if (i2 < 64) lp2 = atomicAdd(&cntl[i2], 1u);
            if (i3 < 64) lp3 = atomicAdd(&cntl[i3], 1u);
        }
        __syncthreads();
        if (tid < 64) { const unsigned c = cntl[tid]; basel[tid] = (c && !dry) ? atomicAdd(&cnt[h * 64 + tid], c) : 0u; }
        __syncthreads();
        if (hh == 0 && !dry) {
            unsigned short* lh = lists + (size_t)h * LIST_PER_HEAD;
            if (i1 < 64) lh[list_off(i1) + basel[i1] + lp1] = (unsigned short)(t);
            if (i2 < 64) lh[list_off(i2) + basel[i2] + lp2] = (unsigned short)(t | (1 << 14));
            if (i3 < 64) lh[list_off(i3) + basel[i3] + lp3] = (unsigned short)(t | (2 << 14));
        }
    }
}

__device__ __forceinline__ void load_kv(const bf16_t* QKVZ, int h, int n, unsigned char* smem) {
    const int tid = tid_l();
    for (int e = tid; e < 4096; e += 512) {
        const int key = e >> 4, pc = e & 15;
        *(u32x4*)(smem + key * KL_STRIDE + pc * 16) = *(const u32x4*)(QKVZ + (size_t)(n * 256 + key) * QK_STRIDE + 1024 + h * 128 + pc * 8);
    }
    for (int e = tid; e < 4096; e += 512) {
        const int d = e >> 5, pc = e & 31, key0 = pc * 8;
        const u32x4 v = *(const u32x4*)(QKVZ + (size_t)(n * 256 + 2 * d + (key0 >> 7)) * QK_STRIDE + 2048 + h * 128 + (key0 & 127));
        u32x2* dst = (u32x2*)(smem + VT_OFF + d * VL_STRIDE + pc * 16);
        dst[0] = (u32x2){v.x, v.y}; dst[1] = (u32x2){v.z, v.w};
    }
}
__device__ __forceinline__ void attn_core(const unsigned char* smem, const bf16x8 (&qf)[8], int nkt, int mask_kt, int qidx, float c1, float c2, f32x16 (&O)[4], float& lsum) {
    const int lane = tid_l() & 63, r = lane & 31, hh = lane >> 5;
    for (int kt = 0; kt < nkt; ++kt) {
        f32x16 S;
#pragma unroll
        for (int i = 0; i < 16; ++i) S[i] = 0.f;
#pragma unroll
        for (int kk = 0; kk < 8; ++kk) { const bf16x8 A = *(const bf16x8*)(smem + (kt * 32 + r) * KL_STRIDE + (kk * 16 + hh * 8) * 2); S = MFMA32(A, qf[kk], S); }
        float p[16];
#pragma unroll
        for (int i = 0; i < 16; ++i) { p[i] = exp2f(S[i] * c1 - c2);
            if (kt == mask_kt) { const int key = kt * 32 + (i & 3) + 8 * (i >> 2) + 4 * hh; if (key > qidx) p[i] = 0.f; }
            lsum += p[i]; }
#pragma unroll
        for (int s = 0; s < 2; ++s) {
            u32x4 pw; pw.x = pk2(p[8 * s], p[8 * s + 1]); pw.y = pk2(p[8 * s + 2], p[8 * s + 3]); pw.z = pk2(p[8 * s + 4], p[8 * s + 5]); pw.w = pk2(p[8 * s + 6], p[8 * s + 7]);
            const bf16x8 pa = __builtin_bit_cast(bf16x8, pw);
#pragma unroll
            for (int dt = 0; dt < 4; ++dt) {
                const unsigned char* vp = smem + VT_OFF + (dt * 32 + r) * VL_STRIDE + (kt * 32 + 16 * s + 4 * hh) * 2;
                const s16x4 lo = *(const s16x4*)vp, hi = *(const s16x4*)(vp + 16);
                const bf16x8 Bv = __builtin_shufflevector(lo, hi, 0, 1, 2, 3, 4, 5, 6, 7);
                O[dt] = MFMA32(pa, Bv, O[dt]);
            }
        }
    }
}
__device__ __forceinline__ float attn_ref(ArgsP a, int j) {
    const int lane = tid_l() & 63;
    float mq = fmaxf(fabsf(a->in[15][j * 128 + lane]), fabsf(a->in[15][j * 128 + 64 + lane]));
    float mk = fmaxf(fabsf(a->in[16][j * 128 + lane]), fabsf(a->in[16][j * 128 + 64 + lane]));
#pragma unroll
    for (int o = 1; o < 64; o <<= 1) { mq = fmaxf(mq, __shfl_xor(mq, o)); mk = fmaxf(mk, __shfl_xor(mk, o)); }
    return 11.313708499f * mq * mk;
}
constexpr int LDS_LQ = 141312;

__device__ __forceinline__ void attn_a3(ArgsP a, int j, unsigned char* smem) {
    const int tid = tid_l(), lane = tid & 63, wave = tid >> 6, G = sg_l(gridDim.x), r = lane & 31, hh = lane >> 5;
    unsigned char* ws = a->ws;
    const bf16_t* QKVZ = (const bf16_t*)(ws + WS_BIG);
    const unsigned* cnt = (const unsigned*)(ws + WS_CTL); const unsigned short* lists = (const unsigned short*)(ws + WS_TAB);
    float* lpart = (float*)(ws + WS_LPART);
    int* pre = (int*)(smem + 140 * 1024);
    const float ref = attn_ref(a, j), c1 = 0.08838834764831845f * 1.4426950408889634f, c2 = ref * 1.4426950408889634f;
    __syncthreads();
    { const int c = (int)cnt[tid]; pre[tid] = (c + 255) >> 8; }
    __syncthreads();
    for (int o = 1; o < 512; o <<= 1) { const int v = pre[tid] + (tid >= o ? pre[tid - o] : 0); __syncthreads(); pre[tid] = v; __syncthreads(); }
    const int total = pre[511]; const int bidx = sg_l(blockIdx.x);
    const int t_lo = (int)(((long)total * bidx) / G), t_hi = (int)(((long)total * (bidx + 1)) / G);
    int cur_pr = -1;
    int e_cur = -1; bf16x8 qf[8];
    auto tile_info = [&](int tile, int& pr, int& tl) { int lo = 0, hi = 511; while (lo < hi) { const int mid = (lo + hi) >> 1; if (pre[mid] > tile) hi = mid; else lo = mid + 1; } pr = lo; tl = tile - (pr ? pre[pr - 1] : 0); };
    auto load_entry = [&](int tile) -> int { int pr, tl; tile_info(tile, pr, tl); const int h = pr >> 6, n = pr & 63, c = (int)cnt[pr]; const int li = tl * 256 + wave * 32 + r; const bool valid = li < c;
        const unsigned e = lists[(size_t)h * LIST_PER_HEAD + list_off(n) + (valid ? li : 0)]; return (int)e | (valid ? 0x10000 : 0); };
    if (t_lo < t_hi) { e_cur = load_entry(t_lo); int pr, tl; tile_info(t_lo, pr, tl); const int h = pr >> 6;
#pragma unroll
        for (int kk = 0; kk < 8; ++kk) qf[kk] = *(const bf16x8*)(QKVZ + (size_t)(e_cur & 0x3fff) * QK_STRIDE + h * 128 + kk * 16 + hh * 8); }
    for (int tile = t_lo; tile < t_hi; ++tile) {
        int pr, tl; tile_info(tile, pr, tl);
        const int h = pr >> 6, n = pr & 63;
        if (pr != cur_pr) { __syncthreads(); load_kv(QKVZ, h, n, smem); __syncthreads(); cur_pr = pr; }
        int e_nxt = -1; bf16x8 qn[8];
        if (tile + 1 < t_hi) { e_nxt = load_entry(tile + 1); int pr2, tl2; tile_info(tile + 1, pr2, tl2); const int h2 = pr2 >> 6;
#pragma unroll
            for (int kk = 0; kk < 8; ++kk) qn[kk] = *(const bf16x8*)(QKVZ + (size_t)(e_nxt & 0x3fff) * QK_STRIDE + h2 * 128 + kk * 16 + hh * 8); }
        else {
#pragma unroll
            for (int kk = 0; kk < 8; ++kk) qn[kk] = qf[kk];
        }
        f32x16 O[4];
#pragma unroll
        for (int dt = 0; dt < 4; ++dt)
#pragma unroll
            for (int i = 0; i < 16; ++i) O[dt][i] = 0.f;
        float lsum = 0.f;
        attn_core(smem, qf, 8, -1, 0, c1, c2, O, lsum);
        lsum += __shfl_xor(lsum, 32);
        if (hh == 0 && (e_cur & 0x10000)) lpart[((size_t)((e_cur >> 14) & 3) * L + (e_cur & 0x3fff)) * 8 + h] = lsum;
#pragma unroll
        for (int i = 0; i < 16; ++i) {
            const int ei = __shfl(e_cur, (i & 3) + 8 * (i >> 2) + 4 * hh);
            if (ei & 0x10000) {
                const int slot = (ei >> 14) & 3, ti = ei & 0x3fff;
                bf16_t* P = (bf16_t*)(ws + (slot == 0 ? WS_XN : (slot == 1 ? WS_P1 : WS_P2))) + (size_t)ti * DM + h * 128 + r * 4;
                u32x2 w; w.x = pk2(O[0][i], O[1][i]); w.y = pk2(O[2][i], O[3][i]);
                *(u32x2*)P = w;
            }
        }
        e_cur = e_nxt;
#pragma unroll
        for (int kk = 0; kk < 8; ++kk) qf[kk] = qn[kk];
    }
}
__device__ __forceinline__ void attn_a4(ArgsP a, int j, unsigned char* smem, int dry) {
    const int tid = tid_l(), lane = tid & 63, wave = tid >> 6, G = sg_l(gridDim.x), r = lane & 31, hh = lane >> 5;
    unsigned char* ws = a->ws;
    const bf16_t* QKVZ = (const bf16_t*)(ws + WS_BIG); const float* lpart = (const float*)(ws + WS_LPART);
    const float ref = attn_ref(a, j), c1 = 0.08838834764831845f * 1.4426950408889634f, c2 = ref * 1.4426950408889634f;
    float* lq = (float*)(smem + LDS_LQ) + wave * 32;
    const int qt = wave < 4 ? wave : 11 - wave;
    for (int unit = sg_l(blockIdx.x); unit < 512; unit += G) {
        const int h = unit & 7, b = unit >> 3;
        __syncthreads(); load_kv(QKVZ, h, b, smem); __syncthreads();
        const int qidx = qt * 32 + r, t = b * 256 + qidx;
        bf16x8 qf[8];
#pragma unroll
        for (int kk = 0; kk < 8; ++kk) qf[kk] = *(const bf16x8*)(QKVZ + (size_t)t * QK_STRIDE + h * 128 + kk * 16 + hh * 8);
        f32x16 O[4];
#pragma unroll
        for (int dt = 0; dt < 4; ++dt)
#pragma unroll
            for (int i = 0; i < 16; ++i) O[dt][i] = 0.f;
        float lsum = 0.f;
        attn_core(smem, qf, qt + 1, qt, qidx, c1, c2, O, lsum);
        lsum += __shfl_xor(lsum, 32);
        const int nsel = b < 3 ? b : 3;
        for (int s = 0; s < nsel; ++s) lsum += lpart[((size_t)s * L + t) * 8 + h];
        if (hh == 0) lq[r] = 1.0f / lsum;
        __builtin_amdgcn_wave_barrier(); asm volatile("s_waitcnt lgkmcnt(0)" ::: "memory");
#pragma unroll
        for (int i = 0; i < 16; ++i) {
            const int qi = (i & 3) + 8 * (i >> 2) + 4 * hh; const size_t ti = (size_t)(b * 256 + qt * 32 + qi);
            const float inv = lq[qi];
            float o0 = O[0][i], o1 = O[1][i], o2 = O[2][i], o3 = O[3][i];
            for (int s = 0; s < nsel; ++s) {
                const u32x2 pv = *(const u32x2*)((const bf16_t*)(ws + (s == 0 ? WS_XN : (s == 1 ? WS_P1 : WS_P2))) + ti * DM + h * 128 + r * 4);
                o0 += bflo(pv.x); o1 += bfhi(pv.x); o2 += bflo(pv.y); o3 += bfhi(pv.y);
            }
            const u32x2 zv = *(const u32x2*)(QKVZ + ti * QK_STRIDE + 3072 + h * 128 + r * 4);
            const float z0 = bflo(zv.x), z1 = bfhi(zv.x), z2 = bflo(zv.y), z3 = bfhi(zv.y);
            u32x2 w; w.x = pk2(o0 * inv * z0 * sigmoidf_(z0), o1 * inv * z1 * sigmoidf_(z1)); w.y = pk2(o2 * inv * z2 * sigmoidf_(z2), o3 * inv * z3 * sigmoidf_(z3));
            if (!dry) *(u32x2*)((bf16_t*)(ws + WS_XN) + ti * DM + h * 128 + r * 4) = w;
        }
        __builtin_amdgcn_wave_barrier();
    }
}

#define XB_TMO      128
#define XB_XCNT(j)  (256  + 64 * (j))
#define XB_XSUB(j)  (1280 + 64 * (j))
#define XB_XGEN(j)  (2304 + 64 * (j))
#define XB_TOP      3328
#define XB_TOPGEN   3392
#define XCD_BAR_WORDS 3456
#define XB_SPIN_CAP (1u << 22)
__device__ __forceinline__ unsigned xb_ld(unsigned* p)              { return __hip_atomic_load(p, __ATOMIC_RELAXED, __HIP_MEMORY_SCOPE_AGENT); }
__device__ __forceinline__ unsigned xb_add(unsigned* p, unsigned v) { return __hip_atomic_fetch_add(p, v, __ATOMIC_RELAXED, __HIP_MEMORY_SCOPE_AGENT); }
__device__ __forceinline__ unsigned xb_xcc_id() { return (unsigned)__builtin_amdgcn_s_getreg((3 << 11) | 20) & 0xFu; }
#define XB_SPIN(cond, bar) do { unsigned _sp = 0; while (cond) { __builtin_amdgcn_s_sleep(1); \
    if ((++_sp & 255u) == 0u) { if (xb_ld(&(bar)[XB_TMO])) break; if (_sp > XB_SPIN_CAP) { atomicAdd(&(bar)[XB_TMO], 1u); break; } } } } while (0)
struct XcdBarrier { unsigned* bar; unsigned x; volatile LAS unsigned* st; };
__device__ __forceinline__ XcdBarrier xcd_barrier_post(unsigned* bar, volatile LAS unsigned* st) {
    XcdBarrier b; b.bar = bar; b.x = xb_xcc_id(); b.st = st;
    if (threadIdx.x == 0) (void)xb_add(&bar[XB_XCNT(b.x)], 1u);
    return b;
}
__device__ __forceinline__ void xcd_barrier_complete(unsigned* bar, unsigned x, unsigned& nloc, unsigned& nx) {
    const unsigned G = gridDim.x * gridDim.y * gridDim.z;
    unsigned sum, cnt, mine, sp = 0u;
    for (;;) {
        sum = 0u; cnt = 0u; mine = 0u;
#pragma unroll
        for (unsigned j = 0; j < 16; ++j) { const unsigned c = xb_ld(&bar[XB_XCNT(j)]); sum += c; cnt += (c > 0u) ? 1u : 0u; mine = (j == x) ? c : mine; }
        if (sum == G) break;
        __builtin_amdgcn_s_sleep(1);
        if ((++sp & 255u) == 0u) { if (xb_ld(&bar[XB_TMO])) break; if (sp > XB_SPIN_CAP) { atomicAdd(&bar[XB_TMO], 1u); break; } }
    }
    nloc = mine > 0u ? mine : 1u; nx = cnt > 0u ? cnt : 1u;
}
__device__ __forceinline__ void xcd_barrier(const XcdBarrier& b) {
    asm volatile("s_waitcnt vmcnt(0)" ::: "memory");
    __syncthreads();
    if (threadIdx.x == 0) {
        unsigned* bar = b.bar;
        __builtin_amdgcn_s_waitcnt(0);
        unsigned nloc = b.st[0], nx = b.st[1];
        if (nloc == 0u) { xcd_barrier_complete(bar, b.x, nloc, nx); b.st[0] = nloc; b.st[1] = nx; }
        const unsigned old = xb_add(&bar[XB_XSUB(b.x)], 1u);
        const unsigned gen = old / nloc;
        if (old + 1u == (gen + 1u) * nloc) {
            __builtin_amdgcn_fence(__ATOMIC_RELEASE, "agent");
            asm volatile("s_waitcnt vmcnt(0)" ::: "memory");
            const unsigned og = xb_add(&bar[XB_TOP], 1u);
            const unsigned tg = og / nx;
            if (og + 1u == (tg + 1u) * nx) xb_add(&bar[XB_TOPGEN], 1u);
            else XB_SPIN(xb_ld(&bar[XB_TOPGEN]) == tg, bar);
            __builtin_amdgcn_fence(__ATOMIC_ACQUIRE, "agent");
            xb_add(&bar[XB_XGEN(b.x)], 1u);
            asm volatile("s_waitcnt vmcnt(0)" ::: "memory");
        } else {
            XB_SPIN(xb_ld(&bar[XB_XGEN(b.x)]) == gen, bar);
            __builtin_amdgcn_fence(__ATOMIC_ACQUIRE, "agent");
            asm volatile("s_waitcnt vmcnt(0)" ::: "memory");
        }
    }
    __syncthreads();
}
#ifndef PH_MASK
#define PH_MASK 0xFFFF
#endif
#define PH(b) ((PH_MASK >> (b)) & 1)
#ifndef REP_MASK
#define REP_MASK 0
#endif
#ifndef XSYNC
#define XSYNC 0
#endif
#define REP(b) for (int _r = 0; _r < 1 + ((REP_MASK >> (b)) & 1); ++_r)
__global__ void __launch_bounds__(512, 2) hybrid_fwd(Args a_unused) {
    extern __shared__ __attribute__((aligned(16))) unsigned char smem[];
    cg::grid_group grid = cg::this_grid();
    LAS unsigned char* lds = (LAS unsigned char*)smem;
    const ArgsP ap = (ArgsP)__builtin_amdgcn_kernarg_segment_ptr();
    if (threadIdx.x < 2) ((volatile LAS unsigned*)(lds + LDS_BARST))[threadIdx.x] = 0u;
    __syncthreads();
    if (blockIdx.x == 0) for (int e = threadIdx.x; e < XCD_BAR_WORDS; e += 512) ((unsigned*)(ap->ws + WS_BAR))[e] = 0u;

#define a launder(ap)
#define ws (launder(ap)->ws)
#define Wb ((bf16_t*)(ws + WS_W))
#define XN ((bf16_t*)(ws + WS_XN))
    REP(0) if (PH(0)) pre0_phase(a);
    grid.sync();
    const XcdBarrier xbar = xcd_barrier_post((unsigned*)(ws + WS_BAR), (volatile LAS unsigned*)(lds + LDS_BARST));
    for (int _x = 0; _x < XSYNC; ++_x) xcd_barrier(xbar);
    REP(0) if (PH(0)) prep_phase(a, 0, a->in[0], smem);
    xcd_barrier(xbar);
#pragma unroll 1
    for (int layer = 0; layer < 4; ++layer) {
        const int j = layer >> 1;
        if ((layer & 1) == 0) {
            REP(1) if (PH(1)) { pg8::Gemm g{layer == 0 ? XN : (bf16_t*)(ws + WS_Y2), Wb, L, 2048, 1024}; pg8::StaticOrder S; S.init(L, 2048, sg_l(gridDim.x), sg_l(blockIdx.x));
              pg8::EpiStore E{(bf16_t*)(ws + WS_U), 1024, 1024, (size_t)(WS_Z - WS_U) / 2, (const float*)(ws + WS_ROWSQ)};
              pg8::gemm_phase<pg8::EpiStore, pg8::StaticOrder, true, true>(lds, g, S, E); }
            xcd_barrier(xbar);
            REP(2) if (PH(2)) ssm_s1(a, smem);
            xcd_barrier(xbar);
            REP(3) if (PH(3)) ssm_s2(a, j, smem);
            xcd_barrier(xbar);
            REP(4) if (PH(4)) ssm_s3(a, j, smem);
            xcd_barrier(xbar);
            REP(5) if (PH(5)) { pg8::Gemm g{(const bf16_t*)(ws + WS_YG), Wb + 2048 * 1024, L, 1024, 1024}; pg8::StaticOrder S; S.init(L, 1024, sg_l(gridDim.x), sg_l(blockIdx.x));
              pg8::EpiGlu E{(const bf16_t*)(ws + WS_YG), (const bf16_t*)(ws + WS_Z), a->in[12] + j * 1024, (bf16_t*)(ws + WS_Y2)};
              pg8::gemm_phase<pg8::EpiGlu, pg8::StaticOrder, true, true>(lds, g, S, E); }
            xcd_barrier(xbar);
            REP(6) if (PH(6)) { pg8::Gemm g{(const bf16_t*)(ws + WS_Y2), Wb + 3072 * 1024, L, 1024, 1024}; pg8::StaticOrder S; S.init(L, 1024, sg_l(gridDim.x), sg_l(blockIdx.x));
              pg8::EpiRes E{layer == 0 ? a->in[0] : (const float*)a->out, a->out, layer < 3 ? XN : (bf16_t*)nullptr, (float*)(ws + WS_ROWSQ)};
              pg8::gemm_phase<pg8::EpiRes, pg8::StaticOrder, true, true>(lds, g, S, E); }
            xcd_barrier(xbar);
        } else {
            REP(7) if (PH(7)) { pg8::Gemm g{XN, Wb, L, 4096, 1024}; pg8::StaticOrder S; S.init(L, 4096, sg_l(gridDim.x), sg_l(blockIdx.x));
              pg8::EpiStore E{(bf16_t*)(ws + WS_BIG), 4096, 0, 0, (const float*)(ws + WS_ROWSQ)};
              pg8::gemm_phase<pg8::EpiStore, pg8::StaticOrder, true, true>(lds, g, S, E); }
            xcd_barrier(xbar);
            REP(8) if (PH(8)) attn_a1(a, j, smem, sg_l(_r == 0 && ((REP_MASK >> 8) & 1)));
            xcd_barrier(xbar);
            REP(9) if (PH(9)) attn_a2(a, smem, sg_l(_r == 0 && ((REP_MASK >> 9) & 1)));
            xcd_barrier(xbar);
            REP(10) if (PH(10)) attn_a3(a, j, smem);
            xcd_barrier(xbar);
            REP(11) if (PH(11)) attn_a4(a, j, smem, sg_l(_r == 0 && ((REP_MASK >> 11) & 1)));
            xcd_barrier(xbar);
            REP(12) if (PH(12)) { pg8::Gemm g{XN, Wb + 4096 * 1024, L, 1024, 1024}; pg8::StaticOrder S; S.init(L, 1024, sg_l(gridDim.x), sg_l(blockIdx.x));
              pg8::EpiRes E{(const float*)a->out, a->out, layer < 3 ? (bf16_t*)(ws + WS_Y2) : (bf16_t*)nullptr, (float*)(ws + WS_ROWSQ)};
              pg8::gemm_phase<pg8::EpiRes, pg8::StaticOrder, true, true>(lds, g, S, E); }
            xcd_barrier(xbar);
        }
        if (layer < 3) { REP(13) if (PH(13)) prep_phase(a, layer + 1, a->out, smem); xcd_barrier(xbar); }
    }
}

#undef a
#undef ws
#undef Wb
#undef XN
extern "C" void kernel_launch(void* const* d_in, const int* in_sizes, int n_in, void* d_out, int out_size, void* d_ws, size_t ws_size, hipStream_t stream) {
    static int grid = 0;
    if (grid == 0) {
        if (n_in != 18 || out_size != L * DM || ws_size < WS_END) { fprintf(stderr, "kernel_launch: unexpected shapes (n_in %d, out %d, ws %zu)\n", n_in, out_size, ws_size); grid = -1; return; }
        int dev = 0, cus = 0, per_cu = 0;
        (void)hipGetDevice(&dev); (void)hipDeviceGetAttribute(&cus, hipDeviceAttributeMultiprocessorCount, dev);
        (void)hipFuncSetAttribute((const void*)hybrid_fwd, hipFuncAttributeMaxDynamicSharedMemorySize, LDS_BYTES);
        (void)hipOccupancyMaxActiveBlocksPerMultiprocessor(&per_cu, (const void*)hybrid_fwd, 512, LDS_BYTES);
        if (per_cu < 1) { fprintf(stderr, "kernel_launch: occupancy query says %d blocks per CU\n", per_cu); per_cu = 1; }
        grid = cus * 1;
        if (grid > 256) grid = 256;
    }
    if (grid < 0) return;
    Args a{};
    for (int i = 0; i < 18; ++i) a.in[i] = (const float*)d_in[i];
    a.out = (float*)d_out; a.ws = (unsigned char*)d_ws;
    void* args[] = {&a};
    hipError_t e = hipLaunchCooperativeKernel((const void*)hybrid_fwd, dim3(grid), dim3(512), args, LDS_BYTES, stream);
    if (e != hipSuccess) fprintf(stderr, "cooperative launch failed: %s (grid %d)\n", hipGetErrorString(e), grid);
}
```

```cpp
#include <hip/hip_runtime.h>
#include <hip/hip_cooperative_groups.h>
#include <cstdio>
#include <cstdint>
namespace cg = cooperative_groups;

#define LAS __attribute__((address_space(3)))
typedef unsigned short bf16_t;
typedef short bf16x8 __attribute__((ext_vector_type(8)));
typedef short s16x4 __attribute__((ext_vector_type(4)));
typedef float f32x2 __attribute__((ext_vector_type(2)));
typedef float f32x4 __attribute__((ext_vector_type(4)));
typedef float f32x16 __attribute__((ext_vector_type(16)));
typedef unsigned u32x2 __attribute__((ext_vector_type(2)));
typedef unsigned u32x4 __attribute__((ext_vector_type(4)));
typedef __bf16 bf16v2 __attribute__((ext_vector_type(2)));

__device__ __forceinline__ unsigned pk2(float lo, float hi) { f32x2 v = {lo, hi}; bf16v2 b = __builtin_convertvector(v, bf16v2); return __builtin_bit_cast(unsigned, b); }
__device__ __forceinline__ float bflo(unsigned w) { return __uint_as_float(w << 16); }
__device__ __forceinline__ float bfhi(unsigned w) { return __uint_as_float(w & 0xffff0000u); }
__device__ __forceinline__ float sigmoidf_(float x) { return 1.0f / (1.0f + __expf(-x)); }
__device__ __forceinline__ float gelu_tanh(float y) { const float t = 0.7978845608028654f * (y + 0.044715f * y * y * y); const float e = __expf(2.0f * t); const float th = 1.0f - 2.0f / (e + 1.0f); return 0.5f * y * (1.0f + th); }

__device__ __forceinline__ int tid_l() { int t = threadIdx.x; asm volatile("" : "+v"(t)); return t; }
__device__ __forceinline__ int sg_l(int v) { v = __builtin_amdgcn_readfirstlane(v); asm volatile("" : "+s"(v)); return v; }
constexpr int L = 16384, DM = 1024, NH = 8, HD = 128, NBLK = 64;
constexpr size_t MiB = 1u << 20;
constexpr size_t WS_CTL = 0, WS_BAR = 16 * 1024, WS_KMEAN = 256 * 1024, WS_ROWSQ = 512 * 1024;
constexpr int LDS_BARST = 146432;
constexpr size_t WS_W = 1 * MiB, WS_TAB = 11 * MiB, WS_XN = 21 * MiB, WS_BIG = 53 * MiB;
constexpr size_t WS_U = WS_BIG, WS_Z = WS_BIG + 32 * MiB, WS_YG = WS_BIG + 64 * MiB, WS_Y2 = WS_BIG + 96 * MiB;
constexpr size_t WS_P1 = 181 * MiB, WS_P2 = 213 * MiB, WS_SLOC = 181 * MiB, WS_SIN = 213 * MiB;
constexpr size_t WS_LPART = 245 * MiB, WS_ROPE = 247 * MiB, WS_EP = 249 * MiB, WS_END = 251 * MiB;
constexpr int EP_STRIDE = 19 * 64 * 2;
constexpr int TAB_STRIDE = 147456;
constexpr int LIST_PER_HEAD = 516096;
__host__ __device__ __forceinline__ int list_off(int n) { return 16128 * n - 128 * n * (n - 1); }
constexpr int LDS_BYTES = 147456;
constexpr float NORM_EPS = 1e-6f;

namespace pg8 {
constexpr int M_ROWS = 16384;
constexpr int BM = 256, BK = 64, HALF = 128, HTB = HALF * BK * 2, STAGE_BYTES = 8 * HTB, NXCD = 8, WGM = 8;
__host__ __device__ __forceinline__ int lds_byte(int r, int c) { const int st = (r >> 4) * 2 + (c >> 5), rr = r & 15, cc = c & 31, ob = rr * 64 + cc * 2; return st * 1024 + (ob ^ (((ob >> 9) & 1) << 5)); }
__host__ __device__ __forceinline__ void stage_rc(int b, int& R, int& C) { const int st = b / 1024, sb = b % 1024, swz = sb ^ (((sb >> 9) & 1) << 5); R = (st >> 1) * 16 + swz / 64; C = (st & 1) * 32 + (swz % 64) / 2; }
__host__ __device__ __forceinline__ int perm32(int rho) { const int n = rho >> 4, i = rho & 15; return 8 * (i >> 2) + 4 * n + (i & 3); }
struct Unit { int pm, pn; };
struct Gemm { const bf16_t* A; const bf16_t* Bt; int M, N, K; };
struct StaticOrder {
    int nM, nN, nwg, G, c;
    __host__ __device__ void init(int M, int N, int G_, int c_) { nM = M / BM; nN = N / BM; nwg = nM * nN; G = G_; c = c_; }
    __host__ __device__ bool next(int i, Unit& u) const {
        const long Lx = (long)i * G + c; if (Lx >= nwg) return false;
        int wgid = (int)Lx; { const int q = nwg / NXCD, r = nwg % NXCD, xcd = wgid % NXCD, off = wgid / NXCD; wgid = (xcd < r ? xcd * (q + 1) : r * (q + 1) + (xcd - r) * q) + off; }
        const int nig = WGM * nN, gid = wgid / nig, fm = gid * WGM, gsz = (nM - fm) < WGM ? (nM - fm) : WGM;
        u.pm = fm + ((wgid % nig) % gsz); u.pn = (wgid % nig) / gsz; return true;
    }
    __device__ __forceinline__ void a_ready(const Unit&) const {}
    __device__ __forceinline__ void done(const Unit&) const {}
};

struct EpiStore {
    static constexpr bool PERM = true, AFTER_DRAIN = false;
    bf16_t* O; int ldc; int split_cols; size_t split_stride; const float* rowsq; int ugm;
    __device__ __forceinline__ void operator()(const f32x4 (&acc)[2][2][4][2], const Unit& u, int wr, int wc, int fr, int fq) const {
        const int row0 = u.pm * BM + wr * 64 + fr; int colt = u.pn * BM; bf16_t* base = O;
        if (split_cols) { const int t = colt / split_cols; base += (size_t)t * split_stride; colt -= t * split_cols; }
        const int col0 = colt + wc * 32 + 8 * fq; const bool gm = ugm && base == O;
#pragma unroll
        for (int ai = 0; ai < 2; ++ai)
#pragma unroll
            for (int m = 0; m < 4; ++m) { bf16_t* rowp = gm ? base + ((size_t)(col0 >> 4) * M_ROWS + (row0 + ai * HALF + m * 16)) * 16 + (col0 & 15) : base + (size_t)(row0 + ai * HALF + m * 16) * ldc + col0;
                const float rs = rsqrtf(rowsq[row0 + ai * HALF + m * 16] * (1.f / 1024.f) + NORM_EPS);
#pragma unroll
                for (int bj = 0; bj < 2; ++bj) { const f32x4 v0 = acc[ai][bj][m][0] * rs, v1 = acc[ai][bj][m][1] * rs;
                    u32x4 w; w.x = pk2(v0[0], v0[1]); w.y = pk2(v0[2], v0[3]); w.z = pk2(v1[0], v1[1]); w.w = pk2(v1[2], v1[3]);
                    *(u32x4*)(rowp + (gm ? (size_t)bj * 8 * M_ROWS * 16 : (size_t)bj * HALF)) = w; } }
    }
};
struct EpiGlu {
    static constexpr bool PERM = true, AFTER_DRAIN = false;
    const bf16_t* YG; const bf16_t* Z; const float* bias; bf16_t* O;
    __device__ __forceinline__ void operator()(const f32x4 (&acc)[2][2][4][2], const Unit& u, int wr, int wc, int fr, int fq) const {
        const int row0 = u.pm * BM + wr * 64 + fr; const int col0 = u.pn * BM + wc * 32 + 8 * fq;
#pragma unroll
        for (int bj = 0; bj < 2; ++bj) {
            const f32x4 b0 = *(const f32x4*)(bias + col0 + bj * HALF), b1 = *(const f32x4*)(bias + col0 + bj * HALF + 4);
#pragma unroll
            for (int ai = 0; ai < 2; ++ai)
#pragma unroll
                for (int m = 0; m < 4; ++m) {
                    const size_t off = (size_t)(row0 + ai * HALF + m * 16) * DM + col0 + bj * HALF;
                    const int colg = col0 + bj * HALF;
                    const u32x4 yv = *(const u32x4*)(YG + ((size_t)(colg >> 4) * M_ROWS + (row0 + ai * HALF + m * 16)) * 16 + (colg & 15)), zv = *(const u32x4*)(Z + off);
                    const f32x4 v0 = acc[ai][bj][m][0] + b0, v1 = acc[ai][bj][m][1] + b1;
                    float r[8];
#pragma unroll
                    for (int q = 0; q < 4; ++q) {
                        const float a0 = q < 2 ? v0[2 * q] : v1[2 * q - 4], a1 = q < 2 ? v0[2 * q + 1] : v1[2 * q - 3];
                        const float y0 = bflo(yv[q]), y1 = bfhi(yv[q]), z0 = bflo(zv[q]), z1 = bfhi(zv[q]);
                        r[2 * q] = y0 * sigmoidf_(a0) * (z0 * sigmoidf_(z0)); r[2 * q + 1] = y1 * sigmoidf_(a1) * (z1 * sigmoidf_(z1));
                    }
                    u32x4 w; w.x = pk2(r[0], r[1]); w.y = pk2(r[2], r[3]); w.z = pk2(r[4], r[5]); w.w = pk2(r[6], r[7]);
                    *(u32x4*)(O + off) = w;
                }
        }
    }
};
struct EpiRes {
    static constexpr bool PERM = true, AFTER_DRAIN = false;
    const float* base; float* out; bf16_t* xn; float* rowsq;
    __device__ __forceinline__ void operator()(const f32x4 (&acc)[2][2][4][2], const Unit& u, int wr, int wc, int fr, int fq) const {
        const int row0 = u.pm * BM + wr * 64 + fr; const int col0 = u.pn * BM + wc * 32 + 8 * fq;
#pragma unroll
        for (int ai = 0; ai < 2; ++ai)
#pragma unroll
            for (int m = 0; m < 4; ++m) {
                float ss = 0.f;
#pragma unroll
                for (int bj = 0; bj < 2; ++bj) {
                    const size_t off = (size_t)(row0 + ai * HALF + m * 16) * DM + col0 + bj * HALF;
                    const f32x4 v0 = *(const f32x4*)(base + off) + acc[ai][bj][m][0], v1 = *(const f32x4*)(base + off + 4) + acc[ai][bj][m][1];
                    *(f32x4*)(out + off) = v0; *(f32x4*)(out + off + 4) = v1;
                    if (xn) {
                        u32x4 w; w.x = pk2(v0[0], v0[1]); w.y = pk2(v0[2], v0[3]); w.z = pk2(v1[0], v1[1]); w.w = pk2(v1[2], v1[3]);
                        *(u32x4*)(xn + off) = w;
                        ss += (v0[0] * v0[0] + v0[1] * v0[1]) + (v0[2] * v0[2] + v0[3] * v0[3]) + (v1[0] * v1[0] + v1[1] * v1[1]) + (v1[2] * v1[2] + v1[3] * v1[3]);
                    }
                }
                if (xn) { ss += __shfl_xor(ss, 16); ss += __shfl_xor(ss, 32); if (fq == 0) atomicAdd(rowsq + row0 + ai * HALF + m * 16, ss); }
            }
    }
};

template <class Epi, class Sched, bool ALIGN_EPI = false, bool SP2 = false, bool AGM = false>
__device__ __forceinline__ void gemm_phase(LAS unsigned char* lds, const Gemm g, const Sched& S, const Epi& E) {
    const int tid = tid_l(), wid = __builtin_amdgcn_readfirstlane(tid >> 6), lane = tid & 63, wr = wid >> 2, wc = wid & 3, fr = lane & 15, fq = lane >> 4;
    const int K = g.K, nt = K / BK;
    unsigned voffA[2], voffB[2];
#pragma unroll
    for (int i = 0; i < 2; ++i) { int R, C; stage_rc(tid * 16 + i * 8192, R, C); const int Rb = Epi::PERM ? ((R & ~31) + perm32(R & 31)) : R;
        voffA[i] = AGM ? (unsigned)(((C >> 4) * M_ROWS + R) * 16 + (C & 15)) * 2u : (unsigned)(R * K + C) * 2u; voffB[i] = (unsigned)(Rb * K + C) * 2u; }
    const size_t kstep = (size_t)(BK * 2);
    const size_t hstep = (size_t)HALF * K * 2;
    const size_t tstep = 2 * hstep;
    const size_t kstepA = AGM ? (size_t)4 * M_ROWS * 32 : kstep, hstepA = AGM ? (size_t)HALF * 32 : hstep, tstepA = 2 * hstepA;
    const unsigned ldsw = (unsigned)wid * 1024u;
    const int aoff = lds_byte(wr * 64 + fr, fq * 8), boff = lds_byte(wc * 32 + fr, fq * 8);
#define PG8_SA(b, h) (((b) * 2 + (h)) * HTB)
#define PG8_SB(b, h) ((4 + (b) * 2 + (h)) * HTB)
#define PG8_STAGE(bufoff, gbase, voff) do { _Pragma("unroll") for (int _i = 0; _i < 2; ++_i) \
        __builtin_amdgcn_global_load_lds((const unsigned*)((const char*)(gbase) + (voff)[_i]), (LAS unsigned*)(lds + (bufoff) + ldsw + _i * 8192), 16, 0, 0); } while (0)
#define PG8_LDA(dst, b, h) do { _Pragma("unroll") for (int m = 0; m < 4; ++m) _Pragma("unroll") for (int k = 0; k < 2; ++k) dst[m][k] = *(const LAS bf16x8*)(lds + PG8_SA(b, h) + aoff + m * 2048 + k * 1024); } while (0)
#define PG8_LDB(dst, b, h) do { _Pragma("unroll") for (int n = 0; n < 2; ++n) _Pragma("unroll") for (int k = 0; k < 2; ++k) dst[n][k] = *(const LAS bf16x8*)(lds + PG8_SB(b, h) + boff + n * 2048 + k * 1024); } while (0)
#define PG8_MMA(ai, bj, At, Bt) do { __builtin_amdgcn_s_setprio(1); _Pragma("unroll") for (int m = 0; m < 4; ++m) _Pragma("unroll") for (int n = 0; n < 2; ++n) _Pragma("unroll") for (int k = 0; k < 2; ++k) \
        acc[ai][bj][m][n] = __builtin_amdgcn_mfma_f32_16x16x32_bf16(Bt[n][k], At[m][k], acc[ai][bj][m][n], 0, 0, 0); __builtin_amdgcn_s_setprio(0); } while (0)
#define PG8_WAIT_V(n) asm volatile("s_waitcnt vmcnt(" #n ")" ::: "memory")
#define PG8_WAIT_L(n) asm volatile("s_waitcnt lgkmcnt(" #n ")" ::: "memory")
#define PG8_BAR __builtin_amdgcn_s_barrier()
#define PG8_SCHED __builtin_amdgcn_sched_barrier(0)
    Unit cur, nxt; int ui = 0;
    if (!S.next(0, cur)) return;
    f32x4 acc[2][2][4][2];
#pragma unroll
    for (int a = 0; a < 2; ++a)
#pragma unroll
        for (int b = 0; b < 2; ++b)
#pragma unroll
            for (int m = 0; m < 4; ++m)
#pragma unroll
                for (int n = 0; n < 2; ++n) acc[a][b][m][n] = (f32x4){0.f, 0.f, 0.f, 0.f};
    bf16x8 At[4][2], B0[2][2], B1[2][2];
    const char* cA = (const char*)g.A + (size_t)cur.pm * tstepA; const char* cB = (const char*)g.Bt + (size_t)cur.pn * tstep;
    S.a_ready(cur);
    if constexpr (SP2) {
        PG8_STAGE(PG8_SB(0, 0), cB, voffB); PG8_STAGE(PG8_SB(0, 1), cB + hstep, voffB); PG8_STAGE(PG8_SA(0, 0), cA, voffA); PG8_STAGE(PG8_SA(0, 1), cA + hstepA, voffA);
        if (wr == 1) PG8_BAR;
        PG8_WAIT_V(2); PG8_BAR;
        PG8_STAGE(PG8_SB(1, 0), cB + kstep, voffB); PG8_STAGE(PG8_SA(1, 0), cA + kstepA, voffA); PG8_STAGE(PG8_SB(1, 1), cB + hstep + kstep, voffB);
        PG8_WAIT_V(6); PG8_BAR;
    } else {
        PG8_STAGE(PG8_SB(0, 0), cB, voffB); PG8_STAGE(PG8_SA(0, 0), cA, voffA); PG8_STAGE(PG8_SB(0, 1), cB + hstep, voffB); PG8_STAGE(PG8_SA(0, 1), cA + hstepA, voffA);
        if (wr == 1) PG8_BAR;
        PG8_WAIT_V(4); PG8_BAR;
        PG8_STAGE(PG8_SB(1, 0), cB + kstep, voffB); PG8_STAGE(PG8_SA(1, 0), cA + kstepA, voffA); PG8_STAGE(PG8_SB(1, 1), cB + hstep + kstep, voffB);
        PG8_WAIT_V(6); PG8_BAR;
    }
    for (;;) {
        const bool has_next = S.next(ui + 1, nxt);
        const char* nA = has_next ? (const char*)g.A + (size_t)nxt.pm * tstepA : cA; const char* nB = has_next ? (const char*)g.Bt + (size_t)nxt.pn * tstep : cB;
        for (int t = 0; t < nt; t += 2) {
            const bool last = (t == nt - 2);
            const char* a1 = cA + (size_t)(t + 1) * kstepA;
            const char* a2 = last ? nA : cA + (size_t)(t + 2) * kstepA; const char* b2 = last ? nB : cB + (size_t)(t + 2) * kstep;
            const char* a3 = a2 + kstepA; const char* b3 = b2 + kstep;
            if (last && has_next) S.a_ready(nxt);
            if constexpr (SP2) {
            PG8_LDB(B0, 0, 0); PG8_LDB(B1, 0, 1); PG8_SCHED; PG8_LDA(At, 0, 0); PG8_STAGE(PG8_SA(1, 1), a1 + hstepA, voffA);
            PG8_WAIT_V(8); PG8_WAIT_L(0); PG8_BAR; PG8_MMA(0, 0, At, B0); PG8_MMA(0, 1, At, B1); PG8_BAR; PG8_SCHED;
            PG8_LDA(At, 0, 1); PG8_STAGE(PG8_SB(0, 0), b2, voffB); PG8_STAGE(PG8_SB(0, 1), b2 + hstep, voffB); PG8_STAGE(PG8_SA(0, 0), a2, voffA);
            PG8_WAIT_V(8); PG8_WAIT_L(0); PG8_BAR; PG8_MMA(1, 0, At, B0); PG8_MMA(1, 1, At, B1); PG8_BAR; PG8_SCHED;
            PG8_LDB(B0, 1, 0); PG8_LDB(B1, 1, 1); PG8_SCHED; PG8_LDA(At, 1, 0); PG8_STAGE(PG8_SA(0, 1), a2 + hstepA, voffA);
            PG8_WAIT_V(8); PG8_WAIT_L(0); PG8_BAR; PG8_MMA(0, 0, At, B0); PG8_MMA(0, 1, At, B1); PG8_BAR; PG8_SCHED;
            PG8_LDA(At, 1, 1); PG8_STAGE(PG8_SB(1, 0), b3, voffB); PG8_STAGE(PG8_SB(1, 1), b3 + hstep, voffB); PG8_STAGE(PG8_SA(1, 0), a3, voffA);
            PG8_WAIT_V(8); PG8_WAIT_L(0); PG8_BAR; PG8_MMA(1, 0, At, B0); PG8_MMA(1, 1, At, B1); PG8_BAR; PG8_SCHED;
            } else {
            PG8_LDB(B0, 0, 0); PG8_SCHED; PG8_LDA(At, 0, 0); PG8_STAGE(PG8_SA(1, 1), a1 + hstepA, voffA);
            PG8_WAIT_L(8); PG8_BAR; PG8_WAIT_L(0); PG8_MMA(0, 0, At, B0); PG8_BAR; PG8_SCHED;
            PG8_LDB(B1, 0, 1); PG8_STAGE(PG8_SB(0, 0), b2, voffB);
            PG8_BAR; PG8_WAIT_L(0); PG8_MMA(0, 1, At, B1); PG8_BAR;
            PG8_LDA(At, 0, 1); PG8_STAGE(PG8_SA(0, 0), a2, voffA);
            PG8_BAR; PG8_WAIT_L(0); PG8_MMA(1, 0, At, B0); PG8_BAR; PG8_SCHED;
            PG8_STAGE(PG8_SB(0, 1), b2 + hstep, voffB);
            PG8_WAIT_V(6); PG8_BAR; PG8_MMA(1, 1, At, B1); PG8_BAR;
            PG8_LDB(B0, 1, 0); PG8_SCHED; PG8_LDA(At, 1, 0); PG8_STAGE(PG8_SA(0, 1), a2 + hstepA, voffA);
            PG8_WAIT_L(8); PG8_BAR; PG8_WAIT_L(0); PG8_MMA(0, 0, At, B0); PG8_BAR; PG8_SCHED;
            PG8_LDB(B1, 1, 1); PG8_STAGE(PG8_SB(1, 0), b3, voffB);
            PG8_BAR; PG8_WAIT_L(0); PG8_MMA(0, 1, At, B1); PG8_BAR;
            PG8_LDA(At, 1, 1); PG8_STAGE(PG8_SA(1, 0), a3, voffA);
            PG8_BAR; PG8_WAIT_L(0); PG8_MMA(1, 0, At, B0); PG8_BAR; PG8_SCHED;
            PG8_STAGE(PG8_SB(1, 1), b3 + hstep, voffB);
            PG8_WAIT_V(6); PG8_BAR; PG8_MMA(1, 1, At, B1); PG8_BAR;
            }
        }
        if constexpr (ALIGN_EPI) { if (wr == 0) PG8_BAR; }
        if constexpr (!Epi::AFTER_DRAIN) { E(acc, cur, wr, wc, fr, fq); S.done(cur); }
        if (!has_next) break;
#pragma unroll
        for (int a = 0; a < 2; ++a)
#pragma unroll
            for (int b = 0; b < 2; ++b)
#pragma unroll
                for (int m = 0; m < 4; ++m)
#pragma unroll
                    for (int n = 0; n < 2; ++n) acc[a][b][m][n] = (f32x4){0.f, 0.f, 0.f, 0.f};
        cur = nxt; cA = nA; cB = nB; ++ui;
        if constexpr (ALIGN_EPI) { if (wr == 1) PG8_BAR; }
    }
    PG8_WAIT_V(0);
    if constexpr (!ALIGN_EPI) { if (wr == 0) PG8_BAR; }
    PG8_BAR;
#undef PG8_SA
#undef PG8_SB
#undef PG8_STAGE
#undef PG8_LDA
#undef PG8_LDB
#undef PG8_MMA
#undef PG8_WAIT_V
#undef PG8_WAIT_L
#undef PG8_BAR
#undef PG8_SCHED
}
}

struct Args { const float* in[18]; float* out; unsigned char* ws; };
typedef const __attribute__((address_space(4))) Args* ArgsP;
__device__ __forceinline__ ArgsP launder(ArgsP p) { asm volatile("" : "+s"(p)); return p; }

#define MFMA16(a, b, c) __builtin_amdgcn_mfma_f32_16x16x32_bf16((a), (b), (c), 0, 0, 0)
#define MFMA32(a, b, c) __builtin_amdgcn_mfma_f32_32x32x16_bf16((a), (b), (c), 0, 0, 0)

__device__ __forceinline__ float wave_sum(float v) {
#pragma unroll
    for (int o = 1; o < 64; o <<= 1) v += __shfl_xor(v, o);
    return v;
}

__device__ __forceinline__ int head_perm(int x) { const int pos = x & 127; return (x & ~127) + (pos & 3) * 32 + (pos >> 2); }
template <int MODE, bool GAIN>
__device__ __forceinline__ void transpose_item(const float* W, int K, int N, bf16_t* WT, float* scr, int item, int lane, const float* gain = nullptr) {
    const int nblk = N / 32, kb = item / nblk, nb = item % nblk, k0 = 64 * kb, n0 = 32 * nb;
#pragma unroll 8
    for (int i = 0; i < 32; ++i) { const int kk = 2 * i + (lane >> 5); int sk = k0 + kk, sn = n0 + (lane & 31);
        if (MODE == 1 && sn >= 3072) sn = head_perm(sn);
        if (MODE == 2) sk = head_perm(sk);
        scr[kk * 33 + (lane & 31)] = W[(size_t)sk * N + sn] * (GAIN ? gain[sk] : 1.f); }
    __builtin_amdgcn_wave_barrier(); asm volatile("s_waitcnt lgkmcnt(0)" ::: "memory");
    const int c = lane & 7;
#pragma unroll
    for (int j = 0; j < 4; ++j) { const int n = (lane >> 3) + 8 * j; const float* s = scr + (8 * c) * 33 + n;
        u32x4 o; o.x = pk2(s[0 * 33], s[1 * 33]); o.y = pk2(s[2 * 33], s[3 * 33]); o.z = pk2(s[4 * 33], s[5 * 33]); o.w = pk2(s[6 * 33], s[7 * 33]);
        *(u32x4*)(WT + (size_t)(n0 + n) * K + k0 + 8 * c) = o; }
    asm volatile("s_waitcnt lgkmcnt(0)" ::: "memory"); __builtin_amdgcn_wave_barrier();
}

__device__ __forceinline__ void ssm_tables(ArgsP a, int j, int g, unsigned char* smem, unsigned char* tab) {
    float* Epow = (float*)smem;
    float* Bb = Epow + 17 * 64 * 2;
    float* Cc = Bb + 64 * 16 * 2;
    float* Fp = Cc + 16 * 64 * 2;
    float* Km = Fp + 128;
    const int tid = tid_l();
    const float* a_re = a->in[3] + (size_t)(j * 64 + g) * 64; const float* a_im = a->in[4] + (size_t)(j * 64 + g) * 64;
    const float* b_re = a->in[6] + (size_t)(j * 64 + g) * 64 * 16; const float* b_im = a->in[7] + (size_t)(j * 64 + g) * 64 * 16;
    const float* c_re = a->in[8] + (size_t)(j * 64 + g) * 16 * 64; const float* c_im = a->in[9] + (size_t)(j * 64 + g) * 16 * 64;
    { const float* ep = (const float*)(a->ws + WS_EP) + (size_t)(j * 64 + g) * EP_STRIDE;
      for (int e = tid; e < 17 * 64 * 2; e += 512) Epow[e] = ep[e];
      if (tid < 128) Fp[tid] = ep[18 * 128 + tid]; }
    __syncthreads();
    for (int e = tid; e < 1024; e += 512) {
        { const int p = e >> 4; const float fr_ = Fp[p * 2], fi_ = Fp[p * 2 + 1], br = b_re[e], bi = b_im[e];
          Bb[e * 2] = fr_ * br - fi_ * bi; Bb[e * 2 + 1] = fr_ * bi + fi_ * br; }
        Cc[e * 2] = c_re[e]; Cc[e * 2 + 1] = c_im[e];
    }
    __syncthreads();
    for (int e = tid; e < 4096; e += 512) {
        const int d = e >> 8, c = (e >> 4) & 15, c2 = e & 15; float acc = 0.f;
        for (int p = 0; p < 64; ++p) {
            const float ar = Epow[(d * 64 + p) * 2], ai = Epow[(d * 64 + p) * 2 + 1], br = Bb[(p * 16 + c2) * 2], bi = Bb[(p * 16 + c2) * 2 + 1];
            const float gr = ar * br - ai * bi, gi = ar * bi + ai * br;
            acc += Cc[(c * 64 + p) * 2] * gr - Cc[(c * 64 + p) * 2 + 1] * gi;
        }
        Km[e] = acc;
    }
    __syncthreads();
    for (int e = tid; e < 16 * 64; e += 512) {
        const int d = e >> 6, l = e & 63, c = l & 15, ts = l >> 5, c0 = ((l >> 4) & 1) * 8, dd = d - ts; float v[8];
#pragma unroll
        for (int jj = 0; jj < 8; ++jj) v[jj] = dd >= 0 ? Km[(dd * 16 + c) * 16 + c0 + jj] : 0.f;
        u32x4 w; w.x = pk2(v[0], v[1]); w.y = pk2(v[2], v[3]); w.z = pk2(v[4], v[5]); w.w = pk2(v[6], v[7]);
        *(u32x4*)(tab + d * 1024 + l * 16) = w;
    }
    for (int e = tid; e < 64 * 64; e += 512) {
        const int f = e >> 6, l = e & 63, mt = f >> 3, ks = f & 7, m = mt * 16 + (l & 15), p = m >> 1, ri = m & 1, tau = ks * 2 + (l >> 5), c0 = ((l >> 4) & 1) * 8;
        const float ar = Epow[((15 - tau) * 64 + p) * 2], ai = Epow[((15 - tau) * 64 + p) * 2 + 1]; float v[8];
#pragma unroll
        for (int jj = 0; jj < 8; ++jj) { const float br = Bb[(p * 16 + c0 + jj) * 2], bi = Bb[(p * 16 + c0 + jj) * 2 + 1]; v[jj] = ri == 0 ? (ar * br - ai * bi) : (ar * bi + ai * br); }
        u32x4 w; w.x = pk2(v[0], v[1]); w.y = pk2(v[2], v[3]); w.z = pk2(v[4], v[5]); w.w = pk2(v[6], v[7]);
        *(u32x4*)(tab + 16384 + f * 1024 + l * 16) = w;
    }
    for (int e = tid; e < 64 * 64; e += 512) {
        const int f = e >> 6, l = e & 63, t = f >> 2, kk = f & 3, c = l & 15, m0 = kk * 32 + (l >> 4) * 8; float v[8];
#pragma unroll
        for (int jj = 0; jj < 8; ++jj) { const int m = m0 + jj, p = m >> 1, ri = m & 1;
            const float ar = Epow[((t + 1) * 64 + p) * 2], ai = Epow[((t + 1) * 64 + p) * 2 + 1], cr = Cc[(c * 64 + p) * 2], ci = Cc[(c * 64 + p) * 2 + 1];
            v[jj] = ri == 0 ? (cr * ar - ci * ai) : -(cr * ai + ci * ar); }
        u32x4 w; w.x = pk2(v[0], v[1]); w.y = pk2(v[2], v[3]); w.z = pk2(v[4], v[5]); w.w = pk2(v[6], v[7]);
        *(u32x4*)(tab + 16384 + 65536 + f * 1024 + l * 16) = w;
    }
    __syncthreads();
}

__device__ __forceinline__ void pre0_phase(ArgsP a) {
    const int tid = tid_l(), G = sg_l(gridDim.x), bid = sg_l(blockIdx.x);
    unsigned char* ws = a->ws;
    float* rope = (float*)(ws + WS_ROPE);
    for (int e = bid * 512 + tid; e < L * 16; e += G * 512) {
        const int pos = e >> 4, i = e & 15;
        const double invf = exp(-(double)i * (1.0 / 16.0) * 13.122363377404328);
        double ang = (double)pos * invf; ang -= 6.283185307179586476925 * floor(ang / 6.283185307179586476925);
        rope[e * 2] = (float)cos(ang); rope[e * 2 + 1] = (float)sin(ang);
    }
    float* epb = (float*)(ws + WS_EP);
    for (int e = bid * 512 + tid; e < 2 * 64 * 19 * 64; e += G * 512) {
        const int p = e & 63, n = (e >> 6) % 19, jg = (e >> 6) / 19;
        const double dt = exp((double)a->in[5][jg]);
        const double lr = (double)a->in[3][(size_t)jg * 64 + p], li = (double)a->in[4][(size_t)jg * 64 + p];
        const double pw = n <= 16 ? (double)n : (n == 17 ? 512.0 : 1.0);
        const double mag = exp(lr * dt * pw); double ang = li * dt * pw; ang -= 6.283185307179586476925 * floor(ang / 6.283185307179586476925);
        double cr = cos(ang) * mag, ci = sin(ang) * mag;
        if (n == 18) { const double nr = cr - 1.0, ni = ci, den = lr * lr + li * li; cr = (nr * lr + ni * li) / den; ci = (ni * lr - nr * li) / den; }
        epb[(size_t)jg * EP_STRIDE + (n * 64 + p) * 2] = (float)cr; epb[(size_t)jg * EP_STRIDE + (n * 64 + p) * 2 + 1] = (float)ci;
    }
}
__device__ __forceinline__ void prep_phase(ArgsP a, int layer, const float* h, unsigned char* smem) {
    const int tid = tid_l(), lane = tid & 63, wave = tid >> 6, G = sg_l(gridDim.x), bid = sg_l(blockIdx.x);
    unsigned char* ws = a->ws;
    const int j = layer >> 1;
    if ((layer & 1) == 0) {
        for (int g = bid; g < 64; g += G) ssm_tables(a, j, g, smem, ws + WS_TAB + (size_t)g * TAB_STRIDE);
    }
    __syncthreads();
    float* scr = (float*)(smem + wave * 16384);
    const int gw = bid * 8 + wave, NGW = G * 8;
    bf16_t* Wb = (bf16_t*)(ws + WS_W);
    const float* gain = a->in[1] + layer * 1024;
    if ((layer & 1) == 0) {
        const float* w_in = a->in[2] + (size_t)j * 1024 * 2048; const float* w_glu = a->in[11] + (size_t)j * 1024 * 1024; const float* w_out = a->in[13] + (size_t)j * 1024 * 1024;
        for (int it = gw; it < 2048; it += NGW) {
            if (it < 1024) transpose_item<0, true>(w_in, 1024, 2048, Wb, scr, it, lane, gain);
            else if (it < 1536) transpose_item<0, false>(w_glu, 1024, 1024, Wb + 2048 * 1024, scr, it - 1024, lane);
            else transpose_item<0, false>(w_out, 1024, 1024, Wb + 3072 * 1024, scr, it - 1536, lane);
        }
    } else {
        const float* w_in = a->in[14] + (size_t)j * 1024 * 4096; const float* w_out = a->in[17] + (size_t)j * 1024 * 1024;
        for (int it = gw; it < 2560; it += NGW) {
            if (it < 2048) transpose_item<1, true>(w_in, 1024, 4096, Wb, scr, it, lane, gain);
            else transpose_item<2, false>(w_out, 1024, 1024, Wb + 4096 * 1024, scr, it - 2048, lane);
        }
    }
    if (layer == 0) {
        bf16_t* XN = (bf16_t*)(ws + WS_XN); float* rowsq = (float*)(ws + WS_ROWSQ);
        for (int m = gw; m < L; m += NGW) {
            const f32x4* xr = (const f32x4*)(h + (size_t)m * DM) + lane;
            f32x4 v[4]; float s = 0.f;
#pragma unroll
            for (int q = 0; q < 4; ++q) { v[q] = xr[64 * q]; s += (v[q].x * v[q].x + v[q].y * v[q].y) + (v[q].z * v[q].z + v[q].w * v[q].w); }
            s = wave_sum(s);
            if (lane == 0) rowsq[m] = s;
            u32x2* o8 = (u32x2*)(XN + (size_t)m * DM) + lane;
#pragma unroll
            for (int q = 0; q < 4; ++q) { u32x2 w; w.x = pk2(v[q].x, v[q].y); w.y = pk2(v[q].z, v[q].w); o8[64 * q] = w; }
        }
    }
}

__device__ __forceinline__ void ssm_s1(ArgsP a, unsigned char* smem) {
    const int tid = tid_l(), lane = tid & 63, wave = tid >> 6, G = sg_l(gridDim.x);
    unsigned char* ws = a->ws;
    const bf16_t* U = (const bf16_t*)(ws + WS_U); float* SL = (float*)(ws + WS_SLOC);
    { float* rowsq = (float*)(ws + WS_ROWSQ); for (int e = sg_l(blockIdx.x) * 512 + tid; e < L; e += G * 512) rowsq[e] = 0.f; }
    for (int unit = sg_l(blockIdx.x); unit < 256; unit += G) {
        const int g = unit >> 2, qtr = unit & 3;
        __syncthreads();
        { const u32x4* src = (const u32x4*)(ws + WS_TAB + (size_t)g * TAB_STRIDE + 16384); u32x4* dst = (u32x4*)smem; u32x4 tr[8];
#pragma unroll
          for (int i = 0; i < 8; ++i) tr[i] = src[tid + i * 512];
#pragma unroll
          for (int i = 0; i < 8; ++i) dst[tid + i * 512] = tr[i]; }
        __syncthreads();
#pragma unroll 1
        for (int nt = 0; nt < 2; ++nt) {
            const int chunk0 = qtr * 256 + wave * 32 + nt * 16, n = lane & 15;
            bf16x8 B[8];
#pragma unroll
            for (int ks = 0; ks < 8; ++ks) B[ks] = *(const bf16x8*)(U + ((size_t)g * L + (chunk0 + n) * 16 + ks * 2 + (lane >> 5)) * 16 + ((lane >> 4) & 1) * 8);
#pragma unroll
            for (int mt = 0; mt < 8; ++mt) {
                f32x4 acc = {0.f, 0.f, 0.f, 0.f};
#pragma unroll
                for (int ks = 0; ks < 8; ++ks) { const bf16x8 A = *(const bf16x8*)(smem + (mt * 8 + ks) * 1024 + lane * 16); acc = MFMA16(A, B[ks], acc); }
                *(f32x4*)(SL + ((size_t)(chunk0 + n) * 64 + g) * 128 + mt * 16 + (lane >> 4) * 4) = acc;
                asm volatile("" ::: "memory");
            }
        }
    }
}
__device__ __forceinline__ void ssm_s2(ArgsP a, int j, unsigned char* smem) {
    const int tid = tid_l(), G = sg_l(gridDim.x);
    unsigned char* ws = a->ws;
    const float* SL = (const float*)(ws + WS_SLOC); unsigned* SIN = (unsigned*)(ws + WS_SIN);
    float* ex = (float*)smem;
    for (int unit = sg_l(blockIdx.x); unit < 256; unit += G) {
        const int seg = tid >> 4, sl = tid & 15, st = unit * 16 + sl, g = st >> 6, p = st & 63;
        const float* ep = (const float*)(ws + WS_EP) + (size_t)(j * 64 + g) * EP_STRIDE;
        const float e16r = ep[(16 * 64 + p) * 2], e16i = ep[(16 * 64 + p) * 2 + 1], eSr = ep[(17 * 64 + p) * 2], eSi = ep[(17 * 64 + p) * 2 + 1];
        const float* src = SL + ((size_t)(seg * 32) * 64 + g) * 128 + 2 * p;
        f32x2 v[32];
#pragma unroll
        for (int i = 0; i < 32; ++i) v[i] = *(const f32x2*)(src + (size_t)i * 8192);
        float sr = 0.f, si = 0.f;
#pragma unroll
        for (int i = 0; i < 32; ++i) { const float nr = e16r * sr - e16i * si + v[i].x, ni = e16r * si + e16i * sr + v[i].y; sr = nr; si = ni; }
        __syncthreads();
        ex[(seg * 16 + sl) * 2] = sr; ex[(seg * 16 + sl) * 2 + 1] = si;
        __syncthreads();
        float cr = 0.f, ci = 0.f;
        for (int s = 0; s < seg; ++s) { const float xr = ex[(s * 16 + sl) * 2], xi = ex[(s * 16 + sl) * 2 + 1]; const float nr = eSr * cr - eSi * ci + xr, ni = eSr * ci + eSi * cr + xi; cr = nr; ci = ni; }
        unsigned* dst = SIN + ((size_t)(seg * 32) * 64 + g) * 64 + p;
#pragma unroll
        for (int i = 0; i < 32; ++i) {
            dst[(size_t)i * 4096] = pk2(cr, ci);
            const float nr = e16r * cr - e16i * ci + v[i].x, ni = e16r * ci + e16i * cr + v[i].y; cr = nr; ci = ni;
        }
    }
}
__device__ __forceinline__ void ssm_s3(ArgsP a, int j, unsigned char* smem) {
    const int tid = tid_l(), lane = tid & 63, wave = tid >> 6, G = sg_l(gridDim.x);
    unsigned char* ws = a->ws;
    const bf16_t* U = (const bf16_t*)(ws + WS_U); const bf16_t* SIN = (const bf16_t*)(ws + WS_SIN); bf16_t* YG = (bf16_t*)(ws + WS_YG);
    const float* dsk = a->in[10] + j * 1024;
    for (int unit = sg_l(blockIdx.x); unit < 256; unit += G) {
        const int g = unit >> 2, qtr = unit & 3;
        __syncthreads();
        { const u32x4* srcF = (const u32x4*)(ws + WS_TAB + (size_t)g * TAB_STRIDE); u32x4* dst = (u32x4*)smem;
          const u32x4* srcC = (const u32x4*)(ws + WS_TAB + (size_t)g * TAB_STRIDE + 16384 + 65536); u32x4 tr[10];
#pragma unroll
          for (int i = 0; i < 2; ++i) tr[i] = srcF[tid + i * 512];
#pragma unroll
          for (int i = 0; i < 8; ++i) tr[2 + i] = srcC[tid + i * 512];
#pragma unroll
          for (int i = 0; i < 2; ++i) dst[tid + i * 512] = tr[i];
#pragma unroll
          for (int i = 0; i < 8; ++i) dst[1024 + tid + i * 512] = tr[2 + i]; }
        __syncthreads();
        const unsigned char* Fl = smem; const unsigned char* Wl = smem + 16384;
        const int n = lane & 15, cq = (lane >> 4) * 4;
        const f32x4 dv = *(const f32x4*)(dsk + g * 16 + cq);
#pragma unroll 1
        for (int nt = 0; nt < 2; ++nt) {
            const int chunk = qtr * 256 + wave * 32 + nt * 16 + n;
            bf16x8 Bu[8], Bs[4];
#pragma unroll
            for (int ks = 0; ks < 8; ++ks) Bu[ks] = *(const bf16x8*)(U + ((size_t)g * L + chunk * 16 + ks * 2 + (lane >> 5)) * 16 + ((lane >> 4) & 1) * 8);
#pragma unroll
            for (int kk = 0; kk < 4; ++kk) Bs[kk] = *(const bf16x8*)(SIN + ((size_t)chunk * 64 + g) * 128 + kk * 32 + (lane >> 4) * 8);
#pragma unroll
            for (int t = 0; t < 16; ++t) {
                f32x4 acc = {0.f, 0.f, 0.f, 0.f};
#pragma unroll
                for (int i = 0; i <= t / 2; ++i) { const bf16x8 A = *(const bf16x8*)(Fl + (t - 2 * i) * 1024 + lane * 16); acc = MFMA16(A, Bu[i], acc); }
#pragma unroll
                for (int kk = 0; kk < 4; ++kk) { const bf16x8 A = *(const bf16x8*)(Wl + (t * 4 + kk) * 1024 + lane * 16); acc = MFMA16(A, Bs[kk], acc); }
                const size_t off = ((size_t)g * L + chunk * 16 + t) * 16 + cq;
                const u32x2 uv = *(const u32x2*)(U + off);
                const float y0 = gelu_tanh(acc[0] + dv[0] * bflo(uv.x)), y1 = gelu_tanh(acc[1] + dv[1] * bfhi(uv.x));
                const float y2 = gelu_tanh(acc[2] + dv[2] * bflo(uv.y)), y3 = gelu_tanh(acc[3] + dv[3] * bfhi(uv.y));
                u32x2 w; w.x = pk2(y0, y1); w.y = pk2(y2, y3);
                *(u32x2*)(YG + off) = w;
                asm volatile("" ::: "memory");
            }
        }
    }
}

constexpr int QK_STRIDE = 4096;
constexpr int KL_STRIDE = 272, VL_STRIDE = 520, VT_OFF = 256 * KL_STRIDE;

__device__ __forceinline__ void attn_a1(ArgsP a, int j, unsigned char* smem, int dry) {
    const int tid = tid_l(), G = sg_l(gridDim.x);
    unsigned char* ws = a->ws;
    bf16_t* QKVZ = (bf16_t*)(ws + WS_BIG); const float* rope = (const float*)(ws + WS_ROPE); float* kmean = (float*)(ws + WS_KMEAN);
    if (sg_l(blockIdx.x) == 0) ((unsigned*)(ws + WS_CTL))[tid] = 0u;
    if (!dry) { float* rowsq = (float*)(ws + WS_ROWSQ); for (int e = sg_l(blockIdx.x) * 512 + tid; e < L; e += G * 512) rowsq[e] = 0.f; }
    const int seg = tid & 15, rg = tid >> 4;
    const float* qg = a->in[15] + j * 128 + seg * 8; const float* kg = a->in[16] + j * 128 + seg * 8;
    float gq[8], gk[8];
#pragma unroll
    for (int i = 0; i < 8; ++i) { gq[i] = qg[i]; gk[i] = kg[i]; }
    float* red = (float*)(smem + 72 * 1024);
    for (int unit = sg_l(blockIdx.x); unit < 512; unit += G) {
        const int h = unit & 7, b = unit >> 3;
        float ksum[8];
#pragma unroll
        for (int i = 0; i < 8; ++i) ksum[i] = 0.f;
        __syncthreads();
#pragma unroll 1
        for (int pb = 0; pb < 2; ++pb) {
            u32x4 rq[4], rk[4], rv[4]; f32x2 rp[4][8];
#pragma unroll
            for (int p4 = 0; p4 < 4; ++p4) {
                const int t = b * 256 + (pb * 4 + p4) * 32 + rg;
                const bf16_t* p = QKVZ + (size_t)t * QK_STRIDE + h * 128 + seg * 8;
                rq[p4] = *(const u32x4*)p; rk[p4] = *(const u32x4*)(p + 1024); rv[p4] = *(const u32x4*)(p + 2048);
#pragma unroll
                for (int i = 0; i < 8; ++i) rp[p4][i] = *(const f32x2*)(rope + ((size_t)t * 16 + (seg & 1) * 8 + i) * 2);
            }
#pragma unroll
            for (int p4 = 0; p4 < 4; ++p4) {
                const int ps = pb * 4 + p4, t = b * 256 + ps * 32 + rg;
#pragma unroll
                for (int which = 0; which < 2; ++which) {
                    bf16_t* p = QKVZ + (size_t)t * QK_STRIDE + which * 1024 + h * 128 + seg * 8;
                    const u32x4 raw = which == 0 ? rq[p4] : rk[p4];
                    float x[8];
#pragma unroll
                    for (int q = 0; q < 4; ++q) { x[2 * q] = bflo(raw[q]); x[2 * q + 1] = bfhi(raw[q]); }
                    float ss = 0.f;
#pragma unroll
                    for (int i = 0; i < 8; ++i) ss += x[i] * x[i];
                    ss += __shfl_xor(ss, 1); ss += __shfl_xor(ss, 2); ss += __shfl_xor(ss, 4); ss += __shfl_xor(ss, 8);
                    const float rstd = rsqrtf(ss * (1.f / 128.f) + NORM_EPS);
#pragma unroll
                    for (int i = 0; i < 8; ++i) x[i] = x[i] * rstd * (which == 0 ? gq[i] : gk[i]);
                    float y[8];
#pragma unroll
                    for (int i = 0; i < 8; ++i) {
                        const float o = __shfl_xor(x[i], 2);
                        y[i] = x[i];
                        if (seg < 2) y[i] = x[i] * rp[p4][i].x - o * rp[p4][i].y;
                        else if (seg < 4) y[i] = x[i] * rp[p4][i].x + o * rp[p4][i].y;
                    }
                    u32x4 w; w.x = pk2(y[0], y[1]); w.y = pk2(y[2], y[3]); w.z = pk2(y[4], y[5]); w.w = pk2(y[6], y[7]);
                    if (!dry) *(u32x4*)p = w;
                    if (which == 1) {
#pragma unroll
                        for (int i = 0; i < 8; ++i) ksum[i] += y[i];
                    }
                }
                { const int key = ps * 32 + rg; *(u32x4*)(smem + key * 256 + ((seg ^ ((key >> 3) & 15)) * 16)) = rv[p4]; }
            }
        }
#pragma unroll
        for (int i = 0; i < 8; ++i) red[rg * 128 + seg * 8 + i] = ksum[i];
        __syncthreads();
        if (tid < 128) { float s = 0.f;
#pragma unroll
            for (int r = 0; r < 32; ++r) s += red[r * 128 + tid];
            if (!dry) kmean[((size_t)h * 64 + b) * 128 + tid] = s * (1.f / 256.f); }
        for (int e = tid; e < 4096; e += 512) {
            const int ko = e & 31, d = e >> 5, key0 = ko * 8;
            unsigned short v[8];
#pragma unroll
            for (int i = 0; i < 8; ++i) v[i] = *(const unsigned short*)(smem + (key0 + i) * 256 + (((d >> 3) ^ (ko & 15)) * 16) + (d & 7) * 2);
            u32x4 w; w.x = v[0] | ((unsigned)v[1] << 16); w.y = v[2] | ((unsigned)v[3] << 16); w.z = v[4] | ((unsigned)v[5] << 16); w.w = v[6] | ((unsigned)v[7] << 16);
            if (!dry) *(u32x4*)(QKVZ + (size_t)(b * 256 + 2 * d + (key0 >> 7)) * QK_STRIDE + 2048 + h * 128 + (key0 & 127)) = w;
        }
    }
}

__device__ __forceinline__ bool gate_better(float v, int i, float w, int k) { return v > w || (v == w && i < k); }
#define TOP3_INSERT(s_, n_) do { const float _s = (s_); const int _n = (n_); \
    const bool _b1 = gate_better(_s, _n, v1, i1), _b2 = gate_better(_s, _n, v2, i2), _b3 = gate_better(_s, _n, v3, i3); \
    const float _nv3 = _b2 ? v2 : (_b3 ? _s : v3); const int _ni3 = _b2 ? i2 : (_b3 ? _n : i3); \
    const float _nv2 = _b1 ? v1 : (_b2 ? _s : v2); const int _ni2 = _b1 ? i1 : (_b2 ? _n : i2); \
    const float _nv1 = _b1 ? _s : v1; const int _ni1 = _b1 ? _n : i1; \
    v1 = _nv1; i1 = _ni1; v2 = _nv2; i2 = _ni2; v3 = _nv3; i3 = _ni3; } while (0)
__device__ __forceinline__ void attn_a2(ArgsP a, unsigned char* smem, int dry) {
    const int tid = tid_l(), lane = tid & 63, wave = tid >> 6, G = sg_l(gridDim.x), r = lane & 31, hh = lane >> 5;
    unsigned char* ws = a->ws;
    const bf16_t* QKVZ = (const bf16_t*)(ws + WS_BIG); const float* kmean = (const float*)(ws + WS_KMEAN);
    unsigned* cnt = (unsigned*)(ws + WS_CTL); unsigned short* lists = (unsigned short*)(ws + WS_TAB);
    unsigned* cntl = (unsigned*)smem; unsigned* basel = cntl + 64;
    int cur_h = -1;
    bf16x8 Khi[2][8], Klo[2][8];
    for (int unit = sg_l(blockIdx.x); unit < 512; unit += G) {
        const int h = unit & 7, b = unit >> 3;
        if (b == 0) continue;
        if (h != cur_h) {
            cur_h = h;
#pragma unroll
            for (int tl = 0; tl < 2; ++tl)
#pragma unroll
                for (int kk = 0; kk < 8; ++kk) {
                    const float* kp = kmean + ((size_t)h * 64 + tl * 32 + r) * 128 + kk * 16 + hh * 8;
                    const f32x4 x0 = *(const f32x4*)kp, x1 = *(const f32x4*)(kp + 4);
                    u32x4 hi; hi.x = pk2(x0[0], x0[1]); hi.y = pk2(x0[2], x0[3]); hi.z = pk2(x1[0], x1[1]); hi.w = pk2(x1[2], x1[3]);
                    u32x4 lo; lo.x = pk2(x0[0] - bflo(hi.x), x0[1] - bfhi(hi.x)); lo.y = pk2(x0[2] - bflo(hi.y), x0[3] - bfhi(hi.y));
                    lo.z = pk2(x1[0] - bflo(hi.z), x1[1] - bfhi(hi.z)); lo.w = pk2(x1[2] - bflo(hi.w), x1[3] - bfhi(hi.w));
                    Khi[tl][kk] = __builtin_bit_cast(bf16x8, hi); Klo[tl][kk] = __builtin_bit_cast(bf16x8, lo);
                }
        }
        const int t = b * 256 + wave * 32 + r;
        bf16x8 qf[8];
#pragma unroll
        for (int kk = 0; kk < 8; ++kk) qf[kk] = *(const bf16x8*)(QKVZ + (size_t)t * QK_STRIDE + h * 128 + kk * 16 + hh * 8);
        float v1 = -INFINITY, v2 = -INFINITY, v3 = -INFINITY; int i1 = 1 << 20, i2 = 1 << 20, i3 = 1 << 20;
#pragma unroll
        for (int tl = 0; tl < 2; ++tl) {
            if (tl == 1 && b <= 32) break;
            f32x16 Gt;
#pragma unroll
            for (int i = 0; i < 16; ++i) Gt[i] = 0.f;
#pragma unroll
            for (int kk = 0; kk < 8; ++kk) { Gt = MFMA32(Khi[tl][kk], qf[kk], Gt); Gt = MFMA32(Klo[tl][kk], qf[kk], Gt); }
#pragma unroll
            for (int i = 0; i < 16; ++i) { const int n = tl * 32 + (i & 3) + 8 * (i >> 2) + 4 * hh; if (n < b) TOP3_INSERT(Gt[i], n); }
        }
        {
            const float w1 = __shfl_xor(v1, 32), w2 = __shfl_xor(v2, 32), w3 = __shfl_xor(v3, 32);
            const int k1 = __shfl_xor(i1, 32), k2 = __shfl_xor(i2, 32), k3 = __shfl_xor(i3, 32);
            TOP3_INSERT(w1, k1); TOP3_INSERT(w2, k2); TOP3_INSERT(w3, k3);
        }
        __syncthreads();
        if (tid < 64) cntl[tid] = 0u;
        __syncthreads();
        unsigned lp1 = 0u, lp2 = 0u, lp3 = 0u;
        if (hh == 0) {
            if (i1 < 64) lp1 = atomicAdd(&cntl[i1], 1u);
            if (i2 < 64) lp2 = atomicAdd(&cntl[i2], 1u);
            if (i3 < 64) lp3 = atomicAdd(&cntl[i3], 1u);
        }
        __syncthreads();
        if (tid < 64) { const unsigned c = cntl[tid]; basel[tid] = (c && !dry) ? atomicAdd(&cnt[h * 64 + tid], c) : 0u; }
        __syncthreads();
        if (hh == 0 && !dry) {
            unsigned short* lh = lists + (size_t)h * LIST_PER_HEAD;
            if (i1 < 64) lh[list_off(i1) + basel[i1] + lp1] = (unsigned short)(t);
            if (i2 < 64) lh[list_off(i2) + basel[i2] + lp2] = (unsigned short)(t | (1 << 14));
            if (i3 < 64) lh[list_off(i3) + basel[i3] + lp3] = (unsigned short)(t | (2 << 14));
        }
    }
}

__device__ __forceinline__ void load_kv(const bf16_t* QKVZ, int h, int n, unsigned char* smem) {
    const int tid = tid_l();
    u32x4 kr[8], vr[8];
#pragma unroll
    for (int i = 0; i < 8; ++i) { const int e = tid + i * 512, key = e >> 4, pc = e & 15;
        kr[i] = *(const u32x4*)(QKVZ + (size_t)(n * 256 + key) * QK_STRIDE + 1024 + h * 128 + pc * 8); }
#pragma unroll
    for (int i = 0; i < 8; ++i) { const int e = tid + i * 512, d = e >> 5, pc = e & 31, key0 = pc * 8;
        vr[i] = *(const u32x4*)(QKVZ + (size_t)(n * 256 + 2 * d + (key0 >> 7)) * QK_STRIDE + 2048 + h * 128 + (key0 & 127)); }
#pragma unroll
    for (int i = 0; i < 8; ++i) { const int e = tid + i * 512, key = e >> 4, pc = e & 15; *(u32x4*)(smem + key * KL_STRIDE + pc * 16) = kr[i]; }
#pragma unroll
    for (int i = 0; i < 8; ++i) { const int e = tid + i * 512, d = e >> 5, pc = e & 31;
        u32x2* dst = (u32x2*)(smem + VT_OFF + d * VL_STRIDE + pc * 16);
        dst[0] = (u32x2){vr[i].x, vr[i].y}; dst[1] = (u32x2){vr[i].z, vr[i].w}; }
}
__device__ __forceinline__ void attn_core(const unsigned char* smem, const bf16x8 (&qf)[8], int nkt, int mask_kt, int qidx, float c1, float c2, f32x16 (&O)[4], float& lsum) {
    const int lane = tid_l() & 63, r = lane & 31, hh = lane >> 5;
    const unsigned char* kbase = smem + r * KL_STRIDE + hh * 16;
    const unsigned char* vbase = smem + VT_OFF + r * VL_STRIDE + hh * 8;
    bf16x8 Kf[8];
#pragma unroll
    for (int kk = 0; kk < 8; ++kk) Kf[kk] = *(const bf16x8*)(kbase + kk * 32);
    for (int kt = 0; kt < nkt; ++kt) {
        f32x16 S;
#pragma unroll
        for (int i = 0; i < 16; ++i) S[i] = 0.f;
#pragma unroll
        for (int kk = 0; kk < 8; ++kk) S = MFMA32(Kf[kk], qf[kk], S);
        s16x4 Vl[2][4], Vh[2][4];
#pragma unroll
        for (int s = 0; s < 2; ++s)
#pragma unroll
            for (int dt = 0; dt < 4; ++dt) { const unsigned char* vp = vbase + dt * 32 * VL_STRIDE + (kt * 32 + 16 * s) * 2; Vl[s][dt] = *(const s16x4*)vp; Vh[s][dt] = *(const s16x4*)(vp + 16); }
        { const int ktn = kt + 1 < nkt ? kt + 1 : kt;
#pragma unroll
          for (int kk = 0; kk < 8; ++kk) Kf[kk] = *(const bf16x8*)(kbase + ktn * 32 * KL_STRIDE + kk * 32); }
        asm volatile("" ::: "memory");
        float p[16];
#pragma unroll
        for (int i = 0; i < 16; ++i) { p[i] = __builtin_amdgcn_exp2f(S[i] * c1 - c2);
            if (kt == mask_kt) { const int key = kt * 32 + (i & 3) + 8 * (i >> 2) + 4 * hh; if (key > qidx) p[i] = 0.f; }
            lsum += p[i]; }
#pragma unroll
        for (int s = 0; s < 2; ++s) {
            u32x4 pw; pw.x = pk2(p[8 * s], p[8 * s + 1]); pw.y = pk2(p[8 * s + 2], p[8 * s + 3]); pw.z = pk2(p[8 * s + 4], p[8 * s + 5]); pw.w = pk2(p[8 * s + 6], p[8 * s + 7]);
            const bf16x8 pa = __builtin_bit_cast(bf16x8, pw);
#pragma unroll
            for (int dt = 0; dt < 4; ++dt) {
                const bf16x8 Bv = __builtin_shufflevector(Vl[s][dt], Vh[s][dt], 0, 1, 2, 3, 4, 5, 6, 7);
                O[dt] = MFMA32(pa, Bv, O[dt]);
            }
        }
    }
}
__device__ __forceinline__ float attn_ref(ArgsP a, int j) {
    const int lane = tid_l() & 63;
    float mq = fmaxf(fabsf(a->in[15][j * 128 + lane]), fabsf(a->in[15][j * 128 + 64 + lane]));
    float mk = fmaxf(fabsf(a->in[16][j * 128 + lane]), fabsf(a->in[16][j * 128 + 64 + lane]));
#pragma unroll
    for (int o = 1; o < 64; o <<= 1) { mq = fmaxf(mq, __shfl_xor(mq, o)); mk = fmaxf(mk, __shfl_xor(mk, o)); }
    return 11.313708499f * mq * mk;
}
constexpr int LDS_LQ = 141312;

__device__ __forceinline__ void attn_a3(ArgsP a, int j, unsigned char* smem) {
    const int tid = tid_l(), lane = tid & 63, wave = tid >> 6, G = sg_l(gridDim.x), r = lane & 31, hh = lane >> 5;
    unsigned char* ws = a->ws;
    const bf16_t* QKVZ = (const bf16_t*)(ws + WS_BIG);
    const unsigned* cnt = (const unsigned*)(ws + WS_CTL); const unsigned short* lists = (const unsigned short*)(ws + WS_TAB);
    float* lpart = (float*)(ws + WS_LPART);
    int* pre = (int*)(smem + 140 * 1024);
    const float ref = attn_ref(a, j), c1 = 0.08838834764831845f * 1.4426950408889634f, c2 = ref * 1.4426950408889634f;
    __syncthreads();
    { const int c = (int)cnt[tid]; pre[tid] = (c + 255) >> 8; }
    __syncthreads();
    for (int o = 1; o < 512; o <<= 1) { const int v = pre[tid] + (tid >= o ? pre[tid - o] : 0); __syncthreads(); pre[tid] = v; __syncthreads(); }
    const int total = pre[511]; const int bidx = sg_l(blockIdx.x);
    const int t_lo = (int)(((long)total * bidx) / G), t_hi = (int)(((long)total * (bidx + 1)) / G);
    int cur_pr = -1;
    int e_cur = -1; bf16x8 qf[8];
    auto tile_info = [&](int tile, int& pr, int& tl) { int lo = 0, hi = 511; while (lo < hi) { const int mid = (lo + hi) >> 1; if (pre[mid] > tile) hi = mid; else lo = mid + 1; } pr = lo; tl = tile - (pr ? pre[pr - 1] : 0); };
    auto load_entry = [&](int tile) -> int { int pr, tl; tile_info(tile, pr, tl); const int h = pr >> 6, n = pr & 63, c = (int)cnt[pr]; const int li = tl * 256 + wave * 32 + r; const bool valid = li < c;
        const unsigned e = lists[(size_t)h * LIST_PER_HEAD + list_off(n) + (valid ? li : 0)]; return (int)e | (valid ? 0x10000 : 0); };
    if (t_lo < t_hi) { e_cur = load_entry(t_lo); int pr, tl; tile_info(t_lo, pr, tl); const int h = pr >> 6;
#pragma unroll
        for (int kk = 0; kk < 8; ++kk) qf[kk] = *(const bf16x8*)(QKVZ + (size_t)(e_cur & 0x3fff) * QK_STRIDE + h * 128 + kk * 16 + hh * 8); }
    for (int tile = t_lo; tile < t_hi; ++tile) {
        int pr, tl; tile_info(tile, pr, tl);
        const int h = pr >> 6, n = pr & 63;
        if (pr != cur_pr) { __syncthreads(); load_kv(QKVZ, h, n, smem); __syncthreads(); cur_pr = pr; }
        int e_nxt = -1; bf16x8 qn[8];
        if (tile + 1 < t_hi) { e_nxt = load_entry(tile + 1); int pr2, tl2; tile_info(tile + 1, pr2, tl2); const int h2 = pr2 >> 6;
#pragma unroll
            for (int kk = 0; kk < 8; ++kk) qn[kk] = *(const bf16x8*)(QKVZ + (size_t)(e_nxt & 0x3fff) * QK_STRIDE + h2 * 128 + kk * 16 + hh * 8); }
        else {
#pragma unroll
            for (int kk = 0; kk < 8; ++kk) qn[kk] = qf[kk];
        }
        f32x16 O[4];
#pragma unroll
        for (int dt = 0; dt < 4; ++dt)
#pragma unroll
            for (int i = 0; i < 16; ++i) O[dt][i] = 0.f;
        float lsum = 0.f;
        attn_core(smem, qf, 8, -1, 0, c1, c2, O, lsum);
        lsum += __shfl_xor(lsum, 32);
        if (hh == 0 && (e_cur & 0x10000)) lpart[((size_t)((e_cur >> 14) & 3) * L + (e_cur & 0x3fff)) * 8 + h] = lsum;
#pragma unroll
        for (int i = 0; i < 16; ++i) {
            const int ei = __shfl(e_cur, (i & 3) + 8 * (i >> 2) + 4 * hh);
            if (ei & 0x10000) {
                const int slot = (ei >> 14) & 3, ti = ei & 0x3fff;
                bf16_t* P = (bf16_t*)(ws + (slot == 0 ? WS_XN : (slot == 1 ? WS_P1 : WS_P2))) + (size_t)ti * DM + h * 128 + r * 4;
                u32x2 w; w.x = pk2(O[0][i], O[1][i]); w.y = pk2(O[2][i], O[3][i]);
                *(u32x2*)P = w;
            }
        }
        e_cur = e_nxt;
#pragma unroll
        for (int kk = 0; kk < 8; ++kk) qf[kk] = qn[kk];
    }
}
__device__ __forceinline__ void attn_a4(ArgsP a, int j, unsigned char* smem, int dry) {
    const int tid = tid_l(), lane = tid & 63, wave = tid >> 6, G = sg_l(gridDim.x), r = lane & 31, hh = lane >> 5;
    unsigned char* ws = a->ws;
    const bf16_t* QKVZ = (const bf16_t*)(ws + WS_BIG); const float* lpart = (const float*)(ws + WS_LPART);
    const float ref = attn_ref(a, j), c1 = 0.08838834764831845f * 1.4426950408889634f, c2 = ref * 1.4426950408889634f;
    float* lq = (float*)(smem + LDS_LQ) + wave * 32;
    const int qt = wave < 4 ? wave : 11 - wave;
    for (int unit = sg_l(blockIdx.x); unit < 512; unit += G) {
        const int h = unit & 7, b = unit >> 3;
        __syncthreads(); load_kv(QKVZ, h, b, smem); __syncthreads();
        const int qidx = qt * 32 + r, t = b * 256 + qidx;
        bf16x8 qf[8];
#pragma unroll
        for (int kk = 0; kk < 8; ++kk) qf[kk] = *(const bf16x8*)(QKVZ + (size_t)t * QK_STRIDE + h * 128 + kk * 16 + hh * 8);
        f32x16 O[4];
#pragma unroll
        for (int dt = 0; dt < 4; ++dt)
#pragma unroll
            for (int i = 0; i < 16; ++i) O[dt][i] = 0.f;
        float lsum = 0.f;
        attn_core(smem, qf, qt + 1, qt, qidx, c1, c2, O, lsum);
        lsum += __shfl_xor(lsum, 32);
        const int nsel = b < 3 ? b : 3;
        for (int s = 0; s < nsel; ++s) lsum += lpart[((size_t)s * L + t) * 8 + h];
        if (hh == 0) lq[r] = 1.0f / lsum;
        __builtin_amdgcn_wave_barrier(); asm volatile("s_waitcnt lgkmcnt(0)" ::: "memory");
#pragma unroll
        for (int i = 0; i < 16; ++i) {
            const int qi = (i & 3) + 8 * (i >> 2) + 4 * hh; const size_t ti = (size_t)(b * 256 + qt * 32 + qi);
            const float inv = lq[qi];
            float o0 = O[0][i], o1 = O[1][i], o2 = O[2][i], o3 = O[3][i];
            for (int s = 0; s < nsel; ++s) {
                const u32x2 pv = *(const u32x2*)((const bf16_t*)(ws + (s == 0 ? WS_XN : (s == 1 ? WS_P1 : WS_P2))) + ti * DM + h * 128 + r * 4);
                o0 += bflo(pv.x); o1 += bfhi(pv.x); o2 += bflo(pv.y); o3 += bfhi(pv.y);
            }
            const u32x2 zv = *(const u32x2*)(QKVZ + ti * QK_STRIDE + 3072 + h * 128 + r * 4);
            const float z0 = bflo(zv.x), z1 = bfhi(zv.x), z2 = bflo(zv.y), z3 = bfhi(zv.y);
            u32x2 w; w.x = pk2(o0 * inv * z0 * sigmoidf_(z0), o1 * inv * z1 * sigmoidf_(z1)); w.y = pk2(o2 * inv * z2 * sigmoidf_(z2), o3 * inv * z3 * sigmoidf_(z3));
            if (!dry) *(u32x2*)((bf16_t*)(ws + WS_XN) + ti * DM + h * 128 + r * 4) = w;
        }
        __builtin_amdgcn_wave_barrier();
    }
}

#define XB_TMO      128
#define XB_XCNT(j)  (256  + 64 * (j))
#define XB_XSUB(j)  (1280 + 64 * (j))
#define XB_XGEN(j)  (2304 + 64 * (j))
#define XB_TOP      3328
#define XB_TOPGEN   3392
#define XCD_BAR_WORDS 3456
#define XB_SPIN_CAP (1u << 22)
__device__ __forceinline__ unsigned xb_ld(unsigned* p)              { return __hip_atomic_load(p, __ATOMIC_RELAXED, __HIP_MEMORY_SCOPE_AGENT); }
__device__ __forceinline__ unsigned xb_add(unsigned* p, unsigned v) { return __hip_atomic_fetch_add(p, v, __ATOMIC_RELAXED, __HIP_MEMORY_SCOPE_AGENT); }
__device__ __forceinline__ unsigned xb_xcc_id() { return (unsigned)__builtin_amdgcn_s_getreg((3 << 11) | 20) & 0xFu; }
#define XB_SPIN(cond, bar) do { unsigned _sp = 0; while (cond) { __builtin_amdgcn_s_sleep(1); \
    if ((++_sp & 255u) == 0u) { if (xb_ld(&(bar)[XB_TMO])) break; if (_sp > XB_SPIN_CAP) { atomicAdd(&(bar)[XB_TMO], 1u); break; } } } } while (0)
struct XcdBarrier { unsigned* bar; unsigned x; volatile LAS unsigned* st; };
__device__ __forceinline__ XcdBarrier xcd_barrier_post(unsigned* bar, volatile LAS unsigned* st) {
    XcdBarrier b; b.bar = bar; b.x = xb_xcc_id(); b.st = st;
    if (threadIdx.x == 0) (void)xb_add(&bar[XB_XCNT(b.x)], 1u);
    return b;
}
__device__ __forceinline__ void xcd_barrier_complete(unsigned* bar, unsigned x, unsigned& nloc, unsigned& nx) {
    const unsigned G = gridDim.x * gridDim.y * gridDim.z;
    unsigned sum, cnt, mine, sp = 0u;
    for (;;) {
        sum = 0u; cnt = 0u; mine = 0u;
#pragma unroll
        for (unsigned j = 0; j < 16; ++j) { const unsigned c = xb_ld(&bar[XB_XCNT(j)]); sum += c; cnt += (c > 0u) ? 1u : 0u; mine = (j == x) ? c : mine; }
        if (sum == G) break;
        __builtin_amdgcn_s_sleep(1);
        if ((++sp & 255u) == 0u) { if (xb_ld(&bar[XB_TMO])) break; if (sp > XB_SPIN_CAP) { atomicAdd(&bar[XB_TMO], 1u); break; } }
    }
    nloc = mine > 0u ? mine : 1u; nx = cnt > 0u ? cnt : 1u;
}
__device__ __forceinline__ void xcd_barrier(const XcdBarrier& b) {
    asm volatile("s_waitcnt vmcnt(0)" ::: "memory");
    __syncthreads();
    if (threadIdx.x == 0) {
        unsigned* bar = b.bar;
        __builtin_amdgcn_s_waitcnt(0);
        unsigned nloc = b.st[0], nx = b.st[1];
        if (nloc == 0u) { xcd_barrier_complete(bar, b.x, nloc, nx); b.st[0] = nloc; b.st[1] = nx; }
        const unsigned old = xb_add(&bar[XB_XSUB(b.x)], 1u);
        const unsigned gen = old / nloc;
        if (old + 1u == (gen + 1u) * nloc) {
            __builtin_amdgcn_fence(__ATOMIC_RELEASE, "agent");
            asm volatile("s_waitcnt vmcnt(0)" ::: "memory");
            const unsigned og = xb_add(&bar[XB_TOP], 1u);
            const unsigned tg = og / nx;
            if (og + 1u == (tg + 1u) * nx) xb_add(&bar[XB_TOPGEN], 1u);
            else XB_SPIN(xb_ld(&bar[XB_TOPGEN]) == tg, bar);
            __builtin_amdgcn_fence(__ATOMIC_ACQUIRE, "agent");
            xb_add(&bar[XB_XGEN(b.x)], 1u);
            asm volatile("s_waitcnt vmcnt(0)" ::: "memory");
        } else {
            XB_SPIN(xb_ld(&bar[XB_XGEN(b.x)]) == gen, bar);
            __builtin_amdgcn_fence(__ATOMIC_ACQUIRE, "agent");
            asm volatile("s_waitcnt vmcnt(0)" ::: "memory");
        }
    }
    __syncthreads();
}
#ifndef PH_MASK
#define PH_MASK 0xFFFF
#endif
#define PH(b) ((PH_MASK >> (b)) & 1)
#ifndef REP_MASK
#define REP_MASK 0
#endif
#ifndef XSYNC
#define XSYNC 0
#endif
#define REP(b) for (int _r = 0; _r < 1 + ((REP_MASK >> (b)) & 1); ++_r)
__global__ void __launch_bounds__(512, 2) hybrid_fwd(Args a_unused) {
    extern __shared__ __attribute__((aligned(16))) unsigned char smem[];
    cg::grid_group grid = cg::this_grid();
    LAS unsigned char* lds = (LAS unsigned char*)smem;
    const ArgsP ap = (ArgsP)__builtin_amdgcn_kernarg_segment_ptr();
    if (threadIdx.x < 2) ((volatile LAS unsigned*)(lds + LDS_BARST))[threadIdx.x] = 0u;
    __syncthreads();
    if (blockIdx.x == 0) for (int e = threadIdx.x; e < XCD_BAR_WORDS; e += 512) ((unsigned*)(ap->ws + WS_BAR))[e] = 0u;

#define a launder(ap)
#define ws (launder(ap)->ws)
#define Wb ((bf16_t*)(ws + WS_W))
#define XN ((bf16_t*)(ws + WS_XN))
    REP(0) if (PH(0)) pre0_phase(a);
    grid.sync();
    const XcdBarrier xbar = xcd_barrier_post((unsigned*)(ws + WS_BAR), (volatile LAS unsigned*)(lds + LDS_BARST));
    for (int _x = 0; _x < XSYNC; ++_x) xcd_barrier(xbar);
    REP(0) if (PH(0)) prep_phase(a, 0, a->in[0], smem);
    xcd_barrier(xbar);
#pragma unroll 1
    for (int layer = 0; layer < 4; ++layer) {
        const int j = layer >> 1;
        if ((layer & 1) == 0) {
            REP(1) if (PH(1)) { pg8::Gemm g{layer == 0 ? XN : (bf16_t*)(ws + WS_Y2), Wb, L, 2048, 1024}; pg8::StaticOrder S; S.init(L, 2048, sg_l(gridDim.x), sg_l(blockIdx.x));
              pg8::EpiStore E{(bf16_t*)(ws + WS_U), 1024, 1024, (size_t)(WS_Z - WS_U) / 2, (const float*)(ws + WS_ROWSQ), 1};
              pg8::gemm_phase<pg8::EpiStore, pg8::StaticOrder, true, true>(lds, g, S, E); }
            xcd_barrier(xbar);
            REP(2) if (PH(2)) ssm_s1(a, smem);
            xcd_barrier(xbar);
            REP(3) if (PH(3)) ssm_s2(a, j, smem);
            xcd_barrier(xbar);
            REP(4) if (PH(4)) ssm_s3(a, j, smem);
            xcd_barrier(xbar);
            REP(5) if (PH(5)) { pg8::Gemm g{(const bf16_t*)(ws + WS_YG), Wb + 2048 * 1024, L, 1024, 1024}; pg8::StaticOrder S; S.init(L, 1024, sg_l(gridDim.x), sg_l(blockIdx.x));
              pg8::EpiGlu E{(const bf16_t*)(ws + WS_YG), (const bf16_t*)(ws + WS_Z), a->in[12] + j * 1024, (bf16_t*)(ws + WS_Y2)};
              pg8::gemm_phase<pg8::EpiGlu, pg8::StaticOrder, true, true, true>(lds, g, S, E); }
            xcd_barrier(xbar);
            REP(6) if (PH(6)) { pg8::Gemm g{(const bf16_t*)(ws + WS_Y2), Wb + 3072 * 1024, L, 1024, 1024}; pg8::StaticOrder S; S.init(L, 1024, sg_l(gridDim.x), sg_l(blockIdx.x));
              pg8::EpiRes E{layer == 0 ? a->in[0] : (const float*)a->out, a->out, layer < 3 ? XN : (bf16_t*)nullptr, (float*)(ws + WS_ROWSQ)};
              pg8::gemm_phase<pg8::EpiRes, pg8::StaticOrder, true, true>(lds, g, S, E); }
            xcd_barrier(xbar);
        } else {
            REP(7) if (PH(7)) { pg8::Gemm g{XN, Wb, L, 4096, 1024}; pg8::StaticOrder S; S.init(L, 4096, sg_l(gridDim.x), sg_l(blockIdx.x));
              pg8::EpiStore E{(bf16_t*)(ws + WS_BIG), 4096, 0, 0, (const float*)(ws + WS_ROWSQ), 0};
              pg8::gemm_phase<pg8::EpiStore, pg8::StaticOrder, true, true>(lds, g, S, E); }
            xcd_barrier(xbar);
            REP(8) if (PH(8)) attn_a1(a, j, smem, sg_l(_r == 0 && ((REP_MASK >> 8) & 1)));
            xcd_barrier(xbar);
            REP(9) if (PH(9)) attn_a2(a, smem, sg_l(_r == 0 && ((REP_MASK >> 9) & 1)));
            xcd_barrier(xbar);
            REP(10) if (PH(10)) attn_a3(a, j, smem);
            xcd_barrier(xbar);
            REP(11) if (PH(11)) attn_a4(a, j, smem, sg_l(_r == 0 && ((REP_MASK >> 11) & 1)));
            xcd_barrier(xbar);
            REP(12) if (PH(12)) { pg8::Gemm g{XN, Wb + 4096 * 1024, L, 1024, 1024}; pg8::StaticOrder S; S.init(L, 1024, sg_l(gridDim.x), sg_l(blockIdx.x));
              pg8::EpiRes E{(const float*)a->out, a->out, layer < 3 ? (bf16_t*)(ws + WS_Y2) : (bf16_t*)nullptr, (float*)(ws + WS_ROWSQ)};
              pg8::gemm_phase<pg8::EpiRes, pg8::StaticOrder, true, true>(lds, g, S, E); }
            xcd_barrier(xbar);
        }
        if (layer < 3) { REP(13) if (PH(13)) prep_phase(a, layer + 1, a->out, smem); xcd_barrier(xbar); }
    }
}

#undef a
#undef ws
#undef Wb
#undef XN
extern "C" void kernel_launch(void* const* d_in, const int* in_sizes, int n_in, void* d_out, int out_size, void* d_ws, size_t ws_size, hipStream_t stream) {
    static int grid = 0;
    if (grid == 0) {
        if (n_in != 18 || out_size != L * DM || ws_size < WS_END) { fprintf(stderr, "kernel_launch: unexpected shapes (n_in %d, out %d, ws %zu)\n", n_in, out_size, ws_size); grid = -1; return; }
        int dev = 0, cus = 0, per_cu = 0;
        (void)hipGetDevice(&dev); (void)hipDeviceGetAttribute(&cus, hipDeviceAttributeMultiprocessorCount, dev);
        (void)hipFuncSetAttribute((const void*)hybrid_fwd, hipFuncAttributeMaxDynamicSharedMemorySize, LDS_BYTES);
        (void)hipOccupancyMaxActiveBlocksPerMultiprocessor(&per_cu, (const void*)hybrid_fwd, 512, LDS_BYTES);
        if (per_cu < 1) { fprintf(stderr, "kernel_launch: occupancy query says %d blocks per CU\n", per_cu); per_cu = 1; }
        grid = cus * 1;
        if (grid > 256) grid = 256;
    }
    if (grid < 0) return;
    Args a{};
    for (int i = 0; i < 18; ++i) a.in[i] = (const float*)d_in[i];
    a.out = (float*)d_out; a.ws = (unsigned char*)d_ws;
    void* args[] = {&a};
    hipError_t e = hipLaunchCooperativeKernel((const void*)hybrid_fwd, dim3(grid), dim3(512), args, LDS_BYTES, stream);
    if (e != hipSuccess) fprintf(stderr, "cooperative launch failed: %s (grid %d)\n", hipGetErrorString(e), grid);
}
```

```cpp
#include <hip/hip_runtime.h>
#include <hip/hip_cooperative_groups.h>
#include <cstdio>
#include <cstdint>
namespace cg = cooperative_groups;

#define LAS __attribute__((address_space(3)))
typedef unsigned short bf16_t;
typedef short bf16x8 __attribute__((ext_vector_type(8)));
typedef short s16x4 __attribute__((ext_vector_type(4)));
typedef float f32x2 __attribute__((ext_vector_type(2)));
typedef float f32x4 __attribute__((ext_vector_type(4)));
typedef float f32x16 __attribute__((ext_vector_type(16)));
typedef unsigned u32x2 __attribute__((ext_vector_type(2)));
typedef unsigned u32x4 __attribute__((ext_vector_type(4)));
typedef __bf16 bf16v2 __attribute__((ext_vector_type(2)));

__device__ __forceinline__ unsigned pk2(float lo, float hi) { f32x2 v = {lo, hi}; bf16v2 b = __builtin_convertvector(v, bf16v2); return __builtin_bit_cast(unsigned, b); }
__device__ __forceinline__ float bflo(unsigned w) { return __uint_as_float(w << 16); }
__device__ __forceinline__ float bfhi(unsigned w) { return __uint_as_float(w & 0xffff0000u); }
__device__ __forceinline__ float sigmoidf_(float x) { return 1.0f / (1.0f + __expf(-x)); }
__device__ __forceinline__ float gelu_tanh(float y) { const float t = 0.7978845608028654f * (y + 0.044715f * y * y * y); const float e = __expf(2.0f * t); const float th = 1.0f - 2.0f / (e + 1.0f); return 0.5f * y * (1.0f + th); }

__device__ __forceinline__ int tid_l() { int t = threadIdx.x; asm volatile("" : "+v"(t)); return t; }
__device__ __forceinline__ int sg_l(int v) { v = __builtin_amdgcn_readfirstlane(v); asm volatile("" : "+s"(v)); return v; }
constexpr int L = 16384, DM = 1024, NH = 8, HD = 128, NBLK = 64;
constexpr size_t MiB = 1u << 20;
constexpr size_t WS_CTL = 0, WS_BAR = 16 * 1024, WS_KMEAN = 256 * 1024, WS_ROWSQ = 512 * 1024;
constexpr int LDS_BARST = 146432;
constexpr size_t WS_W = 1 * MiB, WS_TAB = 11 * MiB, WS_XN = 21 * MiB, WS_BIG = 53 * MiB;
constexpr size_t WS_U = WS_BIG, WS_Z = WS_BIG + 32 * MiB, WS_YG = WS_BIG + 64 * MiB, WS_Y2 = WS_BIG + 96 * MiB;
constexpr size_t WS_P1 = 181 * MiB, WS_P2 = 213 * MiB, WS_SLOC = 181 * MiB, WS_SIN = 213 * MiB;
constexpr size_t WS_LPART = 245 * MiB, WS_ROPE = 247 * MiB, WS_EP = 249 * MiB, WS_END = 251 * MiB;
constexpr int EP_STRIDE = 19 * 64 * 2;
constexpr int TAB_STRIDE = 147456;
constexpr int LIST_PER_HEAD = 516096;
__host__ __device__ __forceinline__ int list_off(int n) { return 16128 * n - 128 * n * (n - 1); }
constexpr int LDS_BYTES = 147456;
constexpr float NORM_EPS = 1e-6f;

namespace pg8 {
constexpr int M_ROWS = 16384;
constexpr int BM = 256, BK = 64, HALF = 128, HTB = HALF * BK * 2, STAGE_BYTES = 8 * HTB, NXCD = 8, WGM = 8;
__host__ __device__ __forceinline__ int lds_byte(int r, int c) { const int st = (r >> 4) * 2 + (c >> 5), rr = r & 15, cc = c & 31, ob = rr * 64 + cc * 2; return st * 1024 + (ob ^ (((ob >> 9) & 1) << 5)); }
__host__ __device__ __forceinline__ void stage_rc(int b, int& R, int& C) { const int st = b / 1024, sb = b % 1024, swz = sb ^ (((sb >> 9) & 1) << 5); R = (st >> 1) * 16 + swz / 64; C = (st & 1) * 32 + (swz % 64) / 2; }
__host__ __device__ __forceinline__ int perm32(int rho) { const int n = rho >> 4, i = rho & 15; return 8 * (i >> 2) + 4 * n + (i & 3); }
struct Unit { int pm, pn; };
struct Gemm { const bf16_t* A; const bf16_t* Bt; int M, N, K; };
struct StaticOrder {
    int nM, nN, nwg, G, c;
    __host__ __device__ void init(int M, int N, int G_, int c_) { nM = M / BM; nN = N / BM; nwg = nM * nN; G = G_; c = c_; }
    __host__ __device__ bool next(int i, Unit& u) const {
        const long Lx = (long)i * G + c; if (Lx >= nwg) return false;
        int wgid = (int)Lx; { const int q = nwg / NXCD, r = nwg % NXCD, xcd = wgid % NXCD, off = wgid / NXCD; wgid = (xcd < r ? xcd * (q + 1) : r * (q + 1) + (xcd - r) * q) + off; }
        const int nig = WGM * nN, gid = wgid / nig, fm = gid * WGM, gsz = (nM - fm) < WGM ? (nM - fm) : WGM;
        u.pm = fm + ((wgid % nig) % gsz); u.pn = (wgid % nig) / gsz; return true;
    }
    __device__ __forceinline__ void a_ready(const Unit&) const {}
    __device__ __forceinline__ void done(const Unit&) const {}
};

struct EpiStore {
    static constexpr bool PERM = true, AFTER_DRAIN = false;
    bf16_t* O; int ldc; int split_cols; size_t split_stride; const float* rowsq; int ugm;
    __device__ __forceinline__ void operator()(const f32x4 (&acc)[2][2][4][2], const Unit& u, int wr, int wc, int fr, int fq) const {
        const int row0 = u.pm * BM + wr * 64 + fr; int colt = u.pn * BM; bf16_t* base = O;
        if (split_cols) { const int t = colt / split_cols; base += (size_t)t * split_stride; colt -= t * split_cols; }
        const int col0 = colt + wc * 32 + 8 * fq; const bool gm = ugm && base == O;
        float rsv[2][4];
#pragma unroll
        for (int ai = 0; ai < 2; ++ai)
#pragma unroll
            for (int m = 0; m < 4; ++m) rsv[ai][m] = rsqrtf(rowsq[row0 + ai * HALF + m * 16] * (1.f / 1024.f) + NORM_EPS);
        asm volatile("" ::: "memory");
#pragma unroll
        for (int ai = 0; ai < 2; ++ai)
#pragma unroll
            for (int m = 0; m < 4; ++m) { bf16_t* rowp = gm ? base + ((size_t)(col0 >> 4) * M_ROWS + (row0 + ai * HALF + m * 16)) * 16 + (col0 & 15) : base + (size_t)(row0 + ai * HALF + m * 16) * ldc + col0;
                const float rs = rsv[ai][m];
#pragma unroll
                for (int bj = 0; bj < 2; ++bj) { const f32x4 v0 = acc[ai][bj][m][0] * rs, v1 = acc[ai][bj][m][1] * rs;
                    u32x4 w; w.x = pk2(v0[0], v0[1]); w.y = pk2(v0[2], v0[3]); w.z = pk2(v1[0], v1[1]); w.w = pk2(v1[2], v1[3]);
                    *(u32x4*)(rowp + (gm ? (size_t)bj * 8 * M_ROWS * 16 : (size_t)bj * HALF)) = w; } }
    }
};
struct EpiGlu {
    static constexpr bool PERM = true, AFTER_DRAIN = false;
    const bf16_t* YG; const bf16_t* Z; const float* bias; bf16_t* O;
    __device__ __forceinline__ void operator()(const f32x4 (&acc)[2][2][4][2], const Unit& u, int wr, int wc, int fr, int fq) const {
        const int row0 = u.pm * BM + wr * 64 + fr; const int col0 = u.pn * BM + wc * 32 + 8 * fq;
        f32x4 b0[2], b1[2];
#pragma unroll
        for (int bj = 0; bj < 2; ++bj) { b0[bj] = *(const f32x4*)(bias + col0 + bj * HALF); b1[bj] = *(const f32x4*)(bias + col0 + bj * HALF + 4); }
#pragma unroll
        for (int aq = 0; aq < 4; ++aq) {
            const int ai = aq >> 1, mh = (aq & 1) * 2;
            u32x4 yv[2][2], zv[2][2];
#pragma unroll
            for (int m2 = 0; m2 < 2; ++m2)
#pragma unroll
                for (int bj = 0; bj < 2; ++bj) {
                    const int row = row0 + ai * HALF + (mh + m2) * 16, colg = col0 + bj * HALF;
                    yv[m2][bj] = *(const u32x4*)(YG + ((size_t)(colg >> 4) * M_ROWS + row) * 16 + (colg & 15));
                    zv[m2][bj] = *(const u32x4*)(Z + (size_t)row * DM + colg);
                }
            asm volatile("" ::: "memory");
#pragma unroll
            for (int m2 = 0; m2 < 2; ++m2)
#pragma unroll
                for (int bj = 0; bj < 2; ++bj) {
                    const int m = mh + m2;
                    const size_t off = (size_t)(row0 + ai * HALF + m * 16) * DM + col0 + bj * HALF;
                    const f32x4 v0 = acc[ai][bj][m][0] + b0[bj], v1 = acc[ai][bj][m][1] + b1[bj];
                    float r[8];
#pragma unroll
                    for (int q = 0; q < 4; ++q) {
                        const float a0 = q < 2 ? v0[2 * q] : v1[2 * q - 4], a1 = q < 2 ? v0[2 * q + 1] : v1[2 * q - 3];
                        const float y0 = bflo(yv[m2][bj][q]), y1 = bfhi(yv[m2][bj][q]), z0 = bflo(zv[m2][bj][q]), z1 = bfhi(zv[m2][bj][q]);
                        r[2 * q] = y0 * sigmoidf_(a0) * (z0 * sigmoidf_(z0)); r[2 * q + 1] = y1 * sigmoidf_(a1) * (z1 * sigmoidf_(z1));
                    }
                    u32x4 w; w.x = pk2(r[0], r[1]); w.y = pk2(r[2], r[3]); w.z = pk2(r[4], r[5]); w.w = pk2(r[6], r[7]);
                    *(u32x4*)(O + off) = w;
                }
        }
    }
};
struct EpiRes {
    static constexpr bool PERM = true, AFTER_DRAIN = false;
    const float* base; float* out; bf16_t* xn; float* rowsq;
    __device__ __forceinline__ void operator()(const f32x4 (&acc)[2][2][4][2], const Unit& u, int wr, int wc, int fr, int fq) const {
        const int row0 = u.pm * BM + wr * 64 + fr; const int col0 = u.pn * BM + wc * 32 + 8 * fq;
#pragma unroll
        for (int ai = 0; ai < 2; ++ai) {
            f32x4 pre[4][2][2];
#pragma unroll
            for (int m = 0; m < 4; ++m)
#pragma unroll
                for (int bj = 0; bj < 2; ++bj) { const size_t off = (size_t)(row0 + ai * HALF + m * 16) * DM + col0 + bj * HALF;
                    pre[m][bj][0] = *(const f32x4*)(base + off); pre[m][bj][1] = *(const f32x4*)(base + off + 4); }
            asm volatile("" ::: "memory");
#pragma unroll
            for (int m = 0; m < 4; ++m) {
                float ss = 0.f;
#pragma unroll
                for (int bj = 0; bj < 2; ++bj) {
                    const size_t off = (size_t)(row0 + ai * HALF + m * 16) * DM + col0 + bj * HALF;
                    const f32x4 v0 = pre[m][bj][0] + acc[ai][bj][m][0], v1 = pre[m][bj][1] + acc[ai][bj][m][1];
                    *(f32x4*)(out + off) = v0; *(f32x4*)(out + off + 4) = v1;
                    if (xn) {
                        u32x4 w; w.x = pk2(v0[0], v0[1]); w.y = pk2(v0[2], v0[3]); w.z = pk2(v1[0], v1[1]); w.w = pk2(v1[2], v1[3]);
                        *(u32x4*)(xn + off) = w;
                        ss += (v0[0] * v0[0] + v0[1] * v0[1]) + (v0[2] * v0[2] + v0[3] * v0[3]) + (v1[0] * v1[0] + v1[1] * v1[1]) + (v1[2] * v1[2] + v1[3] * v1[3]);
                    }
                }
                if (xn) { ss += __shfl_xor(ss, 16); ss += __shfl_xor(ss, 32); if (fq == 0) atomicAdd(rowsq + row0 + ai * HALF + m * 16, ss); }
            }
        }
    }
};

template <class Epi, class Sched, bool ALIGN_EPI = false, bool SP2 = false, bool AGM = false>
__device__ __forceinline__ void gemm_phase(LAS unsigned char* lds, const Gemm g, const Sched& S, const Epi& E) {
    const int tid = tid_l(), wid = __builtin_amdgcn_readfirstlane(tid >> 6), lane = tid & 63, wr = wid >> 2, wc = wid & 3, fr = lane & 15, fq = lane >> 4;
    const int K = g.K, nt = K / BK;
    unsigned voffA[2], voffB[2];
#pragma unroll
    for (int i = 0; i < 2; ++i) { int R, C; stage_rc(tid * 16 + i * 8192, R, C); const int Rb = Epi::PERM ? ((R & ~31) + perm32(R & 31)) : R;
        voffA[i] = AGM ? (unsigned)(((C >> 4) * M_ROWS + R) * 16 + (C & 15)) * 2u : (unsigned)(R * K + C) * 2u; voffB[i] = (unsigned)(Rb * K + C) * 2u; }
    const size_t kstep = (size_t)(BK * 2);
    const size_t hstep = (size_t)HALF * K * 2;
    const size_t tstep = 2 * hstep;
    const size_t kstepA = AGM ? (size_t)4 * M_ROWS * 32 : kstep, hstepA = AGM ? (size_t)HALF * 32 : hstep, tstepA = 2 * hstepA;
    const unsigned ldsw = (unsigned)wid * 1024u;
    const int aoff = lds_byte(wr * 64 + fr, fq * 8), boff = lds_byte(wc * 32 + fr, fq * 8);
#define PG8_SA(b, h) (((b) * 2 + (h)) * HTB)
#define PG8_SB(b, h) ((4 + (b) * 2 + (h)) * HTB)
#define PG8_STAGE(bufoff, gbase, voff) do { _Pragma("unroll") for (int _i = 0; _i < 2; ++_i) \
        __builtin_amdgcn_global_load_lds((const unsigned*)((const char*)(gbase) + (voff)[_i]), (LAS unsigned*)(lds + (bufoff) + ldsw + _i * 8192), 16, 0, 0); } while (0)
#define PG8_LDA(dst, b, h) do { _Pragma("unroll") for (int m = 0; m < 4; ++m) _Pragma("unroll") for (int k = 0; k < 2; ++k) dst[m][k] = *(const LAS bf16x8*)(lds + PG8_SA(b, h) + aoff + m * 2048 + k * 1024); } while (0)
#define PG8_LDB(dst, b, h) do { _Pragma("unroll") for (int n = 0; n < 2; ++n) _Pragma("unroll") for (int k = 0; k < 2; ++k) dst[n][k] = *(const LAS bf16x8*)(lds + PG8_SB(b, h) + boff + n * 2048 + k * 1024); } while (0)
#define PG8_MMA(ai, bj, At, Bt) do { __builtin_amdgcn_s_setprio(1); _Pragma("unroll") for (int m = 0; m < 4; ++m) _Pragma("unroll") for (int n = 0; n < 2; ++n) _Pragma("unroll") for (int k = 0; k < 2; ++k) \
        acc[ai][bj][m][n] = __builtin_amdgcn_mfma_f32_16x16x32_bf16(Bt[n][k], At[m][k], acc[ai][bj][m][n], 0, 0, 0); __builtin_amdgcn_s_setprio(0); } while (0)
#define PG8_WAIT_V(n) asm volatile("s_waitcnt vmcnt(" #n ")" ::: "memory")
#define PG8_WAIT_L(n) asm volatile("s_waitcnt lgkmcnt(" #n ")" ::: "memory")
#define PG8_BAR __builtin_amdgcn_s_barrier()
#define PG8_SCHED __builtin_amdgcn_sched_barrier(0)
    Unit cur, nxt; int ui = 0;
    if (!S.next(0, cur)) return;
    f32x4 acc[2][2][4][2];
#pragma unroll
    for (int a = 0; a < 2; ++a)
#pragma unroll
        for (int b = 0; b < 2; ++b)
#pragma unroll
            for (int m = 0; m < 4; ++m)
#pragma unroll
                for (int n = 0; n < 2; ++n) acc[a][b][m][n] = (f32x4){0.f, 0.f, 0.f, 0.f};
    bf16x8 At[4][2], B0[2][2], B1[2][2];
    const char* cA = (const char*)g.A + (size_t)cur.pm * tstepA; const char* cB = (const char*)g.Bt + (size_t)cur.pn * tstep;
    S.a_ready(cur);
    if constexpr (SP2) {
        PG8_STAGE(PG8_SB(0, 0), cB, voffB); PG8_STAGE(PG8_SB(0, 1), cB + hstep, voffB); PG8_STAGE(PG8_SA(0, 0), cA, voffA); PG8_STAGE(PG8_SA(0, 1), cA + hstepA, voffA);
        if (wr == 1) PG8_BAR;
        PG8_WAIT_V(2); PG8_BAR;
        PG8_STAGE(PG8_SB(1, 0), cB + kstep, voffB); PG8_STAGE(PG8_SA(1, 0), cA + kstepA, voffA); PG8_STAGE(PG8_SB(1, 1), cB + hstep + kstep, voffB);
        PG8_WAIT_V(6); PG8_BAR;
    } else {
        PG8_STAGE(PG8_SB(0, 0), cB, voffB); PG8_STAGE(PG8_SA(0, 0), cA, voffA); PG8_STAGE(PG8_SB(0, 1), cB + hstep, voffB); PG8_STAGE(PG8_SA(0, 1), cA + hstepA, voffA);
        if (wr == 1) PG8_BAR;
        PG8_WAIT_V(4); PG8_BAR;
        PG8_STAGE(PG8_SB(1, 0), cB + kstep, voffB); PG8_STAGE(PG8_SA(1, 0), cA + kstepA, voffA); PG8_STAGE(PG8_SB(1, 1), cB + hstep + kstep, voffB);
        PG8_WAIT_V(6); PG8_BAR;
    }
    for (;;) {
        const bool has_next = S.next(ui + 1, nxt);
        const char* nA = has_next ? (const char*)g.A + (size_t)nxt.pm * tstepA : cA; const char* nB = has_next ? (const char*)g.Bt + (size_t)nxt.pn * tstep : cB;
        for (int t = 0; t < nt; t += 2) {
            const bool last = (t == nt - 2);
            const char* a1 = cA + (size_t)(t + 1) * kstepA;
            const char* a2 = last ? nA : cA + (size_t)(t + 2) * kstepA; const char* b2 = last ? nB : cB + (size_t)(t + 2) * kstep;
            const char* a3 = a2 + kstepA; const char* b3 = b2 + kstep;
            if (last && has_next) S.a_ready(nxt);
            if constexpr (SP2) {
            PG8_LDB(B0, 0, 0); PG8_LDB(B1, 0, 1); PG8_SCHED; PG8_LDA(At, 0, 0); PG8_STAGE(PG8_SA(1, 1), a1 + hstepA, voffA);
            PG8_WAIT_V(8); PG8_WAIT_L(0); PG8_BAR; PG8_MMA(0, 0, At, B0); PG8_MMA(0, 1, At, B1); PG8_BAR; PG8_SCHED;
            PG8_LDA(At, 0, 1); PG8_STAGE(PG8_SB(0, 0), b2, voffB); PG8_STAGE(PG8_SB(0, 1), b2 + hstep, voffB); PG8_STAGE(PG8_SA(0, 0), a2, voffA);
            PG8_WAIT_V(8); PG8_WAIT_L(0); PG8_BAR; PG8_MMA(1, 0, At, B0); PG8_MMA(1, 1, At, B1); PG8_BAR; PG8_SCHED;
            PG8_LDB(B0, 1, 0); PG8_LDB(B1, 1, 1); PG8_SCHED; PG8_LDA(At, 1, 0); PG8_STAGE(PG8_SA(0, 1), a2 + hstepA, voffA);
            PG8_WAIT_V(8); PG8_WAIT_L(0); PG8_BAR; PG8_MMA(0, 0, At, B0); PG8_MMA(0, 1, At, B1); PG8_BAR; PG8_SCHED;
            PG8_LDA(At, 1, 1); PG8_STAGE(PG8_SB(1, 0), b3, voffB); PG8_STAGE(PG8_SB(1, 1), b3 + hstep, voffB); PG8_STAGE(PG8_SA(1, 0), a3, voffA);
            PG8_WAIT_V(8); PG8_WAIT_L(0); PG8_BAR; PG8_MMA(1, 0, At, B0); PG8_MMA(1, 1, At, B1); PG8_BAR; PG8_SCHED;
            } else {
            PG8_LDB(B0, 0, 0); PG8_SCHED; PG8_LDA(At, 0, 0); PG8_STAGE(PG8_SA(1, 1), a1 + hstepA, voffA);
            PG8_WAIT_L(8); PG8_BAR; PG8_WAIT_L(0); PG8_MMA(0, 0, At, B0); PG8_BAR; PG8_SCHED;
            PG8_LDB(B1, 0, 1); PG8_STAGE(PG8_SB(0, 0), b2, voffB);
            PG8_BAR; PG8_WAIT_L(0); PG8_MMA(0, 1, At, B1); PG8_BAR;
            PG8_LDA(At, 0, 1); PG8_STAGE(PG8_SA(0, 0), a2, voffA);
            PG8_BAR; PG8_WAIT_L(0); PG8_MMA(1, 0, At, B0); PG8_BAR; PG8_SCHED;
            PG8_STAGE(PG8_SB(0, 1), b2 + hstep, voffB);
            PG8_WAIT_V(6); PG8_BAR; PG8_MMA(1, 1, At, B1); PG8_BAR;
            PG8_LDB(B0, 1, 0); PG8_SCHED; PG8_LDA(At, 1, 0); PG8_STAGE(PG8_SA(0, 1), a2 + hstepA, voffA);
            PG8_WAIT_L(8); PG8_BAR; PG8_WAIT_L(0); PG8_MMA(0, 0, At, B0); PG8_BAR; PG8_SCHED;
            PG8_LDB(B1, 1, 1); PG8_STAGE(PG8_SB(1, 0), b3, voffB);
            PG8_BAR; PG8_WAIT_L(0); PG8_MMA(0, 1, At, B1); PG8_BAR;
            PG8_LDA(At, 1, 1); PG8_STAGE(PG8_SA(1, 0), a3, voffA);
            PG8_BAR; PG8_WAIT_L(0); PG8_MMA(1, 0, At, B0); PG8_BAR; PG8_SCHED;
            PG8_STAGE(PG8_SB(1, 1), b3 + hstep, voffB);
            PG8_WAIT_V(6); PG8_BAR; PG8_MMA(1, 1, At, B1); PG8_BAR;
            }
        }
        if constexpr (ALIGN_EPI) { if (wr == 0) PG8_BAR; }
        if constexpr (!Epi::AFTER_DRAIN) { E(acc, cur, wr, wc, fr, fq); S.done(cur); }
        if (!has_next) break;
#pragma unroll
        for (int a = 0; a < 2; ++a)
#pragma unroll
            for (int b = 0; b < 2; ++b)
#pragma unroll
                for (int m = 0; m < 4; ++m)
#pragma unroll
                    for (int n = 0; n < 2; ++n) acc[a][b][m][n] = (f32x4){0.f, 0.f, 0.f, 0.f};
        cur = nxt; cA = nA; cB = nB; ++ui;
        if constexpr (ALIGN_EPI) { if (wr == 1) PG8_BAR; }
    }
    PG8_WAIT_V(0);
    if constexpr (!ALIGN_EPI) { if (wr == 0) PG8_BAR; }
    PG8_BAR;
#undef PG8_SA
#undef PG8_SB
#undef PG8_STAGE
#undef PG8_LDA
#undef PG8_LDB
#undef PG8_MMA
#undef PG8_WAIT_V
#undef PG8_WAIT_L
#undef PG8_BAR
#undef PG8_SCHED
}
}

struct Args { const float* in[18]; float* out; unsigned char* ws; };
typedef const __attribute__((address_space(4))) Args* ArgsP;
__device__ __forceinline__ ArgsP launder(ArgsP p) { asm volatile("" : "+s"(p)); return p; }

#define MFMA16(a, b, c) __builtin_amdgcn_mfma_f32_16x16x32_bf16((a), (b), (c), 0, 0, 0)
#define MFMA32(a, b, c) __builtin_amdgcn_mfma_f32_32x32x16_bf16((a), (b), (c), 0, 0, 0)

__device__ __forceinline__ float wave_sum(float v) {
#pragma unroll
    for (int o = 1; o < 64; o <<= 1) v += __shfl_xor(v, o);
    return v;
}

__device__ __forceinline__ int head_perm(int x) { const int pos = x & 127; return (x & ~127) + (pos & 3) * 32 + (pos >> 2); }
template <int MODE, bool GAIN>
__device__ __forceinline__ void transpose_item(const float* W, int K, int N, bf16_t* WT, float* scr, int item, int lane, const float* gain = nullptr) {
    const int nblk = N / 32, kb = item / nblk, nb = item % nblk, k0 = 64 * kb, n0 = 32 * nb;
#pragma unroll 8
    for (int i = 0; i < 32; ++i) { const int kk = 2 * i + (lane >> 5); int sk = k0 + kk, sn = n0 + (lane & 31);
        if (MODE == 1 && sn >= 3072) sn = head_perm(sn);
        if (MODE == 2) sk = head_perm(sk);
        scr[kk * 33 + (lane & 31)] = W[(size_t)sk * N + sn] * (GAIN ? gain[sk] : 1.f); }
    __builtin_amdgcn_wave_barrier(); asm volatile("s_waitcnt lgkmcnt(0)" ::: "memory");
    const int c = lane & 7;
#pragma unroll
    for (int j = 0; j < 4; ++j) { const int n = (lane >> 3) + 8 * j; const float* s = scr + (8 * c) * 33 + n;
        u32x4 o; o.x = pk2(s[0 * 33], s[1 * 33]); o.y = pk2(s[2 * 33], s[3 * 33]); o.z = pk2(s[4 * 33], s[5 * 33]); o.w = pk2(s[6 * 33], s[7 * 33]);
        *(u32x4*)(WT + (size_t)(n0 + n) * K + k0 + 8 * c) = o; }
    asm volatile("s_waitcnt lgkmcnt(0)" ::: "memory"); __builtin_amdgcn_wave_barrier();
}

__device__ __forceinline__ void ssm_tables(ArgsP a, int j, int g, unsigned char* smem, unsigned char* tab) {
    float* Epow = (float*)smem;
    float* Bb = Epow + 17 * 64 * 2;
    float* Cc = Bb + 64 * 16 * 2;
    float* Fp = Cc + 16 * 64 * 2;
    float* Km = Fp + 128;
    const int tid = tid_l();
    const float* a_re = a->in[3] + (size_t)(j * 64 + g) * 64; const float* a_im = a->in[4] + (size_t)(j * 64 + g) * 64;
    const float* b_re = a->in[6] + (size_t)(j * 64 + g) * 64 * 16; const float* b_im = a->in[7] + (size_t)(j * 64 + g) * 64 * 16;
    const float* c_re = a->in[8] + (size_t)(j * 64 + g) * 16 * 64; const float* c_im = a->in[9] + (size_t)(j * 64 + g) * 16 * 64;
    { const float* ep = (const float*)(a->ws + WS_EP) + (size_t)(j * 64 + g) * EP_STRIDE;
      for (int e = tid; e < 17 * 64 * 2; e += 512) Epow[e] = ep[e];
      if (tid < 128) Fp[tid] = ep[18 * 128 + tid]; }
    __syncthreads();
    for (int e = tid; e < 1024; e += 512) {
        { const int p = e >> 4; const float fr_ = Fp[p * 2], fi_ = Fp[p * 2 + 1], br = b_re[e], bi = b_im[e];
          Bb[e * 2] = fr_ * br - fi_ * bi; Bb[e * 2 + 1] = fr_ * bi + fi_ * br; }
        Cc[e * 2] = c_re[e]; Cc[e * 2 + 1] = c_im[e];
    }
    __syncthreads();
    for (int e = tid; e < 4096; e += 512) {
        const int d = e >> 8, c = (e >> 4) & 15, c2 = e & 15; float acc = 0.f;
        for (int p = 0; p < 64; ++p) {
            const float ar = Epow[(d * 64 + p) * 2], ai = Epow[(d * 64 + p) * 2 + 1], br = Bb[(p * 16 + c2) * 2], bi = Bb[(p * 16 + c2) * 2 + 1];
            const float gr = ar * br - ai * bi, gi = ar * bi + ai * br;
            acc += Cc[(c * 64 + p) * 2] * gr - Cc[(c * 64 + p) * 2 + 1] * gi;
        }
        Km[e] = acc;
    }
    __syncthreads();
    for (int e = tid; e < 16 * 64; e += 512) {
        const int d = e >> 6, l = e & 63, c = l & 15, ts = l >> 5, c0 = ((l >> 4) & 1) * 8, dd = d - ts; float v[8];
#pragma unroll
        for (int jj = 0; jj < 8; ++jj) v[jj] = dd >= 0 ? Km[(dd * 16 + c) * 16 + c0 + jj] : 0.f;
        u32x4 w; w.x = pk2(v[0], v[1]); w.y = pk2(v[2], v[3]); w.z = pk2(v[4], v[5]); w.w = pk2(v[6], v[7]);
        *(u32x4*)(tab + d * 1024 + l * 16) = w;
    }
    for (int e = tid; e < 64 * 64; e += 512) {
        const int f = e >> 6, l = e & 63, mt = f >> 3, ks = f & 7, m = mt * 16 + (l & 15), p = m >> 1, ri = m & 1, tau = ks * 2 + (l >> 5), c0 = ((l >> 4) & 1) * 8;
        const float ar = Epow[((15 - tau) * 64 + p) * 2], ai = Epow[((15 - tau) * 64 + p) * 2 + 1]; float v[8];
#pragma unroll
        for (int jj = 0; jj < 8; ++jj) { const float br = Bb[(p * 16 + c0 + jj) * 2], bi = Bb[(p * 16 + c0 + jj) * 2 + 1]; v[jj] = ri == 0 ? (ar * br - ai * bi) : (ar * bi + ai * br); }
        u32x4 w; w.x = pk2(v[0], v[1]); w.y = pk2(v[2], v[3]); w.z = pk2(v[4], v[5]); w.w = pk2(v[6], v[7]);
        *(u32x4*)(tab + 16384 + f * 1024 + l * 16) = w;
    }
    for (int e = tid; e < 64 * 64; e += 512) {
        const int f = e >> 6, l = e & 63, t = f >> 2, kk = f & 3, c = l & 15, m0 = kk * 32 + (l >> 4) * 8; float v[8];
#pragma unroll
        for (int jj = 0; jj < 8; ++jj) { const int m = m0 + jj, p = m >> 1, ri = m & 1;
            const float ar = Epow[((t + 1) * 64 + p) * 2], ai = Epow[((t + 1) * 64 + p) * 2 + 1], cr = Cc[(c * 64 + p) * 2], ci = Cc[(c * 64 + p) * 2 + 1];
            v[jj] = ri == 0 ? (cr * ar - ci * ai) : -(cr * ai + ci * ar); }
        u32x4 w; w.x = pk2(v[0], v[1]); w.y = pk2(v[2], v[3]); w.z = pk2(v[4], v[5]); w.w = pk2(v[6], v[7]);
        *(u32x4*)(tab + 16384 + 65536 + f * 1024 + l * 16) = w;
    }
    __syncthreads();
}

__device__ __forceinline__ void pre0_phase(ArgsP a) {
    const int tid = tid_l(), G = sg_l(gridDim.x), bid = sg_l(blockIdx.x);
    unsigned char* ws = a->ws;
    float* rope = (float*)(ws + WS_ROPE);
    for (int e = bid * 512 + tid; e < L * 16; e += G * 512) {
        const int pos = e >> 4, i = e & 15;
        const double invf = exp(-(double)i * (1.0 / 16.0) * 13.122363377404328);
        double ang = (double)pos * invf; ang -= 6.283185307179586476925 * floor(ang / 6.283185307179586476925);
        rope[e * 2] = (float)cos(ang); rope[e * 2 + 1] = (float)sin(ang);
    }
    float* epb = (float*)(ws + WS_EP);
    for (int e = bid * 512 + tid; e < 2 * 64 * 19 * 64; e += G * 512) {
        const int p = e & 63, n = (e >> 6) % 19, jg = (e >> 6) / 19;
        const double dt = exp((double)a->in[5][jg]);
        const double lr = (double)a->in[3][(size_t)jg * 64 + p], li = (double)a->in[4][(size_t)jg * 64 + p];
        const double pw = n <= 16 ? (double)n : (n == 17 ? 512.0 : 1.0);
        const double mag = exp(lr * dt * pw); double ang = li * dt * pw; ang -= 6.283185307179586476925 * floor(ang / 6.283185307179586476925);
        double cr = cos(ang) * mag, ci = sin(ang) * mag;
        if (n == 18) { const double nr = cr - 1.0, ni = ci, den = lr * lr + li * li; cr = (nr * lr + ni * li) / den; ci = (ni * lr - nr * li) / den; }
        epb[(size_t)jg * EP_STRIDE + (n * 64 + p) * 2] = (float)cr; epb[(size_t)jg * EP_STRIDE + (n * 64 + p) * 2 + 1] = (float)ci;
    }
}
__device__ __forceinline__ void prep_phase(ArgsP a, int layer, const float* h, unsigned char* smem) {
    const int tid = tid_l(), lane = tid & 63, wave = tid >> 6, G = sg_l(gridDim.x), bid = sg_l(blockIdx.x);
    unsigned char* ws = a->ws;
    const int j = layer >> 1;
    if ((layer & 1) == 0) {
        for (int g = bid; g < 64; g += G) ssm_tables(a, j, g, smem, ws + WS_TAB + (size_t)g * TAB_STRIDE);
    }
    __syncthreads();
    float* scr = (float*)(smem + wave * 16384);
    const int gw = bid * 8 + wave, NGW = G * 8;
    bf16_t* Wb = (bf16_t*)(ws + WS_W);
    const float* gain = a->in[1] + layer * 1024;
    if ((layer & 1) == 0) {
        const float* w_in = a->in[2] + (size_t)j * 1024 * 2048; const float* w_glu = a->in[11] + (size_t)j * 1024 * 1024; const float* w_out = a->in[13] + (size_t)j * 1024 * 1024;
        for (int it = gw; it < 2048; it += NGW) {
            if (it < 1024) transpose_item<0, true>(w_in, 1024, 2048, Wb, scr, it, lane, gain);
            else if (it < 1536) transpose_item<0, false>(w_glu, 1024, 1024, Wb + 2048 * 1024, scr, it - 1024, lane);
            else transpose_item<0, false>(w_out, 1024, 1024, Wb + 3072 * 1024, scr, it - 1536, lane);
        }
    } else {
        const float* w_in = a->in[14] + (size_t)j * 1024 * 4096; const float* w_out = a->in[17] + (size_t)j * 1024 * 1024;
        for (int it = gw; it < 2560; it += NGW) {
            if (it < 2048) transpose_item<1, true>(w_in, 1024, 4096, Wb, scr, it, lane, gain);
            else transpose_item<2, false>(w_out, 1024, 1024, Wb + 4096 * 1024, scr, it - 2048, lane);
        }
    }
    if (layer == 0) {
        bf16_t* XN = (bf16_t*)(ws + WS_XN); float* rowsq = (float*)(ws + WS_ROWSQ);
        for (int m = gw; m < L; m += NGW) {
            const f32x4* xr = (const f32x4*)(h + (size_t)m * DM) + lane;
            f32x4 v[4]; float s = 0.f;
#pragma unroll
            for (int q = 0; q < 4; ++q) { v[q] = xr[64 * q]; s += (v[q].x * v[q].x + v[q].y * v[q].y) + (v[q].z * v[q].z + v[q].w * v[q].w); }
            s = wave_sum(s);
            if (lane == 0) rowsq[m] = s;
            u32x2* o8 = (u32x2*)(XN + (size_t)m * DM) + lane;
#pragma unroll
            for (int q = 0; q < 4; ++q) { u32x2 w; w.x = pk2(v[q].x, v[q].y); w.y = pk2(v[q].z, v[q].w); o8[64 * q] = w; }
        }
    }
}

__device__ __forceinline__ void ssm_s1(ArgsP a, unsigned char* smem) {
    const int tid = tid_l(), lane = tid & 63, wave = tid >> 6, G = sg_l(gridDim.x);
    unsigned char* ws = a->ws;
    const bf16_t* U = (const bf16_t*)(ws + WS_U); float* SL = (float*)(ws + WS_SLOC);
    { float* rowsq = (float*)(ws + WS_ROWSQ); for (int e = sg_l(blockIdx.x) * 512 + tid; e < L; e += G * 512) rowsq[e] = 0.f; }
    for (int unit = sg_l(blockIdx.x); unit < 256; unit += G) {
        const int g = unit >> 2, qtr = unit & 3;
        __syncthreads();
        { const u32x4* src = (const u32x4*)(ws + WS_TAB + (size_t)g * TAB_STRIDE + 16384); u32x4* dst = (u32x4*)smem; u32x4 tr[8];
#pragma unroll
          for (int i = 0; i < 8; ++i) tr[i] = src[tid + i * 512];
#pragma unroll
          for (int i = 0; i < 8; ++i) dst[tid + i * 512] = tr[i]; }
        __syncthreads();
#pragma unroll 1
        for (int nt = 0; nt < 2; ++nt) {
            const int chunk0 = qtr * 256 + wave * 32 + nt * 16, n = lane & 15;
            bf16x8 B[8];
#pragma unroll
            for (int ks = 0; ks < 8; ++ks) B[ks] = *(const bf16x8*)(U + ((size_t)g * L + (chunk0 + n) * 16 + ks * 2 + (lane >> 5)) * 16 + ((lane >> 4) & 1) * 8);
#pragma unroll
            for (int mt = 0; mt < 8; ++mt) {
                f32x4 acc = {0.f, 0.f, 0.f, 0.f};
#pragma unroll
                for (int ks = 0; ks < 8; ++ks) { const bf16x8 A = *(const bf16x8*)(smem + (mt * 8 + ks) * 1024 + lane * 16); acc = MFMA16(A, B[ks], acc); }
                *(f32x4*)(SL + ((size_t)(chunk0 + n) * 64 + g) * 128 + mt * 16 + (lane >> 4) * 4) = acc;
                asm volatile("" ::: "memory");
            }
        }
    }
}
__device__ __forceinline__ void ssm_s2(ArgsP a, int j, unsigned char* smem) {
    const int tid = tid_l(), G = sg_l(gridDim.x);
    unsigned char* ws = a->ws;
    const float* SL = (const float*)(ws + WS_SLOC); unsigned* SIN = (unsigned*)(ws + WS_SIN);
    float* ex = (float*)smem;
    for (int unit = sg_l(blockIdx.x); unit < 256; unit += G) {
        const int seg = tid >> 4, sl = tid & 15, st = unit * 16 + sl, g = st >> 6, p = st & 63;
        const float* ep = (const float*)(ws + WS_EP) + (size_t)(j * 64 + g) * EP_STRIDE;
        const float e16r = ep[(16 * 64 + p) * 2], e16i = ep[(16 * 64 + p) * 2 + 1], eSr = ep[(17 * 64 + p) * 2], eSi = ep[(17 * 64 + p) * 2 + 1];
        const float* src = SL + ((size_t)(seg * 32) * 64 + g) * 128 + 2 * p;
        f32x2 v[32];
#pragma unroll
        for (int i = 0; i < 32; ++i) v[i] = *(const f32x2*)(src + (size_t)i * 8192);
        float sr = 0.f, si = 0.f;
#pragma unroll
        for (int i = 0; i < 32; ++i) { const float nr = e16r * sr - e16i * si + v[i].x, ni = e16r * si + e16i * sr + v[i].y; sr = nr; si = ni; }
        __syncthreads();
        ex[(seg * 16 + sl) * 2] = sr; ex[(seg * 16 + sl) * 2 + 1] = si;
        __syncthreads();
        float cr = 0.f, ci = 0.f;
        for (int s = 0; s < seg; ++s) { const float xr = ex[(s * 16 + sl) * 2], xi = ex[(s * 16 + sl) * 2 + 1]; const float nr = eSr * cr - eSi * ci + xr, ni = eSr * ci + eSi * cr + xi; cr = nr; ci = ni; }
        unsigned* dst = SIN + ((size_t)(seg * 32) * 64 + g) * 64 + p;
#pragma unroll
        for (int i = 0; i < 32; ++i) {
            dst[(size_t)i * 4096] = pk2(cr, ci);
            const float nr = e16r * cr - e16i * ci + v[i].x, ni = e16r * ci + e16i * cr + v[i].y; cr = nr; ci = ni;
        }
    }
}
__device__ __forceinline__ void ssm_s3(ArgsP a, int j, unsigned char* smem) {
    const int tid = tid_l(), lane = tid & 63, wave = tid >> 6, G = sg_l(gridDim.x);
    unsigned char* ws = a->ws;
    const bf16_t* U = (const bf16_t*)(ws + WS_U); const bf16_t* SIN = (const bf16_t*)(ws + WS_SIN); bf16_t* YG = (bf16_t*)(ws + WS_YG);
    const float* dsk = a->in[10] + j * 1024;
    for (int unit = sg_l(blockIdx.x); unit < 256; unit += G) {
        const int g = unit >> 2, qtr = unit & 3;
        __syncthreads();
        { const u32x4* srcF = (const u32x4*)(ws + WS_TAB + (size_t)g * TAB_STRIDE); u32x4* dst = (u32x4*)smem;
          const u32x4* srcC = (const u32x4*)(ws + WS_TAB + (size_t)g * TAB_STRIDE + 16384 + 65536); u32x4 tr[10];
#pragma unroll
          for (int i = 0; i < 2; ++i) tr[i] = srcF[tid + i * 512];
#pragma unroll
          for (int i = 0; i < 8; ++i) tr[2 + i] = srcC[tid + i * 512];
#pragma unroll
          for (int i = 0; i < 2; ++i) dst[tid + i * 512] = tr[i];
#pragma unroll
          for (int i = 0; i < 8; ++i) dst[1024 + tid + i * 512] = tr[2 + i]; }
        __syncthreads();
        const unsigned char* Fl = smem; const unsigned char* Wl = smem + 16384;
        const int n = lane & 15, cq = (lane >> 4) * 4;
        const f32x4 dv = *(const f32x4*)(dsk + g * 16 + cq);
#pragma unroll 1
        for (int nt = 0; nt < 2; ++nt) {
            const int chunk = qtr * 256 + wave * 32 + nt * 16 + n;
            bf16x8 Bu[8], Bs[4];
#pragma unroll
            for (int ks = 0; ks < 8; ++ks) Bu[ks] = *(const bf16x8*)(U + ((size_t)g * L + chunk * 16 + ks * 2 + (lane >> 5)) * 16 + ((lane >> 4) & 1) * 8);
#pragma unroll
            for (int kk = 0; kk < 4; ++kk) Bs[kk] = *(const bf16x8*)(SIN + ((size_t)chunk * 64 + g) * 128 + kk * 32 + (lane >> 4) * 8);
            u32x2 uvv[16];
#pragma unroll
            for (int t = 0; t < 16; ++t) uvv[t] = *(const u32x2*)(U + ((size_t)g * L + chunk * 16 + t) * 16 + cq);
#pragma unroll
            for (int t = 0; t < 16; ++t) {
                f32x4 acc = {0.f, 0.f, 0.f, 0.f};
#pragma unroll
                for (int i = 0; i <= t / 2; ++i) { const bf16x8 A = *(const bf16x8*)(Fl + (t - 2 * i) * 1024 + lane * 16); acc = MFMA16(A, Bu[i], acc); }
#pragma unroll
                for (int kk = 0; kk < 4; ++kk) { const bf16x8 A = *(const bf16x8*)(Wl + (t * 4 + kk) * 1024 + lane * 16); acc = MFMA16(A, Bs[kk], acc); }
                const size_t off = ((size_t)g * L + chunk * 16 + t) * 16 + cq;
                const u32x2 uv = uvv[t];
                const float y0 = gelu_tanh(acc[0] + dv[0] * bflo(uv.x)), y1 = gelu_tanh(acc[1] + dv[1] * bfhi(uv.x));
                const float y2 = gelu_tanh(acc[2] + dv[2] * bflo(uv.y)), y3 = gelu_tanh(acc[3] + dv[3] * bfhi(uv.y));
                u32x2 w; w.x = pk2(y0, y1); w.y = pk2(y2, y3);
                *(u32x2*)(YG + off) = w;
                asm volatile("" ::: "memory");
            }
        }
    }
}

constexpr int QK_STRIDE = 4096;
constexpr int KL_STRIDE = 272, VL_STRIDE = 520, VT_OFF = 256 * KL_STRIDE;

__device__ __forceinline__ void attn_a1(ArgsP a, int j, unsigned char* smem, int dry) {
    const int tid = tid_l(), G = sg_l(gridDim.x);
    unsigned char* ws = a->ws;
    bf16_t* QKVZ = (bf16_t*)(ws + WS_BIG); const float* rope = (const float*)(ws + WS_ROPE); float* kmean = (float*)(ws + WS_KMEAN);
    if (sg_l(blockIdx.x) == 0) ((unsigned*)(ws + WS_CTL))[tid] = 0u;
    if (!dry) { float* rowsq = (float*)(ws + WS_ROWSQ); for (int e = sg_l(blockIdx.x) * 512 + tid; e < L; e += G * 512) rowsq[e] = 0.f; }
    const int seg = tid & 15, rg = tid >> 4;
    const float* qg = a->in[15] + j * 128 + seg * 8; const float* kg = a->in[16] + j * 128 + seg * 8;
    float gq[8], gk[8];
#pragma unroll
    for (int i = 0; i < 8; ++i) { gq[i] = qg[i]; gk[i] = kg[i]; }
    float* red = (float*)(smem + 72 * 1024);
    for (int unit = sg_l(blockIdx.x); unit < 512; unit += G) {
        const int h = unit & 7, b = unit >> 3;
        float ksum[8];
#pragma unroll
        for (int i = 0; i < 8; ++i) ksum[i] = 0.f;
        __syncthreads();
#pragma unroll 1
        for (int pb = 0; pb < 2; ++pb) {
            u32x4 rq[4], rk[4], rv[4]; f32x2 rp[4][8];
#pragma unroll
            for (int p4 = 0; p4 < 4; ++p4) {
                const int t = b * 256 + (pb * 4 + p4) * 32 + rg;
                const bf16_t* p = QKVZ + (size_t)t * QK_STRIDE + h * 128 + seg * 8;
                rq[p4] = *(const u32x4*)p; rk[p4] = *(const u32x4*)(p + 1024); rv[p4] = *(const u32x4*)(p + 2048);
#pragma unroll
                for (int i = 0; i < 8; ++i) rp[p4][i] = *(const f32x2*)(rope + ((size_t)t * 16 + (seg & 1) * 8 + i) * 2);
            }
#pragma unroll
            for (int p4 = 0; p4 < 4; ++p4) {
                const int ps = pb * 4 + p4, t = b * 256 + ps * 32 + rg;
#pragma unroll
                for (int which = 0; which < 2; ++which) {
                    bf16_t* p = QKVZ + (size_t)t * QK_STRIDE + which * 1024 + h * 128 + seg * 8;
                    const u32x4 raw = which == 0 ? rq[p4] : rk[p4];
                    float x[8];
#pragma unroll
                    for (int q = 0; q < 4; ++q) { x[2 * q] = bflo(raw[q]); x[2 * q + 1] = bfhi(raw[q]); }
                    float ss = 0.f;
#pragma unroll
                    for (int i = 0; i < 8; ++i) ss += x[i] * x[i];
                    ss += __shfl_xor(ss, 1); ss += __shfl_xor(ss, 2); ss += __shfl_xor(ss, 4); ss += __shfl_xor(ss, 8);
                    const float rstd = rsqrtf(ss * (1.f / 128.f) + NORM_EPS);
#pragma unroll
                    for (int i = 0; i < 8; ++i) x[i] = x[i] * rstd * (which == 0 ? gq[i] : gk[i]);
                    float y[8];
#pragma unroll
                    for (int i = 0; i < 8; ++i) {
                        const float o = __shfl_xor(x[i], 2);
                        y[i] = x[i];
                        if (seg < 2) y[i] = x[i] * rp[p4][i].x - o * rp[p4][i].y;
                        else if (seg < 4) y[i] = x[i] * rp[p4][i].x + o * rp[p4][i].y;
                    }
                    u32x4 w; w.x = pk2(y[0], y[1]); w.y = pk2(y[2], y[3]); w.z = pk2(y[4], y[5]); w.w = pk2(y[6], y[7]);
                    if (!dry) *(u32x4*)p = w;
                    if (which == 1) {
#pragma unroll
                        for (int i = 0; i < 8; ++i) ksum[i] += y[i];
                    }
                }
                { const int key = ps * 32 + rg; *(u32x4*)(smem + key * 256 + ((seg ^ ((key >> 3) & 15)) * 16)) = rv[p4]; }
            }
        }
#pragma unroll
        for (int i = 0; i < 8; ++i) red[rg * 128 + seg * 8 + i] = ksum[i];
        __syncthreads();
        if (tid < 128) { float s = 0.f;
#pragma unroll
            for (int r = 0; r < 32; ++r) s += red[r * 128 + tid];
            if (!dry) kmean[((size_t)h * 64 + b) * 128 + tid] = s * (1.f / 256.f); }
        for (int e = tid; e < 4096; e += 512) {
            const int ko = e & 31, d = e >> 5, key0 = ko * 8;
            unsigned short v[8];
#pragma unroll
            for (int i = 0; i < 8; ++i) v[i] = *(const unsigned short*)(smem + (key0 + i) * 256 + (((d >> 3) ^ (ko & 15)) * 16) + (d & 7) * 2);
            u32x4 w; w.x = v[0] | ((unsigned)v[1] << 16); w.y = v[2] | ((unsigned)v[3] << 16); w.z = v[4] | ((unsigned)v[5] << 16); w.w = v[6] | ((unsigned)v[7] << 16);
            if (!dry) *(u32x4*)(QKVZ + (size_t)(b * 256 + 2 * d + (key0 >> 7)) * QK_STRIDE + 2048 + h * 128 + (key0 & 127)) = w;
        }
    }
}

__device__ __forceinline__ bool gate_better(float v, int i, float w, int k) { return v > w || (v == w && i < k); }
#define TOP3_INSERT(s_, n_) do { const float _s = (s_); const int _n = (n_); \
    const bool _b1 = gate_better(_s, _n, v1, i1), _b2 = gate_better(_s, _n, v2, i2), _b3 = gate_better(_s, _n, v3, i3); \
    const float _nv3 = _b2 ? v2 : (_b3 ? _s : v3); const int _ni3 = _b2 ? i2 : (_b3 ? _n : i3); \
    const float _nv2 = _b1 ? v1 : (_b2 ? _s : v2); const int _ni2 = _b1 ? i1 : (_b2 ? _n : i2); \
    const float _nv1 = _b1 ? _s : v1; const int _ni1 = _b1 ? _n : i1; \
    v1 = _nv1; i1 = _ni1; v2 = _nv2; i2 = _ni2; v3 = _nv3; i3 = _ni3; } while (0)
__device__ __forceinline__ void attn_a2(ArgsP a, unsigned char* smem, int dry) {
    const int tid = tid_l(), lane = tid & 63, wave = tid >> 6, G = sg_l(gridDim.x), r = lane & 31, hh = lane >> 5;
    unsigned char* ws = a->ws;
    const bf16_t* QKVZ = (const bf16_t*)(ws + WS_BIG); const float* kmean = (const float*)(ws + WS_KMEAN);
    unsigned* cnt = (unsigned*)(ws + WS_CTL); unsigned short* lists = (unsigned short*)(ws + WS_TAB);
    unsigned* cntl = (unsigned*)smem; unsigned* basel = cntl + 64;
    int cur_h = -1;
    bf16x8 Khi[2][8], Klo[2][8];
    for (int unit = sg_l(blockIdx.x); unit < 512; unit += G) {
        const int h = unit & 7, b = unit >> 3;
        if (b == 0) continue;
        if (h != cur_h) {
            cur_h = h;
#pragma unroll
            for (int tl = 0; tl < 2; ++tl)
#pragma unroll
                for (int kk = 0; kk < 8; ++kk) {
                    const float* kp = kmean + ((size_t)h * 64 + tl * 32 + r) * 128 + kk * 16 + hh * 8;
                    const f32x4 x0 = *(const f32x4*)kp, x1 = *(const f32x4*)(kp + 4);
                    u32x4 hi; hi.x = pk2(x0[0], x0[1]); hi.y = pk2(x0[2], x0[3]); hi.z = pk2(x1[0], x1[1]); hi.w = pk2(x1[2], x1[3]);
                    u32x4 lo; lo.x = pk2(x0[0] - bflo(hi.x), x0[1] - bfhi(hi.x)); lo.y = pk2(x0[2] - bflo(hi.y), x0[3] - bfhi(hi.y));
                    lo.z = pk2(x1[0] - bflo(hi.z), x1[1] - bfhi(hi.z)); lo.w = pk2(x1[2] - bflo(hi.w), x1[3] - bfhi(hi.w));
                    Khi[tl][kk] = __builtin_bit_cast(bf16x8, hi); Klo[tl][kk] = __builtin_bit_cast(bf16x8, lo);
                }
        }
        const int t = b * 256 + wave * 32 + r;
        bf16x8 qf[8];
#pragma unroll
        for (int kk = 0; kk < 8; ++kk) qf[kk] = *(const bf16x8*)(QKVZ + (size_t)t * QK_STRIDE + h * 128 + kk * 16 + hh * 8);
        float v1 = -INFINITY, v2 = -INFINITY, v3 = -INFINITY; int i1 = 1 << 20, i2 = 1 << 20, i3 = 1 << 20;
#pragma unroll
        for (int tl = 0; tl < 2; ++tl) {
            if (tl == 1 && b <= 32) break;
            f32x16 Gt;
#pragma unroll
            for (int i = 0; i < 16; ++i) Gt[i] = 0.f;
#pragma unroll
            for (int kk = 0; kk < 8; ++kk) { Gt = MFMA32(Khi[tl][kk], qf[kk], Gt); Gt = MFMA32(Klo[tl][kk], qf[kk], Gt); }
#pragma unroll
            for (int i = 0; i < 16; ++i) { const int n = tl * 32 + (i & 3) + 8 * (i >> 2) + 4 * hh; if (n < b) TOP3_INSERT(Gt[i], n); }
        }
        {
            const float w1 = __shfl_xor(v1, 32), w2 = __shfl_xor(v2, 32), w3 = __shfl_xor(v3, 32);
            const int k1 = __shfl_xor(i1, 32), k2 = __shfl_xor(i2, 32), k3 = __shfl_xor(i3, 32);
            TOP3_INSERT(w1, k1); TOP3_INSERT(w2, k2); TOP3_INSERT(w3, k3);
        }
        __syncthreads();
        if (tid < 64) cntl[tid] = 0u;
        __syncthreads();
        unsigned lp1 = 0u, lp2 = 0u, lp3 = 0u;
        if (hh == 0) {
            if (i1 < 64) lp1 = atomicAdd(&cntl[i1], 1u);
            if (i2 < 64) lp2 = atomicAdd(&cntl[i2], 1u);
            if (i3 < 64) lp3 = atomicAdd(&cntl[i3], 1u);
        }
        __syncthreads();
        if (tid < 64) { const unsigned c = cntl[tid]; basel[tid] = (c && !dry) ? atomicAdd(&cnt[h * 64 + tid], c) : 0u; }
        __syncthreads();
        if (hh == 0 && !dry) {
            unsigned short* lh = lists + (size_t)h * LIST_PER_HEAD;
            if (i1 < 64) lh[list_off(i1) + basel[i1] + lp1] = (unsigned short)(t);
            if (i2 < 64) lh[list_off(i2) + basel[i2] + lp2] = (unsigned short)(t | (1 << 14));
            if (i3 < 64) lh[list_off(i3) + basel[i3] + lp3] = (unsigned short)(t | (2 << 14));
        }
    }
}

__device__ __forceinline__ void load_kv(const bf16_t* QKVZ, int h, int n, unsigned char* smem) {
    const int tid = tid_l();
    u32x4 kr[8], vr[8];
#pragma unroll
    for (int i = 0; i < 8; ++i) { const int e = tid + i * 512, key = e >> 4, pc = e & 15;
        kr[i] = *(const u32x4*)(QKVZ + (size_t)(n * 256 + key) * QK_STRIDE + 1024 + h * 128 + pc * 8); }
#pragma unroll
    for (int i = 0; i < 8; ++i) { const int e = tid + i * 512, d = e >> 5, pc = e & 31, key0 = pc * 8;
        vr[i] = *(const u32x4*)(QKVZ + (size_t)(n * 256 + 2 * d + (key0 >> 7)) * QK_STRIDE + 2048 + h * 128 + (key0 & 127)); }
#pragma unroll
    for (int i = 0; i < 8; ++i) { const int e = tid + i * 512, key = e >> 4, pc = e & 15; *(u32x4*)(smem + key * KL_STRIDE + pc * 16) = kr[i]; }
#pragma unroll
    for (int i = 0; i < 8; ++i) { const int e = tid + i * 512, d = e >> 5, pc = e & 31;
        u32x2* dst = (u32x2*)(smem + VT_OFF + d * VL_STRIDE + pc * 16);
        dst[0] = (u32x2){vr[i].x, vr[i].y}; dst[1] = (u32x2){vr[i].z, vr[i].w}; }
}
__device__ __forceinline__ void attn_core(const unsigned char* smem, const bf16x8 (&qf)[8], int nkt, int mask_kt, int qidx, float c1, float c2, f32x16 (&O)[4], float& lsum) {
    const int lane = tid_l() & 63, r = lane & 31, hh = lane >> 5;
    const unsigned char* kbase = smem + r * KL_STRIDE + hh * 16;
    const unsigned char* vbase = smem + VT_OFF + r * VL_STRIDE + hh * 8;
    bf16x8 Kf[8];
#pragma unroll
    for (int kk = 0; kk < 8; ++kk) Kf[kk] = *(const bf16x8*)(kbase + kk * 32);
    for (int kt = 0; kt < nkt; ++kt) {
        f32x16 S;
#pragma unroll
        for (int i = 0; i < 16; ++i) S[i] = 0.f;
#pragma unroll
        for (int kk = 0; kk < 8; ++kk) S = MFMA32(Kf[kk], qf[kk], S);
        s16x4 Vl[2][4], Vh[2][4];
#pragma unroll
        for (int s = 0; s < 2; ++s)
#pragma unroll
            for (int dt = 0; dt < 4; ++dt) { const unsigned char* vp = vbase + dt * 32 * VL_STRIDE + (kt * 32 + 16 * s) * 2; Vl[s][dt] = *(const s16x4*)vp; Vh[s][dt] = *(const s16x4*)(vp + 16); }
        { const int ktn = kt + 1 < nkt ? kt + 1 : kt;
#pragma unroll
          for (int kk = 0; kk < 8; ++kk) Kf[kk] = *(const bf16x8*)(kbase + ktn * 32 * KL_STRIDE + kk * 32); }
        asm volatile("" ::: "memory");
        float p[16];
#pragma unroll
        for (int i = 0; i < 16; ++i) { p[i] = __builtin_amdgcn_exp2f(S[i] * c1 - c2);
            if (kt == mask_kt) { const int key = kt * 32 + (i & 3) + 8 * (i >> 2) + 4 * hh; if (key > qidx) p[i] = 0.f; }
            lsum += p[i]; }
#pragma unroll
        for (int s = 0; s < 2; ++s) {
            u32x4 pw; pw.x = pk2(p[8 * s], p[8 * s + 1]); pw.y = pk2(p[8 * s + 2], p[8 * s + 3]); pw.z = pk2(p[8 * s + 4], p[8 * s + 5]); pw.w = pk2(p[8 * s + 6], p[8 * s + 7]);
            const bf16x8 pa = __builtin_bit_cast(bf16x8, pw);
#pragma unroll
            for (int dt = 0; dt < 4; ++dt) {
                const bf16x8 Bv = __builtin_shufflevector(Vl[s][dt], Vh[s][dt], 0, 1, 2, 3, 4, 5, 6, 7);
                O[dt] = MFMA32(pa, Bv, O[dt]);
            }
        }
    }
}
__device__ __forceinline__ float attn_ref(ArgsP a, int j) {
    const int lane = tid_l() & 63;
    float mq = fmaxf(fabsf(a->in[15][j * 128 + lane]), fabsf(a->in[15][j * 128 + 64 + lane]));
    float mk = fmaxf(fabsf(a->in[16][j * 128 + lane]), fabsf(a->in[16][j * 128 + 64 + lane]));
#pragma unroll
    for (int o = 1; o < 64; o <<= 1) { mq = fmaxf(mq, __shfl_xor(mq, o)); mk = fmaxf(mk, __shfl_xor(mk, o)); }
    return 11.313708499f * mq * mk;
}
constexpr int LDS_LQ = 141312;

__device__ __forceinline__ void attn_a3(ArgsP a, int j, unsigned char* smem) {
    const int tid = tid_l(), lane = tid & 63, wave = tid >> 6, G = sg_l(gridDim.x), r = lane & 31, hh = lane >> 5;
    unsigned char* ws = a->ws;
    const bf16_t* QKVZ = (const bf16_t*)(ws + WS_BIG);
    const unsigned* cnt = (const unsigned*)(ws + WS_CTL); const unsigned short* lists = (const unsigned short*)(ws + WS_TAB);
    float* lpart = (float*)(ws + WS_LPART);
    int* pre = (int*)(smem + 140 * 1024);
    const float ref = attn_ref(a, j), c1 = 0.08838834764831845f * 1.4426950408889634f, c2 = ref * 1.4426950408889634f;
    int* cntl = (int*)(smem + 136192);
    __syncthreads();
    { const int c = (int)cnt[tid]; cntl[tid] = c; pre[tid] = (c + 255) >> 8; }
    __syncthreads();
    for (int o = 1; o < 512; o <<= 1) { const int v = pre[tid] + (tid >= o ? pre[tid - o] : 0); __syncthreads(); pre[tid] = v; __syncthreads(); }
    const int total = pre[511]; const int bidx = sg_l(blockIdx.x);
    const int t_lo = (int)(((long)total * bidx) / G), t_hi = (int)(((long)total * (bidx + 1)) / G);
    int cur_pr = -1;
    int e_cur = -1; bf16x8 qf[8];
    auto tile_info = [&](int tile, int& pr, int& tl) { int lo = 0, hi = 511; while (lo < hi) { const int mid = (lo + hi) >> 1; if (pre[mid] > tile) hi = mid; else lo = mid + 1; } pr = lo; tl = tile - (pr ? pre[pr - 1] : 0); };
    auto load_entry = [&](int tile) -> int { int pr, tl; tile_info(tile, pr, tl); const int h = pr >> 6, n = pr & 63, c = cntl[pr]; const int li = tl * 256 + wave * 32 + r; const bool valid = li < c;
        const unsigned e = lists[(size_t)h * LIST_PER_HEAD + list_off(n) + (valid ? li : 0)]; return (int)e | (valid ? 0x10000 : 0); };
    int e_nxt = -1;
    if (t_lo < t_hi) { e_cur = load_entry(t_lo); if (t_lo + 1 < t_hi) e_nxt = load_entry(t_lo + 1); int pr, tl; tile_info(t_lo, pr, tl); const int h = pr >> 6;
#pragma unroll
        for (int kk = 0; kk < 8; ++kk) qf[kk] = *(const bf16x8*)(QKVZ + (size_t)(e_cur & 0x3fff) * QK_STRIDE + h * 128 + kk * 16 + hh * 8); }
    for (int tile = t_lo; tile < t_hi; ++tile) {
        int pr, tl; tile_info(tile, pr, tl);
        const int h = pr >> 6, n = pr & 63;
        if (pr != cur_pr) { __syncthreads(); load_kv(QKVZ, h, n, smem); __syncthreads(); cur_pr = pr; }
        int e_nn = -1; bf16x8 qn[8];
        if (tile + 2 < t_hi) e_nn = load_entry(tile + 2);
        if (tile + 1 < t_hi) { int pr2, tl2; tile_info(tile + 1, pr2, tl2); const int h2 = pr2 >> 6;
#pragma unroll
            for (int kk = 0; kk < 8; ++kk) qn[kk] = *(const bf16x8*)(QKVZ + (size_t)(e_nxt & 0x3fff) * QK_STRIDE + h2 * 128 + kk * 16 + hh * 8); }
        else {
#pragma unroll
            for (int kk = 0; kk < 8; ++kk) qn[kk] = qf[kk];
        }
        f32x16 O[4];
#pragma unroll
        for (int dt = 0; dt < 4; ++dt)
#pragma unroll
            for (int i = 0; i < 16; ++i) O[dt][i] = 0.f;
        float lsum = 0.f;
        attn_core(smem, qf, 8, -1, 0, c1, c2, O, lsum);
        lsum += __shfl_xor(lsum, 32);
        if (hh == 0 && (e_cur & 0x10000)) lpart[((size_t)((e_cur >> 14) & 3) * L + (e_cur & 0x3fff)) * 8 + h] = lsum;
#pragma unroll
        for (int i = 0; i < 16; ++i) {
            const int ei = __shfl(e_cur, (i & 3) + 8 * (i >> 2) + 4 * hh);
            if (ei & 0x10000) {
                const int slot = (ei >> 14) & 3, ti = ei & 0x3fff;
                bf16_t* P = (bf16_t*)(ws + (slot == 0 ? WS_XN : (slot == 1 ? WS_P1 : WS_P2))) + (size_t)ti * DM + h * 128 + r * 4;
                u32x2 w; w.x = pk2(O[0][i], O[1][i]); w.y = pk2(O[2][i], O[3][i]);
                *(u32x2*)P = w;
            }
        }
        e_cur = e_nxt; e_nxt = e_nn;
#pragma unroll
        for (int kk = 0; kk < 8; ++kk) qf[kk] = qn[kk];
    }
}
__device__ __forceinline__ void attn_a4(ArgsP a, int j, unsigned char* smem, int dry) {
    const int tid = tid_l(), lane = tid & 63, wave = tid >> 6, G = sg_l(gridDim.x), r = lane & 31, hh = lane >> 5;
    unsigned char* ws = a->ws;
    const bf16_t* QKVZ = (const bf16_t*)(ws + WS_BIG); const float* lpart = (const float*)(ws + WS_LPART);
    const float ref = attn_ref(a, j), c1 = 0.08838834764831845f * 1.4426950408889634f, c2 = ref * 1.4426950408889634f;
    float* lq = (float*)(smem + LDS_LQ) + wave * 32;
    const int qt = wave < 4 ? wave : 11 - wave;
    for (int unit = sg_l(blockIdx.x); unit < 512; unit += G) {
        const int h = unit & 7, b = unit >> 3;
        __syncthreads(); load_kv(QKVZ, h, b, smem); __syncthreads();
        const int qidx = qt * 32 + r, t = b * 256 + qidx;
        bf16x8 qf[8];
#pragma unroll
        for (int kk = 0; kk < 8; ++kk) qf[kk] = *(const bf16x8*)(QKVZ + (size_t)t * QK_STRIDE + h * 128 + kk * 16 + hh * 8);
        f32x16 O[4];
#pragma unroll
        for (int dt = 0; dt < 4; ++dt)
#pragma unroll
            for (int i = 0; i < 16; ++i) O[dt][i] = 0.f;
        float lsum = 0.f;
        attn_core(smem, qf, qt + 1, qt, qidx, c1, c2, O, lsum);
        lsum += __shfl_xor(lsum, 32);
        const int nsel = b < 3 ? b : 3;
        for (int s = 0; s < nsel; ++s) lsum += lpart[((size_t)s * L + t) * 8 + h];
        if (hh == 0) lq[r] = 1.0f / lsum;
        __builtin_amdgcn_wave_barrier(); asm volatile("s_waitcnt lgkmcnt(0)" ::: "memory");
#pragma unroll
        for (int ih = 0; ih < 2; ++ih) {
            u32x2 pv[8][3], zv[8];
#pragma unroll
            for (int i8 = 0; i8 < 8; ++i8) {
                const int i = ih * 8 + i8, qi = (i & 3) + 8 * (i >> 2) + 4 * hh; const size_t ti = (size_t)(b * 256 + qt * 32 + qi);
#pragma unroll
                for (int s = 0; s < 3; ++s) pv[i8][s] = s < nsel ? *(const u32x2*)((const bf16_t*)(ws + (s == 0 ? WS_XN : (s == 1 ? WS_P1 : WS_P2))) + ti * DM + h * 128 + r * 4) : (u32x2){0u, 0u};
                zv[i8] = *(const u32x2*)(QKVZ + ti * QK_STRIDE + 3072 + h * 128 + r * 4);
            }
            asm volatile("" ::: "memory");
#pragma unroll
            for (int i8 = 0; i8 < 8; ++i8) {
                const int i = ih * 8 + i8, qi = (i & 3) + 8 * (i >> 2) + 4 * hh; const size_t ti = (size_t)(b * 256 + qt * 32 + qi);
                const float inv = lq[qi];
                float o0 = O[0][i], o1 = O[1][i], o2 = O[2][i], o3 = O[3][i];
#pragma unroll
                for (int s = 0; s < 3; ++s) { o0 += bflo(pv[i8][s].x); o1 += bfhi(pv[i8][s].x); o2 += bflo(pv[i8][s].y); o3 += bfhi(pv[i8][s].y); }
                const float z0 = bflo(zv[i8].x), z1 = bfhi(zv[i8].x), z2 = bflo(zv[i8].y), z3 = bfhi(zv[i8].y);
                u32x2 w; w.x = pk2(o0 * inv * z0 * sigmoidf_(z0), o1 * inv * z1 * sigmoidf_(z1)); w.y = pk2(o2 * inv * z2 * sigmoidf_(z2), o3 * inv * z3 * sigmoidf_(z3));
                if (!dry) *(u32x2*)((bf16_t*)(ws + WS_XN) + ti * DM + h * 128 + r * 4) = w;
            }
        }
        __builtin_amdgcn_wave_barrier();
    }
}

#define XB_TMO      128
#define XB_XCNT(j)  (256  + 64 * (j))
#define XB_XSUB(j)  (1280 + 64 * (j))
#define XB_XGEN(j)  (2304 + 64 * (j))
#define XB_TOP      3328
#define XB_TOPGEN   3392
#define XCD_BAR_WORDS 3456
#define XB_SPIN_CAP (1u << 22)
__device__ __forceinline__ unsigned xb_ld(unsigned* p)              { return __hip_atomic_load(p, __ATOMIC_RELAXED, __HIP_MEMORY_SCOPE_AGENT); }
__device__ __forceinline__ unsigned xb_add(unsigned* p, unsigned v) { return __hip_atomic_fetch_add(p, v, __ATOMIC_RELAXED, __HIP_MEMORY_SCOPE_AGENT); }
__device__ __forceinline__ unsigned xb_xcc_id() { return (unsigned)__builtin_amdgcn_s_getreg((3 << 11) | 20) & 0xFu; }
#define XB_SPIN(cond, bar) do { unsigned _sp = 0; while (cond) { __builtin_amdgcn_s_sleep(1); \
    if ((++_sp & 255u) == 0u) { if (xb_ld(&(bar)[XB_TMO])) break; if (_sp > XB_SPIN_CAP) { atomicAdd(&(bar)[XB_TMO], 1u); break; } } } } while (0)
struct XcdBarrier { unsigned* bar; unsigned x; volatile LAS unsigned* st; };
__device__ __forceinline__ XcdBarrier xcd_barrier_post(unsigned* bar, volatile LAS unsigned* st) {
    XcdBarrier b; b.bar = bar; b.x = xb_xcc_id(); b.st = st;
    if (threadIdx.x == 0) (void)xb_add(&bar[XB_XCNT(b.x)], 1u);
    return b;
}
__device__ __forceinline__ void xcd_barrier_complete(unsigned* bar, unsigned x, unsigned& nloc, unsigned& nx) {
    const unsigned G = gridDim.x * gridDim.y * gridDim.z;
    unsigned sum, cnt, mine, sp = 0u;
    for (;;) {
        sum = 0u; cnt = 0u; mine = 0u;
#pragma unroll
        for (unsigned j = 0; j < 16; ++j) { const unsigned c = xb_ld(&bar[XB_XCNT(j)]); sum += c; cnt += (c > 0u) ? 1u : 0u; mine = (j == x) ? c : mine; }
        if (sum == G) break;
        __builtin_amdgcn_s_sleep(1);
        if ((++sp & 255u) == 0u) { if (xb_ld(&bar[XB_TMO])) break; if (sp > XB_SPIN_CAP) { atomicAdd(&bar[XB_TMO], 1u); break; } }
    }
    nloc = mine > 0u ? mine : 1u; nx = cnt > 0u ? cnt : 1u;
}
__device__ __forceinline__ void xcd_barrier(const XcdBarrier& b) {
    asm volatile("s_waitcnt vmcnt(0)" ::: "memory");
    __syncthreads();
    if (threadIdx.x == 0) {
        unsigned* bar = b.bar;
        __builtin_amdgcn_s_waitcnt(0);
        unsigned nloc = b.st[0], nx = b.st[1];
        if (nloc == 0u) { xcd_barrier_complete(bar, b.x, nloc, nx); b.st[0] = nloc; b.st[1] = nx; }
        const unsigned old = xb_add(&bar[XB_XSUB(b.x)], 1u);
        const unsigned gen = old / nloc;
        if (old + 1u == (gen + 1u) * nloc) {
            __builtin_amdgcn_fence(__ATOMIC_RELEASE, "agent");
            asm volatile("s_waitcnt vmcnt(0)" ::: "memory");
            const unsigned og = xb_add(&bar[XB_TOP], 1u);
            const unsigned tg = og / nx;
            if (og + 1u == (tg + 1u) * nx) xb_add(&bar[XB_TOPGEN], 1u);
            else XB_SPIN(xb_ld(&bar[XB_TOPGEN]) == tg, bar);
            __builtin_amdgcn_fence(__ATOMIC_ACQUIRE, "agent");
            xb_add(&bar[XB_XGEN(b.x)], 1u);
            asm volatile("s_waitcnt vmcnt(0)" ::: "memory");
        } else {
            XB_SPIN(xb_ld(&bar[XB_XGEN(b.x)]) == gen, bar);
            __builtin_amdgcn_fence(__ATOMIC_ACQUIRE, "agent");
            asm volatile("s_waitcnt vmcnt(0)" ::: "memory");
        }
    }
    __syncthreads();
}
#ifndef PH_MASK
#define PH_MASK 0xFFFF
#endif
#define PH(b) ((PH_MASK >> (b)) & 1)
#ifndef REP_MASK
#define REP_MASK 0
#endif
#ifndef XSYNC
#define XSYNC 0
#endif
#define REP(b) for (int _r = 0; _r < 1 + ((REP_MASK >> (b)) & 1); ++_r)
__global__ void __launch_bounds__(512, 2) hybrid_fwd(Args a_unused) {
    extern __shared__ __attribute__((aligned(16))) unsigned char smem[];
    cg::grid_group grid = cg::this_grid();
    LAS unsigned char* lds = (LAS unsigned char*)smem;
    const ArgsP ap = (ArgsP)__builtin_amdgcn_kernarg_segment_ptr();
    if (threadIdx.x < 2) ((volatile LAS unsigned*)(lds + LDS_BARST))[threadIdx.x] = 0u;
    __syncthreads();
    if (blockIdx.x == 0) for (int e = threadIdx.x; e < XCD_BAR_WORDS; e += 512) ((unsigned*)(ap->ws + WS_BAR))[e] = 0u;

#define a launder(ap)
#define ws (launder(ap)->ws)
#define Wb ((bf16_t*)(ws + WS_W))
#define XN ((bf16_t*)(ws + WS_XN))
    REP(0) if (PH(0)) pre0_phase(a);
    grid.sync();
    const XcdBarrier xbar = xcd_barrier_post((unsigned*)(ws + WS_BAR), (volatile LAS unsigned*)(lds + LDS_BARST));
    for (int _x = 0; _x < XSYNC; ++_x) xcd_barrier(xbar);
    REP(0) if (PH(0)) prep_phase(a, 0, a->in[0], smem);
    xcd_barrier(xbar);
#pragma unroll 1
    for (int layer = 0; layer < 4; ++layer) {
        const int j = layer >> 1;
        if ((layer & 1) == 0) {
            REP(1) if (PH(1)) { pg8::Gemm g{layer == 0 ? XN : (bf16_t*)(ws + WS_Y2), Wb, L, 2048, 1024}; pg8::StaticOrder S; S.init(L, 2048, sg_l(gridDim.x), sg_l(blockIdx.x));
              pg8::EpiStore E{(bf16_t*)(ws + WS_U), 1024, 1024, (size_t)(WS_Z - WS_U) / 2, (const float*)(ws + WS_ROWSQ), 1};
              pg8::gemm_phase<pg8::EpiStore, pg8::StaticOrder, true, true>(lds, g, S, E); }
            xcd_barrier(xbar);
            REP(2) if (PH(2)) ssm_s1(a, smem);
            xcd_barrier(xbar);
            REP(3) if (PH(3)) ssm_s2(a, j, smem);
            xcd_barrier(xbar);
            REP(4) if (PH(4)) ssm_s3(a, j, smem);
            xcd_barrier(xbar);
            REP(5) if (PH(5)) { pg8::Gemm g{(const bf16_t*)(ws + WS_YG), Wb + 2048 * 1024, L, 1024, 1024}; pg8::StaticOrder S; S.init(L, 1024, sg_l(gridDim.x), sg_l(blockIdx.x));
              pg8::EpiGlu E{(const bf16_t*)(ws + WS_YG), (const bf16_t*)(ws + WS_Z), a->in[12] + j * 1024, (bf16_t*)(ws + WS_Y2)};
              pg8::gemm_phase<pg8::EpiGlu, pg8::StaticOrder, true, true, true>(lds, g, S, E); }
            xcd_barrier(xbar);
            REP(6) if (PH(6)) { pg8::Gemm g{(const bf16_t*)(ws + WS_Y2), Wb + 3072 * 1024, L, 1024, 1024}; pg8::StaticOrder S; S.init(L, 1024, sg_l(gridDim.x), sg_l(blockIdx.x));
              pg8::EpiRes E{layer == 0 ? a->in[0] : (const float*)a->out, a->out, layer < 3 ? XN : (bf16_t*)nullptr, (float*)(ws + WS_ROWSQ)};
              pg8::gemm_phase<pg8::EpiRes, pg8::StaticOrder, true, true>(lds, g, S, E); }
            xcd_barrier(xbar);
        } else {
            REP(7) if (PH(7)) { pg8::Gemm g{XN, Wb, L, 4096, 1024}; pg8::StaticOrder S; S.init(L, 4096, sg_l(gridDim.x), sg_l(blockIdx.x));
              pg8::EpiStore E{(bf16_t*)(ws + WS_BIG), 4096, 0, 0, (const float*)(ws + WS_ROWSQ), 0};
              pg8::gemm_phase<pg8::EpiStore, pg8::StaticOrder, true, true>(lds, g, S, E); }
            xcd_barrier(xbar);
            REP(8) if (PH(8)) attn_a1(a, j, smem, sg_l(_r == 0 && ((REP_MASK >> 8) & 1)));
            xcd_barrier(xbar);
            REP(9) if (PH(9)) attn_a2(a, smem, sg_l(_r == 0 && ((REP_MASK >> 9) & 1)));
            xcd_barrier(xbar);
            REP(10) if (PH(10)) attn_a3(a, j, smem);
            xcd_barrier(xbar);
            REP(11) if (PH(11)) attn_a4(a, j, smem, sg_l(_r == 0 && ((REP_MASK >> 11) & 1)));
            xcd_barrier(xbar);
            REP(12) if (PH(12)) { pg8::Gemm g{XN, Wb + 4096 * 1024, L, 1024, 1024}; pg8::StaticOrder S; S.init(L, 1024, sg_l(gridDim.x), sg_l(blockIdx.x));
              pg8::EpiRes E{(const float*)a->out, a->out, layer < 3 ? (bf16_t*)(ws + WS_Y2) : (bf16_t*)nullptr, (float*)(ws + WS_ROWSQ)};
              pg8::gemm_phase<pg8::EpiRes, pg8::StaticOrder, true, true>(lds, g, S, E); }
            xcd_barrier(xbar);
        }
        if (layer < 3) { REP(13) if (PH(13)) prep_phase(a, layer + 1, a->out, smem); xcd_barrier(xbar); }
    }
}

#undef a
#undef ws
#undef Wb
#undef XN
extern "C" void kernel_launch(void* const* d_in, const int* in_sizes, int n_in, void* d_out, int out_size, void* d_ws, size_t ws_size, hipStream_t stream) {
    static int grid = 0;
    if (grid == 0) {
        if (n_in != 18 || out_size != L * DM || ws_size < WS_END) { fprintf(stderr, "kernel_launch: unexpected shapes (n_in %d, out %d, ws %zu)\n", n_in, out_size, ws_size); grid = -1; return; }
        int dev = 0, cus = 0, per_cu = 0;
        (void)hipGetDevice(&dev); (void)hipDeviceGetAttribute(&cus, hipDeviceAttributeMultiprocessorCount, dev);
        (void)hipFuncSetAttribute((const void*)hybrid_fwd, hipFuncAttributeMaxDynamicSharedMemorySize, LDS_BYTES);
        (void)hipOccupancyMaxActiveBlocksPerMultiprocessor(&per_cu, (const void*)hybrid_fwd, 512, LDS_BYTES);
        if (per_cu < 1) { fprintf(stderr, "kernel_launch: occupancy query says %d blocks per CU\n", per_cu); per_cu = 1; }
        grid = cus * 1;
        if (grid > 256) grid = 256;
    }
    if (grid < 0) return;
    Args a{};
    for (int i = 0; i < 18; ++i) a.in[i] = (const float*)d_in[i];
    a.out = (float*)d_out; a.ws = (unsigned char*)d_ws;
    void* args[] = {&a};
    hipError_t e = hipLaunchCooperativeKernel((const void*)hybrid_fwd, dim3(grid), dim3(512), args, LDS_BYTES, stream);
    if (e != hipSuccess) fprintf(stderr, "cooperative launch failed: %s (grid %d)\n", hipGetErrorString(e), grid);
}
```

```cpp
#include <hip/hip_runtime.h>
#include <hip/hip_cooperative_groups.h>
#include <cstdio>
#include <cstdint>
namespace cg = cooperative_groups;

#define LAS __attribute__((address_space(3)))
typedef unsigned short bf16_t;
typedef short bf16x8 __attribute__((ext_vector_type(8)));
typedef short s16x4 __attribute__((ext_vector_type(4)));
typedef float f32x2 __attribute__((ext_vector_type(2)));
typedef float f32x4 __attribute__((ext_vector_type(4)));
typedef float f32x16 __attribute__((ext_vector_type(16)));
typedef unsigned u32x2 __attribute__((ext_vector_type(2)));
typedef unsigned u32x4 __attribute__((ext_vector_type(4)));
typedef __bf16 bf16v2 __attribute__((ext_vector_type(2)));

__device__ __forceinline__ unsigned pk2(float lo, float hi) { f32x2 v = {lo, hi}; bf16v2 b = __builtin_convertvector(v, bf16v2); return __builtin_bit_cast(unsigned, b); }
__device__ __forceinline__ float bflo(unsigned w) { return __uint_as_float(w << 16); }
__device__ __forceinline__ float bfhi(unsigned w) { return __uint_as_float(w & 0xffff0000u); }
__device__ __forceinline__ float sigmoidf_(float x) { return 1.0f / (1.0f + __expf(-x)); }
__device__ __forceinline__ float gelu_tanh(float y) { const float t = 0.7978845608028654f * (y + 0.044715f * y * y * y); const float e = __expf(2.0f * t); const float th = 1.0f - 2.0f / (e + 1.0f); return 0.5f * y * (1.0f + th); }

__device__ __forceinline__ int tid_l() { int t = threadIdx.x; asm volatile("" : "+v"(t)); return t; }
__device__ __forceinline__ int sg_l(int v) { v = __builtin_amdgcn_readfirstlane(v); asm volatile("" : "+s"(v)); return v; }
constexpr int L = 16384, DM = 1024, NH = 8, HD = 128, NBLK = 64;
constexpr size_t MiB = 1u << 20;
constexpr size_t WS_CTL = 0, WS_BAR = 16 * 1024, WS_KMEAN = 256 * 1024;
constexpr int LDS_BARST = 146432;
constexpr size_t WS_W = 1 * MiB, WS_TAB = 11 * MiB, WS_XN = 21 * MiB, WS_BIG = 53 * MiB;
constexpr size_t WS_U = WS_BIG, WS_Z = WS_BIG + 32 * MiB, WS_YG = WS_BIG + 64 * MiB, WS_Y2 = WS_BIG + 96 * MiB;
constexpr size_t WS_P1 = 181 * MiB, WS_P2 = 213 * MiB, WS_SLOC = 181 * MiB, WS_SIN = 213 * MiB;
constexpr size_t WS_LPART = 245 * MiB, WS_ROPE = 247 * MiB, WS_EP = 249 * MiB, WS_W2 = 251 * MiB, WS_ROWSQ = 253 * MiB, WS_END = 254 * MiB;
constexpr int EP_STRIDE = 19 * 64 * 2;
constexpr int TAB_STRIDE = 147456;
constexpr int LIST_PER_HEAD = 516096;
__host__ __device__ __forceinline__ int list_off(int n) { return 16128 * n - 128 * n * (n - 1); }
constexpr int LDS_BYTES = 147456;
constexpr float NORM_EPS = 1e-6f;

namespace pg8 {
constexpr int M_ROWS = 16384;
constexpr int BM = 256, BK = 64, HALF = 128, HTB = HALF * BK * 2, STAGE_BYTES = 8 * HTB, NXCD = 8, WGM = 8;
__host__ __device__ __forceinline__ int lds_byte(int r, int c) { const int st = (r >> 4) * 2 + (c >> 5), rr = r & 15, cc = c & 31, ob = rr * 64 + cc * 2; return st * 1024 + (ob ^ (((ob >> 9) & 1) << 5)); }
__host__ __device__ __forceinline__ void stage_rc(int b, int& R, int& C) { const int st = b / 1024, sb = b % 1024, swz = sb ^ (((sb >> 9) & 1) << 5); R = (st >> 1) * 16 + swz / 64; C = (st & 1) * 32 + (swz % 64) / 2; }
__host__ __device__ __forceinline__ int perm32(int rho) { const int n = rho >> 4, i = rho & 15; return 8 * (i >> 2) + 4 * n + (i & 3); }
struct Unit { int pm, pn; };
struct Gemm { const bf16_t* A; const bf16_t* Bt; int M, N, K; };
struct StaticOrder {
    int nM, nN, nwg, G, c;
    __host__ __device__ void init(int M, int N, int G_, int c_) { nM = M / BM; nN = N / BM; nwg = nM * nN; G = G_; c = c_; }
    __host__ __device__ bool next(int i, Unit& u) const {
        const long Lx = (long)i * G + c; if (Lx >= nwg) return false;
        int wgid = (int)Lx; { const int q = nwg / NXCD, r = nwg % NXCD, xcd = wgid % NXCD, off = wgid / NXCD; wgid = (xcd < r ? xcd * (q + 1) : r * (q + 1) + (xcd - r) * q) + off; }
        const int nig = WGM * nN, gid = wgid / nig, fm = gid * WGM, gsz = (nM - fm) < WGM ? (nM - fm) : WGM;
        u.pm = fm + ((wgid % nig) % gsz); u.pn = (wgid % nig) / gsz; return true;
    }
    __device__ __forceinline__ void a_ready(const Unit&) const {}
    __device__ __forceinline__ void done(const Unit&) const {}
};

struct EpiStore {
    static constexpr bool PERM = true, AFTER_DRAIN = false;
    bf16_t* O; int ldc; int split_cols; size_t split_stride; const float* rowsq; int ugm;
    __device__ __forceinline__ void operator()(const f32x4 (&acc)[2][2][4][2], const Unit& u, int wr, int wc, int fr, int fq) const {
        const int row0 = u.pm * BM + wr * 64 + fr; int colt = u.pn * BM; bf16_t* base = O;
        if (split_cols) { const int t = colt / split_cols; base += (size_t)t * split_stride; colt -= t * split_cols; }
        const int col0 = colt + wc * 32 + 8 * fq; const bool gm = ugm && base == O;
        float rsv[2][4];
#pragma unroll
        for (int ai = 0; ai < 2; ++ai)
#pragma unroll
            for (int m = 0; m < 4; ++m) { const f32x4* rp = (const f32x4*)(rowsq + (size_t)(row0 + ai * HALF + m * 16) * 16); const f32x4 q0 = rp[0], q1 = rp[1], q2 = rp[2], q3 = rp[3];
                const float tot = (((q0[0] + q0[1]) + (q0[2] + q0[3])) + ((q1[0] + q1[1]) + (q1[2] + q1[3]))) + (((q2[0] + q2[1]) + (q2[2] + q2[3])) + ((q3[0] + q3[1]) + (q3[2] + q3[3])));
                rsv[ai][m] = rsqrtf(tot * (1.f / 1024.f) + NORM_EPS); }
        asm volatile("" ::: "memory");
#pragma unroll
        for (int ai = 0; ai < 2; ++ai)
#pragma unroll
            for (int m = 0; m < 4; ++m) { bf16_t* rowp = gm ? base + ((size_t)(col0 >> 4) * M_ROWS + (row0 + ai * HALF + m * 16)) * 16 + (col0 & 15) : base + (size_t)(row0 + ai * HALF + m * 16) * ldc + col0;
                const float rs = rsv[ai][m];
#pragma unroll
                for (int bj = 0; bj < 2; ++bj) { const f32x4 v0 = acc[ai][bj][m][0] * rs, v1 = acc[ai][bj][m][1] * rs;
                    u32x4 w; w.x = pk2(v0[0], v0[1]); w.y = pk2(v0[2], v0[3]); w.z = pk2(v1[0], v1[1]); w.w = pk2(v1[2], v1[3]);
                    *(u32x4*)(rowp + (gm ? (size_t)bj * 8 * M_ROWS * 16 : (size_t)bj * HALF)) = w; } }
    }
};
struct EpiGlu {
    static constexpr bool PERM = true, AFTER_DRAIN = false;
    const bf16_t* YG; const bf16_t* Z; const float* bias; bf16_t* O;
    __device__ __forceinline__ void operator()(const f32x4 (&acc)[2][2][4][2], const Unit& u, int wr, int wc, int fr, int fq) const {
        const int row0 = u.pm * BM + wr * 64 + fr; const int col0 = u.pn * BM + wc * 32 + 8 * fq;
        f32x4 b0[2], b1[2];
#pragma unroll
        for (int bj = 0; bj < 2; ++bj) { b0[bj] = *(const f32x4*)(bias + col0 + bj * HALF); b1[bj] = *(const f32x4*)(bias + col0 + bj * HALF + 4); }
#pragma unroll
        for (int aq = 0; aq < 4; ++aq) {
            const int ai = aq >> 1, mh = (aq & 1) * 2;
            u32x4 yv[2][2], zv[2][2];
#pragma unroll
            for (int m2 = 0; m2 < 2; ++m2)
#pragma unroll
                for (int bj = 0; bj < 2; ++bj) {
                    const int row = row0 + ai * HALF + (mh + m2) * 16, colg = col0 + bj * HALF;
                    yv[m2][bj] = *(const u32x4*)(YG + ((size_t)(colg >> 4) * M_ROWS + row) * 16 + (colg & 15));
                    zv[m2][bj] = *(const u32x4*)(Z + (size_t)row * DM + colg);
                }
            asm volatile("" ::: "memory");
#pragma unroll
            for (int m2 = 0; m2 < 2; ++m2)
#pragma unroll
                for (int bj = 0; bj < 2; ++bj) {
                    const int m = mh + m2;
                    const size_t off = (size_t)(row0 + ai * HALF + m * 16) * DM + col0 + bj * HALF;
                    const f32x4 v0 = acc[ai][bj][m][0] + b0[bj], v1 = acc[ai][bj][m][1] + b1[bj];
                    float r[8];
#pragma unroll
                    for (int q = 0; q < 4; ++q) {
                        const float a0 = q < 2 ? v0[2 * q] : v1[2 * q - 4], a1 = q < 2 ? v0[2 * q + 1] : v1[2 * q - 3];
                        const float y0 = bflo(yv[m2][bj][q]), y1 = bfhi(yv[m2][bj][q]), z0 = bflo(zv[m2][bj][q]), z1 = bfhi(zv[m2][bj][q]);
                        r[2 * q] = y0 * sigmoidf_(a0) * (z0 * sigmoidf_(z0)); r[2 * q + 1] = y1 * sigmoidf_(a1) * (z1 * sigmoidf_(z1));
                    }
                    u32x4 w; w.x = pk2(r[0], r[1]); w.y = pk2(r[2], r[3]); w.z = pk2(r[4], r[5]); w.w = pk2(r[6], r[7]);
                    *(u32x4*)(O + off) = w;
                }
        }
    }
};
struct EpiRes {
    static constexpr bool PERM = true, AFTER_DRAIN = false;
    const float* base; float* out; bf16_t* xn; float* rowsq;
    __device__ __forceinline__ void operator()(const f32x4 (&acc)[2][2][4][2], const Unit& u, int wr, int wc, int fr, int fq) const {
        const int row0 = u.pm * BM + wr * 64 + fr; const int col0 = u.pn * BM + wc * 32 + 8 * fq;
#pragma unroll
        for (int ai = 0; ai < 2; ++ai) {
            f32x4 pre[4][2][2];
#pragma unroll
            for (int m = 0; m < 4; ++m)
#pragma unroll
                for (int bj = 0; bj < 2; ++bj) { const size_t off = (size_t)(row0 + ai * HALF + m * 16) * DM + col0 + bj * HALF;
                    pre[m][bj][0] = *(const f32x4*)(base + off); pre[m][bj][1] = *(const f32x4*)(base + off + 4); }
            asm volatile("" ::: "memory");
#pragma unroll
            for (int m = 0; m < 4; ++m) {
                float ss = 0.f;
#pragma unroll
                for (int bj = 0; bj < 2; ++bj) {
                    const size_t off = (size_t)(row0 + ai * HALF + m * 16) * DM + col0 + bj * HALF;
                    const f32x4 v0 = pre[m][bj][0] + acc[ai][bj][m][0], v1 = pre[m][bj][1] + acc[ai][bj][m][1];
                    *(f32x4*)(out + off) = v0; *(f32x4*)(out + off + 4) = v1;
                    if (xn) {
                        u32x4 w; w.x = pk2(v0[0], v0[1]); w.y = pk2(v0[2], v0[3]); w.z = pk2(v1[0], v1[1]); w.w = pk2(v1[2], v1[3]);
                        *(u32x4*)(xn + off) = w;
                        ss += (v0[0] * v0[0] + v0[1] * v0[1]) + (v0[2] * v0[2] + v0[3] * v0[3]) + (v1[0] * v1[0] + v1[1] * v1[1]) + (v1[2] * v1[2] + v1[3] * v1[3]);
                    }
                }
                if (xn) { ss += __shfl_xor(ss, 16); ss += __shfl_xor(ss, 32); if (fq == 0) rowsq[(size_t)(row0 + ai * HALF + m * 16) * 16 + u.pn * 4 + wc] = ss; }
            }
        }
    }
};

template <class Epi, class Sched, bool ALIGN_EPI = false, bool SP2 = false, bool AGM = false>
__device__ __forceinline__ void gemm_phase(LAS unsigned char* lds, const Gemm g, const Sched& S, const Epi& E) {
    const int tid = tid_l(), wid = __builtin_amdgcn_readfirstlane(tid >> 6), lane = tid & 63, wr = wid >> 2, wc = wid & 3, fr = lane & 15, fq = lane >> 4;
    const int K = g.K, nt = K / BK;
    unsigned voffA[2], voffB[2];
#pragma unroll
    for (int i = 0; i < 2; ++i) { int R, C; stage_rc(tid * 16 + i * 8192, R, C); const int Rb = Epi::PERM ? ((R & ~31) + perm32(R & 31)) : R;
        voffA[i] = AGM ? (unsigned)(((C >> 4) * M_ROWS + R) * 16 + (C & 15)) * 2u : (unsigned)(R * K + C) * 2u; voffB[i] = (unsigned)(Rb * K + C) * 2u; }
    const size_t kstep = (size_t)(BK * 2);
    const size_t hstep = (size_t)HALF * K * 2;
    const size_t tstep = 2 * hstep;
    const size_t kstepA = AGM ? (size_t)4 * M_ROWS * 32 : kstep, hstepA = AGM ? (size_t)HALF * 32 : hstep, tstepA = 2 * hstepA;
    const unsigned ldsw = (unsigned)wid * 1024u;
    const int aoff = lds_byte(wr * 64 + fr, fq * 8), boff = lds_byte(wc * 32 + fr, fq * 8);
#define PG8_SA(b, h) (((b) * 2 + (h)) * HTB)
#define PG8_SB(b, h) ((4 + (b) * 2 + (h)) * HTB)
#define PG8_STAGE(bufoff, gbase, voff) do { _Pragma("unroll") for (int _i = 0; _i < 2; ++_i) \
        __builtin_amdgcn_global_load_lds((const unsigned*)((const char*)(gbase) + (voff)[_i]), (LAS unsigned*)(lds + (bufoff) + ldsw + _i * 8192), 16, 0, 0); } while (0)
#define PG8_LDA(dst, b, h) do { _Pragma("unroll") for (int m = 0; m < 4; ++m) _Pragma("unroll") for (int k = 0; k < 2; ++k) dst[m][k] = *(const LAS bf16x8*)(lds + PG8_SA(b, h) + aoff + m * 2048 + k * 1024); } while (0)
#define PG8_LDB(dst, b, h) do { _Pragma("unroll") for (int n = 0; n < 2; ++n) _Pragma("unroll") for (int k = 0; k < 2; ++k) dst[n][k] = *(const LAS bf16x8*)(lds + PG8_SB(b, h) + boff + n * 2048 + k * 1024); } while (0)
#define PG8_MMA(ai, bj, At, Bt) do { __builtin_amdgcn_s_setprio(1); _Pragma("unroll") for (int m = 0; m < 4; ++m) _Pragma("unroll") for (int n = 0; n < 2; ++n) _Pragma("unroll") for (int k = 0; k < 2; ++k) \
        acc[ai][bj][m][n] = __builtin_amdgcn_mfma_f32_16x16x32_bf16(Bt[n][k], At[m][k], acc[ai][bj][m][n], 0, 0, 0); __builtin_amdgcn_s_setprio(0); } while (0)
#define PG8_WAIT_V(n) asm volatile("s_waitcnt vmcnt(" #n ")" ::: "memory")
#define PG8_WAIT_L(n) asm volatile("s_waitcnt lgkmcnt(" #n ")" ::: "memory")
#define PG8_BAR __builtin_amdgcn_s_barrier()
#define PG8_SCHED __builtin_amdgcn_sched_barrier(0)
    Unit cur, nxt; int ui = 0;
    if (!S.next(0, cur)) return;
    f32x4 acc[2][2][4][2];
#pragma unroll
    for (int a = 0; a < 2; ++a)
#pragma unroll
        for (int b = 0; b < 2; ++b)
#pragma unroll
            for (int m = 0; m < 4; ++m)
#pragma unroll
                for (int n = 0; n < 2; ++n) acc[a][b][m][n] = (f32x4){0.f, 0.f, 0.f, 0.f};
    bf16x8 At[4][2], B0[2][2], B1[2][2];
    const char* cA = (const char*)g.A + (size_t)cur.pm * tstepA; const char* cB = (const char*)g.Bt + (size_t)cur.pn * tstep;
    S.a_ready(cur);
    if constexpr (SP2) {
        PG8_STAGE(PG8_SB(0, 0), cB, voffB); PG8_STAGE(PG8_SB(0, 1), cB + hstep, voffB); PG8_STAGE(PG8_SA(0, 0), cA, voffA); PG8_STAGE(PG8_SA(0, 1), cA + hstepA, voffA);
        if (wr == 1) PG8_BAR;
        PG8_WAIT_V(2); PG8_BAR;
        PG8_STAGE(PG8_SB(1, 0), cB + kstep, voffB); PG8_STAGE(PG8_SA(1, 0), cA + kstepA, voffA); PG8_STAGE(PG8_SB(1, 1), cB + hstep + kstep, voffB);
        PG8_WAIT_V(6); PG8_BAR;
    } else {
        PG8_STAGE(PG8_SB(0, 0), cB, voffB); PG8_STAGE(PG8_SA(0, 0), cA, voffA); PG8_STAGE(PG8_SB(0, 1), cB + hstep, voffB); PG8_STAGE(PG8_SA(0, 1), cA + hstepA, voffA);
        if (wr == 1) PG8_BAR;
        PG8_WAIT_V(4); PG8_BAR;
        PG8_STAGE(PG8_SB(1, 0), cB + kstep, voffB); PG8_STAGE(PG8_SA(1, 0), cA + kstepA, voffA); PG8_STAGE(PG8_SB(1, 1), cB + hstep + kstep, voffB);
        PG8_WAIT_V(6); PG8_BAR;
    }
    for (;;) {
        const bool has_next = S.next(ui + 1, nxt);
        const char* nA = has_next ? (const char*)g.A + (size_t)nxt.pm * tstepA : cA; const char* nB = has_next ? (const char*)g.Bt + (size_t)nxt.pn * tstep : cB;
        for (int t = 0; t < nt; t += 2) {
            const bool last = (t == nt - 2);
            const char* a1 = cA + (size_t)(t + 1) * kstepA;
            const char* a2 = last ? nA : cA + (size_t)(t + 2) * kstepA; const char* b2 = last ? nB : cB + (size_t)(t + 2) * kstep;
            const char* a3 = a2 + kstepA; const char* b3 = b2 + kstep;
            if (last && has_next) S.a_ready(nxt);
            if constexpr (SP2) {
            PG8_LDB(B0, 0, 0); PG8_LDB(B1, 0, 1); PG8_SCHED; PG8_LDA(At, 0, 0); PG8_STAGE(PG8_SA(1, 1), a1 + hstepA, voffA);
            PG8_WAIT_V(8); PG8_WAIT_L(0); PG8_BAR; PG8_MMA(0, 0, At, B0); PG8_MMA(0, 1, At, B1); PG8_BAR; PG8_SCHED;
            PG8_LDA(At, 0, 1); PG8_STAGE(PG8_SB(0, 0), b2, voffB); PG8_STAGE(PG8_SB(0, 1), b2 + hstep, voffB); PG8_STAGE(PG8_SA(0, 0), a2, voffA);
            PG8_WAIT_V(8); PG8_WAIT_L(0); PG8_BAR; PG8_MMA(1, 0, At, B0); PG8_MMA(1, 1, At, B1); PG8_BAR; PG8_SCHED;
            PG8_LDB(B0, 1, 0); PG8_LDB(B1, 1, 1); PG8_SCHED; PG8_LDA(At, 1, 0); PG8_STAGE(PG8_SA(0, 1), a2 + hstepA, voffA);
            PG8_WAIT_V(8); PG8_WAIT_L(0); PG8_BAR; PG8_MMA(0, 0, At, B0); PG8_MMA(0, 1, At, B1); PG8_BAR; PG8_SCHED;
            PG8_LDA(At, 1, 1); PG8_STAGE(PG8_SB(1, 0), b3, voffB); PG8_STAGE(PG8_SB(1, 1), b3 + hstep, voffB); PG8_STAGE(PG8_SA(1, 0), a3, voffA);
            PG8_WAIT_V(8); PG8_WAIT_L(0); PG8_BAR; PG8_MMA(1, 0, At, B0); PG8_MMA(1, 1, At, B1); PG8_BAR; PG8_SCHED;
            } else {
            PG8_LDB(B0, 0, 0); PG8_SCHED; PG8_LDA(At, 0, 0); PG8_STAGE(PG8_SA(1, 1), a1 + hstepA, voffA);
            PG8_WAIT_L(8); PG8_BAR; PG8_WAIT_L(0); PG8_MMA(0, 0, At, B0); PG8_BAR; PG8_SCHED;
            PG8_LDB(B1, 0, 1); PG8_STAGE(PG8_SB(0, 0), b2, voffB);
            PG8_BAR; PG8_WAIT_L(0); PG8_MMA(0, 1, At, B1); PG8_BAR;
            PG8_LDA(At, 0, 1); PG8_STAGE(PG8_SA(0, 0), a2, voffA);
            PG8_BAR; PG8_WAIT_L(0); PG8_MMA(1, 0, At, B0); PG8_BAR; PG8_SCHED;
            PG8_STAGE(PG8_SB(0, 1), b2 + hstep, voffB);
            PG8_WAIT_V(6); PG8_BAR; PG8_MMA(1, 1, At, B1); PG8_BAR;
            PG8_LDB(B0, 1, 0); PG8_SCHED; PG8_LDA(At, 1, 0); PG8_STAGE(PG8_SA(0, 1), a2 + hstepA, voffA);
            PG8_WAIT_L(8); PG8_BAR; PG8_WAIT_L(0); PG8_MMA(0, 0, At, B0); PG8_BAR; PG8_SCHED;
            PG8_LDB(B1, 1, 1); PG8_STAGE(PG8_SB(1, 0), b3, voffB);
            PG8_BAR; PG8_WAIT_L(0); PG8_MMA(0, 1, At, B1); PG8_BAR;
            PG8_LDA(At, 1, 1); PG8_STAGE(PG8_SA(1, 0), a3, voffA);
            PG8_BAR; PG8_WAIT_L(0); PG8_MMA(1, 0, At, B0); PG8_BAR; PG8_SCHED;
            PG8_STAGE(PG8_SB(1, 1), b3 + hstep, voffB);
            PG8_WAIT_V(6); PG8_BAR; PG8_MMA(1, 1, At, B1); PG8_BAR;
            }
        }
        if constexpr (ALIGN_EPI) { if (wr == 0) PG8_BAR; }
        if constexpr (!Epi::AFTER_DRAIN) { E(acc, cur, wr, wc, fr, fq); S.done(cur); }
        if (!has_next) break;
#pragma unroll
        for (int a = 0; a < 2; ++a)
#pragma unroll
            for (int b = 0; b < 2; ++b)
#pragma unroll
                for (int m = 0; m < 4; ++m)
#pragma unroll
                    for (int n = 0; n < 2; ++n) acc[a][b][m][n] = (f32x4){0.f, 0.f, 0.f, 0.f};
        cur = nxt; cA = nA; cB = nB; ++ui;
        if constexpr (ALIGN_EPI) { if (wr == 1) PG8_BAR; }
    }
    PG8_WAIT_V(0);
    if constexpr (!ALIGN_EPI) { if (wr == 0) PG8_BAR; }
    PG8_BAR;
#undef PG8_SA
#undef PG8_SB
#undef PG8_STAGE
#undef PG8_LDA
#undef PG8_LDB
#undef PG8_MMA
#undef PG8_WAIT_V
#undef PG8_WAIT_L
#undef PG8_BAR
#undef PG8_SCHED
}
}

struct Args { const float* in[18]; float* out; unsigned char* ws; };
typedef const __attribute__((address_space(4))) Args* ArgsP;
__device__ __forceinline__ ArgsP launder(ArgsP p) { asm volatile("" : "+s"(p)); return p; }

#define MFMA16(a, b, c) __builtin_amdgcn_mfma_f32_16x16x32_bf16((a), (b), (c), 0, 0, 0)
#define MFMA32(a, b, c) __builtin_amdgcn_mfma_f32_32x32x16_bf16((a), (b), (c), 0, 0, 0)

__device__ __forceinline__ float wave_sum(float v) {
#pragma unroll
    for (int o = 1; o < 64; o <<= 1) v += __shfl_xor(v, o);
    return v;
}

__device__ __forceinline__ int head_perm(int x) { const int pos = x & 127; return (x & ~127) + (pos & 3) * 32 + (pos >> 2); }
template <int MODE, bool GAIN>
__device__ __forceinline__ void transpose_item(const float* W, int K, int N, bf16_t* WT, float* scr, int item, int lane, const float* gain = nullptr) {
    const int nblk = N / 32, kb = item / nblk, nb = item % nblk, k0 = 64 * kb, n0 = 32 * nb;
#pragma unroll 8
    for (int i = 0; i < 32; ++i) { const int kk = 2 * i + (lane >> 5); int sk = k0 + kk, sn = n0 + (lane & 31);
        if (MODE == 1 && sn >= 3072) sn = head_perm(sn);
        if (MODE == 2) sk = head_perm(sk);
        scr[kk * 33 + (lane & 31)] = W[(size_t)sk * N + sn] * (GAIN ? gain[sk] : 1.f); }
    __builtin_amdgcn_wave_barrier(); asm volatile("s_waitcnt lgkmcnt(0)" ::: "memory");
    const int c = lane & 7;
#pragma unroll
    for (int j = 0; j < 4; ++j) { const int n = (lane >> 3) + 8 * j; const float* s = scr + (8 * c) * 33 + n;
        u32x4 o; o.x = pk2(s[0 * 33], s[1 * 33]); o.y = pk2(s[2 * 33], s[3 * 33]); o.z = pk2(s[4 * 33], s[5 * 33]); o.w = pk2(s[6 * 33], s[7 * 33]);
        *(u32x4*)(WT + (size_t)(n0 + n) * K + k0 + 8 * c) = o; }
    asm volatile("s_waitcnt lgkmcnt(0)" ::: "memory"); __builtin_amdgcn_wave_barrier();
}

__device__ __forceinline__ void ssm_tables(ArgsP a, int j, int g, unsigned char* smem, unsigned char* tab) {
    float* Epow = (float*)smem;
    float* Bb = Epow + 17 * 64 * 2;
    float* Cc = Bb + 64 * 16 * 2;
    float* Fp = Cc + 16 * 64 * 2;
    float* Km = Fp + 128;
    const int tid = tid_l();
    const float* a_re = a->in[3] + (size_t)(j * 64 + g) * 64; const float* a_im = a->in[4] + (size_t)(j * 64 + g) * 64;
    const float* b_re = a->in[6] + (size_t)(j * 64 + g) * 64 * 16; const float* b_im = a->in[7] + (size_t)(j * 64 + g) * 64 * 16;
    const float* c_re = a->in[8] + (size_t)(j * 64 + g) * 16 * 64; const float* c_im = a->in[9] + (size_t)(j * 64 + g) * 16 * 64;
    { const float* ep = (const float*)(a->ws + WS_EP) + (size_t)(j * 64 + g) * EP_STRIDE;
      for (int e = tid; e < 17 * 64 * 2; e += 512) Epow[e] = ep[e];
      if (tid < 128) Fp[tid] = ep[18 * 128 + tid]; }
    __syncthreads();
    for (int e = tid; e < 1024; e += 512) {
        { const int p = e >> 4; const float fr_ = Fp[p * 2], fi_ = Fp[p * 2 + 1], br = b_re[e], bi = b_im[e];
          Bb[e * 2] = fr_ * br - fi_ * bi; Bb[e * 2 + 1] = fr_ * bi + fi_ * br; }
        Cc[e * 2] = c_re[e]; Cc[e * 2 + 1] = c_im[e];
    }
    __syncthreads();
    for (int e = tid; e < 4096; e += 512) {
        const int d = e >> 8, c = (e >> 4) & 15, c2 = e & 15; float acc = 0.f;
        for (int p = 0; p < 64; ++p) {
            const float ar = Epow[(d * 64 + p) * 2], ai = Epow[(d * 64 + p) * 2 + 1], br = Bb[(p * 16 + c2) * 2], bi = Bb[(p * 16 + c2) * 2 + 1];
            const float gr = ar * br - ai * bi, gi = ar * bi + ai * br;
            acc += Cc[(c * 64 + p) * 2] * gr - Cc[(c * 64 + p) * 2 + 1] * gi;
        }
        Km[e] = acc;
    }
    __syncthreads();
    for (int e = tid; e < 16 * 64; e += 512) {
        const int d = e >> 6, l = e & 63, c = l & 15, ts = l >> 5, c0 = ((l >> 4) & 1) * 8, dd = d - ts; float v[8];
#pragma unroll
        for (int jj = 0; jj < 8; ++jj) v[jj] = dd >= 0 ? Km[(dd * 16 + c) * 16 + c0 + jj] : 0.f;
        u32x4 w; w.x = pk2(v[0], v[1]); w.y = pk2(v[2], v[3]); w.z = pk2(v[4], v[5]); w.w = pk2(v[6], v[7]);
        *(u32x4*)(tab + d * 1024 + l * 16) = w;
    }
    for (int e = tid; e < 64 * 64; e += 512) {
        const int f = e >> 6, l = e & 63, mt = f >> 3, ks = f & 7, m = mt * 16 + (l & 15), p = m >> 1, ri = m & 1, tau = ks * 2 + (l >> 5), c0 = ((l >> 4) & 1) * 8;
        const float ar = Epow[((15 - tau) * 64 + p) * 2], ai = Epow[((15 - tau) * 64 + p) * 2 + 1]; float v[8];
#pragma unroll
        for (int jj = 0; jj < 8; ++jj) { const float br = Bb[(p * 16 + c0 + jj) * 2], bi = Bb[(p * 16 + c0 + jj) * 2 + 1]; v[jj] = ri == 0 ? (ar * br - ai * bi) : (ar * bi + ai * br); }
        u32x4 w; w.x = pk2(v[0], v[1]); w.y = pk2(v[2], v[3]); w.z = pk2(v[4], v[5]); w.w = pk2(v[6], v[7]);
        *(u32x4*)(tab + 16384 + f * 1024 + l * 16) = w;
    }
    for (int e = tid; e < 64 * 64; e += 512) {
        const int f = e >> 6, l = e & 63, t = f >> 2, kk = f & 3, c = l & 15, m0 = kk * 32 + (l >> 4) * 8; float v[8];
#pragma unroll
        for (int jj = 0; jj < 8; ++jj) { const int m = m0 + jj, p = m >> 1, ri = m & 1;
            const float ar = Epow[((t + 1) * 64 + p) * 2], ai = Epow[((t + 1) * 64 + p) * 2 + 1], cr = Cc[(c * 64 + p) * 2], ci = Cc[(c * 64 + p) * 2 + 1];
            v[jj] = ri == 0 ? (cr * ar - ci * ai) : -(cr * ai + ci * ar); }
        u32x4 w; w.x = pk2(v[0], v[1]); w.y = pk2(v[2], v[3]); w.z = pk2(v[4], v[5]); w.w = pk2(v[6], v[7]);
        *(u32x4*)(tab + 16384 + 65536 + f * 1024 + l * 16) = w;
    }
    __syncthreads();
}

__device__ __forceinline__ void pre0_phase(ArgsP a) {
    const int tid = tid_l(), G = sg_l(gridDim.x), bid = sg_l(blockIdx.x);
    unsigned char* ws = a->ws;
    float* rope = (float*)(ws + WS_ROPE);
    for (int e = bid * 512 + tid; e < L * 16; e += G * 512) {
        const int pos = e >> 4, i = e & 15;
        const double invf = exp(-(double)i * (1.0 / 16.0) * 13.122363377404328);
        double ang = (double)pos * invf; ang -= 6.283185307179586476925 * floor(ang / 6.283185307179586476925);
        rope[e * 2] = (float)cos(ang); rope[e * 2 + 1] = (float)sin(ang);
    }
    float* epb = (float*)(ws + WS_EP);
    for (int e = bid * 512 + tid; e < 2 * 64 * 19 * 64; e += G * 512) {
        const int p = e & 63, n = (e >> 6) % 19, jg = (e >> 6) / 19;
        const double dt = exp((double)a->in[5][jg]);
        const double lr = (double)a->in[3][(size_t)jg * 64 + p], li = (double)a->in[4][(size_t)jg * 64 + p];
        const double pw = n <= 16 ? (double)n : (n == 17 ? 512.0 : 1.0);
        const double mag = exp(lr * dt * pw); double ang = li * dt * pw; ang -= 6.283185307179586476925 * floor(ang / 6.283185307179586476925);
        double cr = cos(ang) * mag, ci = sin(ang) * mag;
        if (n == 18) { const double nr = cr - 1.0, ni = ci, den = lr * lr + li * li; cr = (nr * lr + ni * li) / den; ci = (ni * lr - nr * li) / den; }
        epb[(size_t)jg * EP_STRIDE + (n * 64 + p) * 2] = (float)cr; epb[(size_t)jg * EP_STRIDE + (n * 64 + p) * 2 + 1] = (float)ci;
    }
}
__device__ __forceinline__ void prep_phase(ArgsP a, int layer, const float* h, unsigned char* smem) {
    const int tid = tid_l(), lane = tid & 63, wave = tid >> 6, G = sg_l(gridDim.x), bid = sg_l(blockIdx.x);
    unsigned char* ws = a->ws;
    const int j = layer >> 1;
    if ((layer & 1) == 0) {
        for (int g = bid; g < 64; g += G) ssm_tables(a, j, g, smem, ws + WS_TAB + (size_t)g * TAB_STRIDE);
    }
    __syncthreads();
    float* scr = (float*)(smem + wave * 16384);
    const int gw = bid * 8 + wave, NGW = G * 8;
    bf16_t* Wb = (bf16_t*)(ws + WS_W);
    const float* gain = a->in[1] + layer * 1024;
    if ((layer & 1) == 0) {
        const float* w_in = a->in[2] + (size_t)j * 1024 * 2048; const float* w_glu = a->in[11] + (size_t)j * 1024 * 1024; const float* w_out = a->in[13] + (size_t)j * 1024 * 1024;
        for (int it = gw; it < 2048; it += NGW) {
            if (it < 1024) transpose_item<0, true>(w_in, 1024, 2048, Wb, scr, it, lane, gain);
            else if (it < 1536) transpose_item<0, false>(w_glu, 1024, 1024, Wb + 2048 * 1024, scr, it - 1024, lane);
            else transpose_item<0, false>(w_out, 1024, 1024, Wb + 4096 * 1024, scr, it - 1536, lane);
        }
    } else {
        const float* w_in = a->in[14] + (size_t)j * 1024 * 4096; const float* w_out = a->in[17] + (size_t)j * 1024 * 1024;
        for (int it = gw; it < 2560; it += NGW) {
            if (it < 2048) transpose_item<1, true>(w_in, 1024, 4096, Wb, scr, it, lane, gain);
            else transpose_item<2, false>(w_out, 1024, 1024, (bf16_t*)(ws + WS_W2), scr, it - 2048, lane);
        }
    }
    if (layer == 0) {
        bf16_t* XN = (bf16_t*)(ws + WS_XN); float* rowsq = (float*)(ws + WS_ROWSQ);
        for (int m = gw; m < L; m += NGW) {
            const f32x4* xr = (const f32x4*)(h + (size_t)m * DM) + lane;
            f32x4 v[4]; float s = 0.f;
#pragma unroll
            for (int q = 0; q < 4; ++q) { v[q] = xr[64 * q]; s += (v[q].x * v[q].x + v[q].y * v[q].y) + (v[q].z * v[q].z + v[q].w * v[q].w); }
            s = wave_sum(s);
            if (lane < 16) rowsq[(size_t)m * 16 + lane] = lane == 0 ? s : 0.f;
            u32x2* o8 = (u32x2*)(XN + (size_t)m * DM) + lane;
#pragma unroll
            for (int q = 0; q < 4; ++q) { u32x2 w; w.x = pk2(v[q].x, v[q].y); w.y = pk2(v[q].z, v[q].w); o8[64 * q] = w; }
        }
    }
}

__device__ __forceinline__ void ssm_s1(ArgsP a, unsigned char* smem) {
    const int tid = tid_l(), lane = tid & 63, wave = tid >> 6, G = sg_l(gridDim.x);
    unsigned char* ws = a->ws;
    const bf16_t* U = (const bf16_t*)(ws + WS_U); float* SL = (float*)(ws + WS_SLOC);
    for (int unit = sg_l(blockIdx.x); unit < 256; unit += G) {
        const int g = unit >> 2, qtr = unit & 3;
        __syncthreads();
        { const u32x4* src = (const u32x4*)(ws + WS_TAB + (size_t)g * TAB_STRIDE + 16384); u32x4* dst = (u32x4*)smem; u32x4 tr[8];
#pragma unroll
          for (int i = 0; i < 8; ++i) tr[i] = src[tid + i * 512];
#pragma unroll
          for (int i = 0; i < 8; ++i) dst[tid + i * 512] = tr[i]; }
        __syncthreads();
#pragma unroll 1
        for (int nt = 0; nt < 2; ++nt) {
            const int chunk0 = qtr * 256 + wave * 32 + nt * 16, n = lane & 15;
            bf16x8 B[8];
#pragma unroll
            for (int ks = 0; ks < 8; ++ks) B[ks] = *(const bf16x8*)(U + ((size_t)g * L + (chunk0 + n) * 16 + ks * 2 + (lane >> 5)) * 16 + ((lane >> 4) & 1) * 8);
#pragma unroll
            for (int mt = 0; mt < 8; ++mt) {
                f32x4 acc = {0.f, 0.f, 0.f, 0.f};
#pragma unroll
                for (int ks = 0; ks < 8; ++ks) { const bf16x8 A = *(const bf16x8*)(smem + (mt * 8 + ks) * 1024 + lane * 16); acc = MFMA16(A, B[ks], acc); }
                *(f32x4*)(SL + ((size_t)(chunk0 + n) * 64 + g) * 128 + mt * 16 + (lane >> 4) * 4) = acc;
                asm volatile("" ::: "memory");
            }
        }
    }
}
__device__ __forceinline__ void ssm_s2(ArgsP a, int j, unsigned char* smem) {
    const int tid = tid_l(), G = sg_l(gridDim.x);
    unsigned char* ws = a->ws;
    const float* SL = (const float*)(ws + WS_SLOC); unsigned* SIN = (unsigned*)(ws + WS_SIN);
    float* ex = (float*)smem;
    for (int unit = sg_l(blockIdx.x); unit < 256; unit += G) {
        const int seg = tid >> 4, sl = tid & 15, st = unit * 16 + sl, g = st >> 6, p = st & 63;
        const float* ep = (const float*)(ws + WS_EP) + (size_t)(j * 64 + g) * EP_STRIDE;
        const float e16r = ep[(16 * 64 + p) * 2], e16i = ep[(16 * 64 + p) * 2 + 1], eSr = ep[(17 * 64 + p) * 2], eSi = ep[(17 * 64 + p) * 2 + 1];
        const float* src = SL + ((size_t)(seg * 32) * 64 + g) * 128 + 2 * p;
        f32x2 v[32];
#pragma unroll
        for (int i = 0; i < 32; ++i) v[i] = *(const f32x2*)(src + (size_t)i * 8192);
        float sr = 0.f, si = 0.f;
#pragma unroll
        for (int i = 0; i < 32; ++i) { const float nr = e16r * sr - e16i * si + v[i].x, ni = e16r * si + e16i * sr + v[i].y; sr = nr; si = ni; }
        __syncthreads();
        ex[(seg * 16 + sl) * 2] = sr; ex[(seg * 16 + sl) * 2 + 1] = si;
        __syncthreads();
        float cr = 0.f, ci = 0.f;
        for (int s = 0; s < seg; ++s) { const float xr = ex[(s * 16 + sl) * 2], xi = ex[(s * 16 + sl) * 2 + 1]; const float nr = eSr * cr - eSi * ci + xr, ni = eSr * ci + eSi * cr + xi; cr = nr; ci = ni; }
        unsigned* dst = SIN + ((size_t)(seg * 32) * 64 + g) * 64 + p;
#pragma unroll
        for (int i = 0; i < 32; ++i) {
            dst[(size_t)i * 4096] = pk2(cr, ci);
            const float nr = e16r * cr - e16i * ci + v[i].x, ni = e16r * ci + e16i * cr + v[i].y; cr = nr; ci = ni;
        }
    }
}
__device__ __forceinline__ void ssm_s3(ArgsP a, int j, unsigned char* smem) {
    const int tid = tid_l(), lane = tid & 63, wave = tid >> 6, G = sg_l(gridDim.x);
    unsigned char* ws = a->ws;
    const bf16_t* U = (const bf16_t*)(ws + WS_U); const bf16_t* SIN = (const bf16_t*)(ws + WS_SIN); bf16_t* YG = (bf16_t*)(ws + WS_YG);
    const float* dsk = a->in[10] + j * 1024;
    for (int unit = sg_l(blockIdx.x); unit < 256; unit += G) {
        const int g = unit >> 2, qtr = unit & 3;
        __syncthreads();
        { const u32x4* srcF = (const u32x4*)(ws + WS_TAB + (size_t)g * TAB_STRIDE); u32x4* dst = (u32x4*)smem;
          const u32x4* srcC = (const u32x4*)(ws + WS_TAB + (size_t)g * TAB_STRIDE + 16384 + 65536); u32x4 tr[10];
#pragma unroll
          for (int i = 0; i < 2; ++i) tr[i] = srcF[tid + i * 512];
#pragma unroll
          for (int i = 0; i < 8; ++i) tr[2 + i] = srcC[tid + i * 512];
#pragma unroll
          for (int i = 0; i < 2; ++i) dst[tid + i * 512] = tr[i];
#pragma unroll
          for (int i = 0; i < 8; ++i) dst[1024 + tid + i * 512] = tr[2 + i]; }
        __syncthreads();
        const unsigned char* Fl = smem; const unsigned char* Wl = smem + 16384;
        const int n = lane & 15, cq = (lane >> 4) * 4;
        const f32x4 dv = *(const f32x4*)(dsk + g * 16 + cq);
#pragma unroll 1
        for (int nt = 0; nt < 2; ++nt) {
            const int chunk = qtr * 256 + wave * 32 + nt * 16 + n;
            bf16x8 Bu[8], Bs[4];
#pragma unroll
            for (int ks = 0; ks < 8; ++ks) Bu[ks] = *(const bf16x8*)(U + ((size_t)g * L + chunk * 16 + ks * 2 + (lane >> 5)) * 16 + ((lane >> 4) & 1) * 8);
#pragma unroll
            for (int kk = 0; kk < 4; ++kk) Bs[kk] = *(const bf16x8*)(SIN + ((size_t)chunk * 64 + g) * 128 + kk * 32 + (lane >> 4) * 8);
            u32x2 uvv[16];
#pragma unroll
            for (int t = 0; t < 16; ++t) uvv[t] = *(const u32x2*)(U + ((size_t)g * L + chunk * 16 + t) * 16 + cq);
#pragma unroll
            for (int t = 0; t < 16; ++t) {
                f32x4 acc = {0.f, 0.f, 0.f, 0.f};
#pragma unroll
                for (int i = 0; i <= t / 2; ++i) { const bf16x8 A = *(const bf16x8*)(Fl + (t - 2 * i) * 1024 + lane * 16); acc = MFMA16(A, Bu[i], acc); }
#pragma unroll
                for (int kk = 0; kk < 4; ++kk) { const bf16x8 A = *(const bf16x8*)(Wl + (t * 4 + kk) * 1024 + lane * 16); acc = MFMA16(A, Bs[kk], acc); }
                const size_t off = ((size_t)g * L + chunk * 16 + t) * 16 + cq;
                const u32x2 uv = uvv[t];
                const float y0 = gelu_tanh(acc[0] + dv[0] * bflo(uv.x)), y1 = gelu_tanh(acc[1] + dv[1] * bfhi(uv.x));
                const float y2 = gelu_tanh(acc[2] + dv[2] * bflo(uv.y)), y3 = gelu_tanh(acc[3] + dv[3] * bfhi(uv.y));
                u32x2 w; w.x = pk2(y0, y1); w.y = pk2(y2, y3);
                *(u32x2*)(YG + off) = w;
                asm volatile("" ::: "memory");
            }
        }
    }
}

constexpr int QK_STRIDE = 4096;
constexpr int KL_STRIDE = 272, VL_STRIDE = 520, VT_OFF = 256 * KL_STRIDE;

__device__ __forceinline__ void attn_a1(ArgsP a, int j, unsigned char* smem, int dry) {
    const int tid = tid_l(), G = sg_l(gridDim.x);
    unsigned char* ws = a->ws;
    bf16_t* QKVZ = (bf16_t*)(ws + WS_BIG); const float* rope = (const float*)(ws + WS_ROPE); float* kmean = (float*)(ws + WS_KMEAN);
    if (sg_l(blockIdx.x) == 0) ((unsigned*)(ws + WS_CTL))[tid] = 0u;
    const int seg = tid & 15, rg = tid >> 4;
    const float* qg = a->in[15] + j * 128 + seg * 8; const float* kg = a->in[16] + j * 128 + seg * 8;
    float gq[8], gk[8];
#pragma unroll
    for (int i = 0; i < 8; ++i) { gq[i] = qg[i] * (0.08838834764831845f * 1.4426950408889634f); gk[i] = kg[i]; }
    float* red = (float*)(smem + 72 * 1024);
    for (int unit = sg_l(blockIdx.x); unit < 512; unit += G) {
        const int h = unit & 7, b = unit >> 3;
        float ksum[8];
#pragma unroll
        for (int i = 0; i < 8; ++i) ksum[i] = 0.f;
        __syncthreads();
#pragma unroll 1
        for (int pb = 0; pb < 2; ++pb) {
            u32x4 rq[4], rk[4], rv[4]; f32x2 rp[4][8];
#pragma unroll
            for (int p4 = 0; p4 < 4; ++p4) {
                const int t = b * 256 + (pb * 4 + p4) * 32 + rg;
                const bf16_t* p = QKVZ + (size_t)t * QK_STRIDE + h * 128 + seg * 8;
                rq[p4] = *(const u32x4*)p; rk[p4] = *(const u32x4*)(p + 1024); rv[p4] = *(const u32x4*)(p + 2048);
#pragma unroll
                for (int i = 0; i < 8; ++i) rp[p4][i] = *(const f32x2*)(rope + ((size_t)t * 16 + (seg & 1) * 8 + i) * 2);
            }
#pragma unroll
            for (int p4 = 0; p4 < 4; ++p4) {
                const int ps = pb * 4 + p4, t = b * 256 + ps * 32 + rg;
#pragma unroll
                for (int which = 0; which < 2; ++which) {
                    bf16_t* p = QKVZ + (size_t)t * QK_STRIDE + which * 1024 + h * 128 + seg * 8;
                    const u32x4 raw = which == 0 ? rq[p4] : rk[p4];
                    float x[8];
#pragma unroll
                    for (int q = 0; q < 4; ++q) { x[2 * q] = bflo(raw[q]); x[2 * q + 1] = bfhi(raw[q]); }
                    float ss = 0.f;
#pragma unroll
                    for (int i = 0; i < 8; ++i) ss += x[i] * x[i];
                    ss += __shfl_xor(ss, 1); ss += __shfl_xor(ss, 2); ss += __shfl_xor(ss, 4); ss += __shfl_xor(ss, 8);
                    const float rstd = rsqrtf(ss * (1.f / 128.f) + NORM_EPS);
#pragma unroll
                    for (int i = 0; i < 8; ++i) x[i] = x[i] * rstd * (which == 0 ? gq[i] : gk[i]);
                    float y[8];
#pragma unroll
                    for (int i = 0; i < 8; ++i) {
                        const float o = __shfl_xor(x[i], 2);
                        y[i] = x[i];
                        if (seg < 2) y[i] = x[i] * rp[p4][i].x - o * rp[p4][i].y;
                        else if (seg < 4) y[i] = x[i] * rp[p4][i].x + o * rp[p4][i].y;
                    }
                    u32x4 w; w.x = pk2(y[0], y[1]); w.y = pk2(y[2], y[3]); w.z = pk2(y[4], y[5]); w.w = pk2(y[6], y[7]);
                    if (!dry) *(u32x4*)p = w;
                    if (which == 1) {
#pragma unroll
                        for (int i = 0; i < 8; ++i) ksum[i] += y[i];
                    }
                }
                { const int key = ps * 32 + rg; *(u32x4*)(smem + key * 256 + ((seg ^ ((key >> 3) & 15)) * 16)) = rv[p4]; }
            }
        }
#pragma unroll
        for (int i = 0; i < 8; ++i) red[rg * 128 + seg * 8 + i] = ksum[i];
        __syncthreads();
        if (tid < 128) { float s = 0.f;
#pragma unroll
            for (int r = 0; r < 32; ++r) s += red[r * 128 + tid];
            if (!dry) kmean[((size_t)h * 64 + b) * 128 + tid] = s * (1.f / 256.f); }
        for (int e = tid; e < 4096; e += 512) {
            const int ko = e & 31, d = e >> 5, key0 = ko * 8;
            unsigned short v[8];
#pragma unroll
            for (int i = 0; i < 8; ++i) v[i] = *(const unsigned short*)(smem + (key0 + i) * 256 + (((d >> 3) ^ (ko & 15)) * 16) + (d & 7) * 2);
            u32x4 w; w.x = v[0] | ((unsigned)v[1] << 16); w.y = v[2] | ((unsigned)v[3] << 16); w.z = v[4] | ((unsigned)v[5] << 16); w.w = v[6] | ((unsigned)v[7] << 16);
            if (!dry) *(u32x4*)(QKVZ + (size_t)(b * 256 + 2 * d + (key0 >> 7)) * QK_STRIDE + 2048 + h * 128 + (key0 & 127)) = w;
        }
    }
}

__device__ __forceinline__ bool gate_better(float v, int i, float w, int k) { return v > w || (v == w && i < k); }
#define TOP3_INSERT(s_, n_) do { const float _s = (s_); const int _n = (n_); \
    const bool _b1 = gate_better(_s, _n, v1, i1), _b2 = gate_better(_s, _n, v2, i2), _b3 = gate_better(_s, _n, v3, i3); \
    const float _nv3 = _b2 ? v2 : (_b3 ? _s : v3); const int _ni3 = _b2 ? i2 : (_b3 ? _n : i3); \
    const float _nv2 = _b1 ? v1 : (_b2 ? _s : v2); const int _ni2 = _b1 ? i1 : (_b2 ? _n : i2); \
    const float _nv1 = _b1 ? _s : v1; const int _ni1 = _b1 ? _n : i1; \
    v1 = _nv1; i1 = _ni1; v2 = _nv2; i2 = _ni2; v3 = _nv3; i3 = _ni3; } while (0)
__device__ __forceinline__ void attn_a2(ArgsP a, unsigned char* smem, int dry) {
    const int tid = tid_l(), lane = tid & 63, wave = tid >> 6, G = sg_l(gridDim.x), r = lane & 31, hh = lane >> 5;
    unsigned char* ws = a->ws;
    const bf16_t* QKVZ = (const bf16_t*)(ws + WS_BIG); const float* kmean = (const float*)(ws + WS_KMEAN);
    unsigned* cnt = (unsigned*)(ws + WS_CTL); unsigned short* lists = (unsigned short*)(ws + WS_TAB);
    unsigned* cntl = (unsigned*)smem; unsigned* basel = cntl + 64;
    int cur_h = -1;
    bf16x8 Khi[2][8], Klo[2][8];
    for (int unit = sg_l(blockIdx.x); unit < 512; unit += G) {
        const int h = unit & 7, b = unit >> 3;
        if (b == 0) continue;
        if (h != cur_h) {
            cur_h = h;
#pragma unroll
            for (int tl = 0; tl < 2; ++tl)
#pragma unroll
                for (int kk = 0; kk < 8; ++kk) {
                    const float* kp = kmean + ((size_t)h * 64 + tl * 32 + r) * 128 + kk * 16 + hh * 8;
                    const f32x4 x0 = *(const f32x4*)kp, x1 = *(const f32x4*)(kp + 4);
                    u32x4 hi; hi.x = pk2(x0[0], x0[1]); hi.y = pk2(x0[2], x0[3]); hi.z = pk2(x1[0], x1[1]); hi.w = pk2(x1[2], x1[3]);
                    u32x4 lo; lo.x = pk2(x0[0] - bflo(hi.x), x0[1] - bfhi(hi.x)); lo.y = pk2(x0[2] - bflo(hi.y), x0[3] - bfhi(hi.y));
                    lo.z = pk2(x1[0] - bflo(hi.z), x1[1] - bfhi(hi.z)); lo.w = pk2(x1[2] - bflo(hi.w), x1[3] - bfhi(hi.w));
                    Khi[tl][kk] = __builtin_bit_cast(bf16x8, hi); Klo[tl][kk] = __builtin_bit_cast(bf16x8, lo);
                }
        }
        const int t = b * 256 + wave * 32 + r;
        bf16x8 qf[8];
#pragma unroll
        for (int kk = 0; kk < 8; ++kk) qf[kk] = *(const bf16x8*)(QKVZ + (size_t)t * QK_STRIDE + h * 128 + kk * 16 + hh * 8);
        float v1 = -INFINITY, v2 = -INFINITY, v3 = -INFINITY; int i1 = 1 << 20, i2 = 1 << 20, i3 = 1 << 20;
#pragma unroll
        for (int tl = 0; tl < 2; ++tl) {
            if (tl == 1 && b <= 32) break;
            f32x16 Gt;
#pragma unroll
            for (int i = 0; i < 16; ++i) Gt[i] = 0.f;
#pragma unroll
            for (int kk = 0; kk < 8; ++kk) { Gt = MFMA32(Khi[tl][kk], qf[kk], Gt); Gt = MFMA32(Klo[tl][kk], qf[kk], Gt); }
#pragma unroll
            for (int i = 0; i < 16; ++i) { const int n = tl * 32 + (i & 3) + 8 * (i >> 2) + 4 * hh; if (n < b) TOP3_INSERT(Gt[i], n); }
        }
        {
            const float w1 = __shfl_xor(v1, 32), w2 = __shfl_xor(v2, 32), w3 = __shfl_xor(v3, 32);
            const int k1 = __shfl_xor(i1, 32), k2 = __shfl_xor(i2, 32), k3 = __shfl_xor(i3, 32);
            TOP3_INSERT(w1, k1); TOP3_INSERT(w2, k2); TOP3_INSERT(w3, k3);
        }
        __syncthreads();
        if (tid < 64) cntl[tid] = 0u;
        __syncthreads();
        unsigned lp1 = 0u, lp2 = 0u, lp3 = 0u;
        if (hh == 0) {
            if (i1 < 64) lp1 = atomicAdd(&cntl[i1], 1u);
            if (i2 < 64) lp2 = atomicAdd(&cntl[i2], 1u);
            if (i3 < 64) lp3 = atomicAdd(&cntl[i3], 1u);
        }
        __syncthreads();
        if (tid < 64) { const unsigned c = cntl[tid]; basel[tid] = (c && !dry) ? atomicAdd(&cnt[h * 64 + tid], c) : 0u; }
        __syncthreads();
        if (hh == 0 && !dry) {
            unsigned short* lh = lists + (size_t)h * LIST_PER_HEAD;
            if (i1 < 64) lh[list_off(i1) + basel[i1] + lp1] = (unsigned short)(t);
            if (i2 < 64) lh[list_off(i2) + basel[i2] + lp2] = (unsigned short)(t | (1 << 14));
            if (i3 < 64) lh[list_off(i3) + basel[i3] + lp3] = (unsigned short)(t | (2 << 14));
        }
    }
}

__device__ __forceinline__ void load_kv(const bf16_t* QKVZ, int h, int n, unsigned char* smem) {
    const int tid = tid_l();
    u32x4 kr[8], vr[8];
#pragma unroll
    for (int i = 0; i < 8; ++i) { const int e = tid + i * 512, key = e >> 4, pc = e & 15;
        kr[i] = *(const u32x4*)(QKVZ + (size_t)(n * 256 + key) * QK_STRIDE + 1024 + h * 128 + pc * 8); }
#pragma unroll
    for (int i = 0; i < 8; ++i) { const int e = tid + i * 512, d = e >> 5, pc = e & 31, key0 = pc * 8;
        vr[i] = *(const u32x4*)(QKVZ + (size_t)(n * 256 + 2 * d + (key0 >> 7)) * QK_STRIDE + 2048 + h * 128 + (key0 & 127)); }
#pragma unroll
    for (int i = 0; i < 8; ++i) { const int e = tid + i * 512, key = e >> 4, pc = e & 15; *(u32x4*)(smem + key * KL_STRIDE + pc * 16) = kr[i]; }
#pragma unroll
    for (int i = 0; i < 8; ++i) { const int e = tid + i * 512, d = e >> 5, pc = e & 31;
        u32x2* dst = (u32x2*)(smem + VT_OFF + d * VL_STRIDE + pc * 16);
        dst[0] = (u32x2){vr[i].x, vr[i].y}; dst[1] = (u32x2){vr[i].z, vr[i].w}; }
}
__device__ __forceinline__ void attn_core(const unsigned char* smem, const bf16x8 (&qf)[8], int nkt, int mask_kt, int qidx, float c2, f32x16 (&O)[4], float& lsum) {
    const int lane = tid_l() & 63, r = lane & 31, hh = lane >> 5;
    const unsigned char* kbase = smem + r * KL_STRIDE + hh * 16;
    const unsigned char* vbase = smem + VT_OFF + r * VL_STRIDE + hh * 8;
    bf16x8 Kf[8];
#pragma unroll
    for (int kk = 0; kk < 8; ++kk) Kf[kk] = *(const bf16x8*)(kbase + kk * 32);
    f32x16 Sc;
#pragma unroll
    for (int i = 0; i < 16; ++i) Sc[i] = -c2;
#pragma unroll
    for (int kk = 0; kk < 8; ++kk) Sc = MFMA32(Kf[kk], qf[kk], Sc);
    if (nkt > 1) {
#pragma unroll
        for (int kk = 0; kk < 8; ++kk) Kf[kk] = *(const bf16x8*)(kbase + 32 * KL_STRIDE + kk * 32);
    }
#pragma unroll 1
    for (int kt = 0; kt < nkt; ++kt) {
        s16x4 V0l[4], V0h[4];
#pragma unroll
        for (int dt = 0; dt < 4; ++dt) { const unsigned char* vp = vbase + dt * 32 * VL_STRIDE + (kt * 32) * 2; V0l[dt] = *(const s16x4*)vp; V0h[dt] = *(const s16x4*)(vp + 16); }
        f32x16 Sn;
#pragma unroll
        for (int i = 0; i < 16; ++i) Sn[i] = -c2;
        if (kt + 1 < nkt) {
#pragma unroll
            for (int kk = 0; kk < 8; ++kk) Sn = MFMA32(Kf[kk], qf[kk], Sn);
            const int kt2 = kt + 2 < nkt ? kt + 2 : kt + 1;
#pragma unroll
            for (int kk = 0; kk < 8; ++kk) Kf[kk] = *(const bf16x8*)(kbase + kt2 * 32 * KL_STRIDE + kk * 32);
        }
        asm volatile("" ::: "memory");
        float p[16];
#pragma unroll
        for (int i = 0; i < 16; ++i) { p[i] = __builtin_amdgcn_exp2f(Sc[i]);
            if (kt == mask_kt) { const int key = kt * 32 + (i & 3) + 8 * (i >> 2) + 4 * hh; if (key > qidx) p[i] = 0.f; }
            lsum += p[i]; }
        u32x4 pw0; pw0.x = pk2(p[0], p[1]); pw0.y = pk2(p[2], p[3]); pw0.z = pk2(p[4], p[5]); pw0.w = pk2(p[6], p[7]);
        u32x4 pw1; pw1.x = pk2(p[8], p[9]); pw1.y = pk2(p[10], p[11]); pw1.z = pk2(p[12], p[13]); pw1.w = pk2(p[14], p[15]);
        asm volatile("" ::: "memory");
        s16x4 V1l[4], V1h[4];
#pragma unroll
        for (int dt = 0; dt < 4; ++dt) { const unsigned char* vp = vbase + dt * 32 * VL_STRIDE + (kt * 32 + 16) * 2; V1l[dt] = *(const s16x4*)vp; V1h[dt] = *(const s16x4*)(vp + 16); }
        { const bf16x8 pa = __builtin_bit_cast(bf16x8, pw0);
#pragma unroll
          for (int dt = 0; dt < 4; ++dt) O[dt] = MFMA32(pa, __builtin_shufflevector(V0l[dt], V0h[dt], 0, 1, 2, 3, 4, 5, 6, 7), O[dt]); }
        { const bf16x8 pa = __builtin_bit_cast(bf16x8, pw1);
#pragma unroll
          for (int dt = 0; dt < 4; ++dt) O[dt] = MFMA32(pa, __builtin_shufflevector(V1l[dt], V1h[dt], 0, 1, 2, 3, 4, 5, 6, 7), O[dt]); }
        Sc = Sn;
    }
}
__device__ __forceinline__ float attn_ref(ArgsP a, int j) {
    const int lane = tid_l() & 63;
    float mq = fmaxf(fabsf(a->in[15][j * 128 + lane]), fabsf(a->in[15][j * 128 + 64 + lane]));
    float mk = fmaxf(fabsf(a->in[16][j * 128 + lane]), fabsf(a->in[16][j * 128 + 64 + lane]));
#pragma unroll
    for (int o = 1; o < 64; o <<= 1) { mq = fmaxf(mq, __shfl_xor(mq, o)); mk = fmaxf(mk, __shfl_xor(mk, o)); }
    return 11.313708499f * mq * mk;
}
constexpr int LDS_LQ = 141312;

__device__ __forceinline__ void attn_a3(ArgsP a, int j, unsigned char* smem) {
    const int tid = tid_l(), lane = tid & 63, wave = tid >> 6, G = sg_l(gridDim.x), r = lane & 31, hh = lane >> 5;
    unsigned char* ws = a->ws;
    const bf16_t* QKVZ = (const bf16_t*)(ws + WS_BIG);
    const unsigned* cnt = (const unsigned*)(ws + WS_CTL); const unsigned short* lists = (const unsigned short*)(ws + WS_TAB);
    float* lpart = (float*)(ws + WS_LPART);
    int* pre = (int*)(smem + 140 * 1024);
    const float ref = attn_ref(a, j), c2 = ref * 1.4426950408889634f;
    int* cntl = (int*)(smem + 136192);
    __syncthreads();
    { const int c = (int)cnt[tid]; cntl[tid] = c; pre[tid] = (c + 255) >> 8; }
    __syncthreads();
    for (int o = 1; o < 512; o <<= 1) { const int v = pre[tid] + (tid >= o ? pre[tid - o] : 0); __syncthreads(); pre[tid] = v; __syncthreads(); }
    const int total = pre[511]; const int bidx = sg_l(blockIdx.x);
    const int t_lo = (int)(((long)total * bidx) / G), t_hi = (int)(((long)total * (bidx + 1)) / G);
    int cur_pr = -1;
    int e_cur = -1; bf16x8 qf[8];
    auto tile_info = [&](int tile, int& pr, int& tl) { int lo = 0, hi = 511; while (lo < hi) { const int mid = (lo + hi) >> 1; if (pre[mid] > tile) hi = mid; else lo = mid + 1; } pr = lo; tl = tile - (pr ? pre[pr - 1] : 0); };
    auto load_entry = [&](int tile) -> int { int pr, tl; tile_info(tile, pr, tl); const int h = pr >> 6, n = pr & 63, c = cntl[pr]; const int li = tl * 256 + wave * 32 + r; const bool valid = li < c;
        const unsigned e = lists[(size_t)h * LIST_PER_HEAD + list_off(n) + (valid ? li : 0)]; return (int)e | (valid ? 0x10000 : 0); };
    int e_nxt = -1;
    if (t_lo < t_hi) { e_cur = load_entry(t_lo); if (t_lo + 1 < t_hi) e_nxt = load_entry(t_lo + 1); int pr, tl; tile_info(t_lo, pr, tl); const int h = pr >> 6;
#pragma unroll
        for (int kk = 0; kk < 8; ++kk) qf[kk] = *(const bf16x8*)(QKVZ + (size_t)(e_cur & 0x3fff) * QK_STRIDE + h * 128 + kk * 16 + hh * 8); }
    for (int tile = t_lo; tile < t_hi; ++tile) {
        int pr, tl; tile_info(tile, pr, tl);
        const int h = pr >> 6, n = pr & 63;
        if (pr != cur_pr) { __syncthreads(); load_kv(QKVZ, h, n, smem); __syncthreads(); cur_pr = pr; }
        int e_nn = -1;
        if (tile + 2 < t_hi) e_nn = load_entry(tile + 2);
        f32x16 O[4];
#pragma unroll
        for (int dt = 0; dt < 4; ++dt)
#pragma unroll
            for (int i = 0; i < 16; ++i) O[dt][i] = 0.f;
        float lsum = 0.f;
        attn_core(smem, qf, 8, -1, 0, c2, O, lsum);
        if (tile + 1 < t_hi) { int pr2, tl2; tile_info(tile + 1, pr2, tl2); const int h2 = pr2 >> 6;
#pragma unroll
            for (int kk = 0; kk < 8; ++kk) qf[kk] = *(const bf16x8*)(QKVZ + (size_t)(e_nxt & 0x3fff) * QK_STRIDE + h2 * 128 + kk * 16 + hh * 8); }
        lsum += __shfl_xor(lsum, 32);
        if (hh == 0 && (e_cur & 0x10000)) lpart[((size_t)((e_cur >> 14) & 3) * L + (e_cur & 0x3fff)) * 8 + h] = lsum;
#pragma unroll
        for (int i = 0; i < 16; ++i) {
            const int ei = __shfl(e_cur, (i & 3) + 8 * (i >> 2) + 4 * hh);
            if (ei & 0x10000) {
                const int slot = (ei >> 14) & 3, ti = ei & 0x3fff;
                bf16_t* P = (bf16_t*)(ws + (slot == 0 ? WS_XN : (slot == 1 ? WS_P1 : WS_P2))) + (size_t)ti * DM + h * 128 + r * 4;
                u32x2 w; w.x = pk2(O[0][i], O[1][i]); w.y = pk2(O[2][i], O[3][i]);
                *(u32x2*)P = w;
            }
        }
        e_cur = e_nxt; e_nxt = e_nn;
    }
}
__device__ __forceinline__ void attn_a4(ArgsP a, int j, unsigned char* smem, int dry) {
    const int tid = tid_l(), lane = tid & 63, wave = tid >> 6, G = sg_l(gridDim.x), r = lane & 31, hh = lane >> 5;
    unsigned char* ws = a->ws;
    const bf16_t* QKVZ = (const bf16_t*)(ws + WS_BIG); const float* lpart = (const float*)(ws + WS_LPART);
    const float ref = attn_ref(a, j), c2 = ref * 1.4426950408889634f;
    float* lq = (float*)(smem + LDS_LQ) + wave * 32;
    const int qt = wave < 4 ? wave : 11 - wave;
    for (int unit = sg_l(blockIdx.x); unit < 512; unit += G) {
        const int h = unit & 7, b = unit >> 3;
        __syncthreads(); load_kv(QKVZ, h, b, smem); __syncthreads();
        const int qidx = qt * 32 + r, t = b * 256 + qidx;
        bf16x8 qf[8];
#pragma unroll
        for (int kk = 0; kk < 8; ++kk) qf[kk] = *(const bf16x8*)(QKVZ + (size_t)t * QK_STRIDE + h * 128 + kk * 16 + hh * 8);
        f32x16 O[4];
#pragma unroll
        for (int dt = 0; dt < 4; ++dt)
#pragma unroll
            for (int i = 0; i < 16; ++i) O[dt][i] = 0.f;
        float lsum = 0.f;
        attn_core(smem, qf, qt + 1, qt, qidx, c2, O, lsum);
        lsum += __shfl_xor(lsum, 32);
        const int nsel = b < 3 ? b : 3;
        for (int s = 0; s < nsel; ++s) lsum += lpart[((size_t)s * L + t) * 8 + h];
        if (hh == 0) lq[r] = 1.0f / lsum;
        __builtin_amdgcn_wave_barrier(); asm volatile("s_waitcnt lgkmcnt(0)" ::: "memory");
#pragma unroll
        for (int ih = 0; ih < 2; ++ih) {
            u32x2 pv[8][3], zv[8];
#pragma unroll
            for (int i8 = 0; i8 < 8; ++i8) {
                const int i = ih * 8 + i8, qi = (i & 3) + 8 * (i >> 2) + 4 * hh; const size_t ti = (size_t)(b * 256 + qt * 32 + qi);
#pragma unroll
                for (int s = 0; s < 3; ++s) pv[i8][s] = s < nsel ? *(const u32x2*)((const bf16_t*)(ws + (s == 0 ? WS_XN : (s == 1 ? WS_P1 : WS_P2))) + ti * DM + h * 128 + r * 4) : (u32x2){0u, 0u};
                zv[i8] = *(const u32x2*)(QKVZ + ti * QK_STRIDE + 3072 + h * 128 + r * 4);
            }
            asm volatile("" ::: "memory");
#pragma unroll
            for (int i8 = 0; i8 < 8; ++i8) {
                const int i = ih * 8 + i8, qi = (i & 3) + 8 * (i >> 2) + 4 * hh; const size_t ti = (size_t)(b * 256 + qt * 32 + qi);
                const float inv = lq[qi];
                float o0 = O[0][i], o1 = O[1][i], o2 = O[2][i], o3 = O[3][i];
#pragma unroll
                for (int s = 0; s < 3; ++s) { o0 += bflo(pv[i8][s].x); o1 += bfhi(pv[i8][s].x); o2 += bflo(pv[i8][s].y); o3 += bfhi(pv[i8][s].y); }
                const float z0 = bflo(zv[i8].x), z1 = bfhi(zv[i8].x), z2 = bflo(zv[i8].y), z3 = bfhi(zv[i8].y);
                u32x2 w; w.x = pk2(o0 * inv * z0 * sigmoidf_(z0), o1 * inv * z1 * sigmoidf_(z1)); w.y = pk2(o2 * inv * z2 * sigmoidf_(z2), o3 * inv * z3 * sigmoidf_(z3));
                if (!dry) *(u32x2*)((bf16_t*)(ws + WS_XN) + ti * DM + h * 128 + r * 4) = w;
            }
        }
        __builtin_amdgcn_wave_barrier();
    }
}

#define XB_TMO      128
#define XB_XCNT(j)  (256  + 64 * (j))
#define XB_XSUB(j)  (1280 + 64 * (j))
#define XB_XGEN(j)  (2304 + 64 * (j))
#define XB_TOP      3328
#define XB_TOPGEN   3392
#define XCD_BAR_WORDS 3456
#define XB_SPIN_CAP (1u << 22)
__device__ __forceinline__ unsigned xb_ld(unsigned* p)              { return __hip_atomic_load(p, __ATOMIC_RELAXED, __HIP_MEMORY_SCOPE_AGENT); }
__device__ __forceinline__ unsigned xb_add(unsigned* p, unsigned v) { return __hip_atomic_fetch_add(p, v, __ATOMIC_RELAXED, __HIP_MEMORY_SCOPE_AGENT); }
__device__ __forceinline__ unsigned xb_xcc_id() { return (unsigned)__builtin_amdgcn_s_getreg((3 << 11) | 20) & 0xFu; }
#define XB_SPIN(cond, bar) do { unsigned _sp = 0; while (cond) { __builtin_amdgcn_s_sleep(1); \
    if ((++_sp & 255u) == 0u) { if (xb_ld(&(bar)[XB_TMO])) break; if (_sp > XB_SPIN_CAP) { atomicAdd(&(bar)[XB_TMO], 1u); break; } } } } while (0)
struct XcdBarrier { unsigned* bar; unsigned x; volatile LAS unsigned* st; };
__device__ __forceinline__ XcdBarrier xcd_barrier_post(unsigned* bar, volatile LAS unsigned* st) {
    XcdBarrier b; b.bar = bar; b.x = xb_xcc_id(); b.st = st;
    if (threadIdx.x == 0) (void)xb_add(&bar[XB_XCNT(b.x)], 1u);
    return b;
}
__device__ __forceinline__ void xcd_barrier_complete(unsigned* bar, unsigned x, unsigned& nloc, unsigned& nx) {
    const unsigned G = gridDim.x * gridDim.y * gridDim.z;
    unsigned sum, cnt, mine, sp = 0u;
    for (;;) {
        sum = 0u; cnt = 0u; mine = 0u;
#pragma unroll
        for (unsigned j = 0; j < 16; ++j) { const unsigned c = xb_ld(&bar[XB_XCNT(j)]); sum += c; cnt += (c > 0u) ? 1u : 0u; mine = (j == x) ? c : mine; }
        if (sum == G) break;
        __builtin_amdgcn_s_sleep(1);
        if ((++sp & 255u) == 0u) { if (xb_ld(&bar[XB_TMO])) break; if (sp > XB_SPIN_CAP) { atomicAdd(&bar[XB_TMO], 1u); break; } }
    }
    nloc = mine > 0u ? mine : 1u; nx = cnt > 0u ? cnt : 1u;
}
__device__ __forceinline__ void xcd_barrier(const XcdBarrier& b) {
    asm volatile("s_waitcnt vmcnt(0)" ::: "memory");
    __syncthreads();
    if (threadIdx.x == 0) {
        unsigned* bar = b.bar;
        __builtin_amdgcn_s_waitcnt(0);
        unsigned nloc = b.st[0], nx = b.st[1];
        if (nloc == 0u) { xcd_barrier_complete(bar, b.x, nloc, nx); b.st[0] = nloc; b.st[1] = nx; }
        const unsigned old = xb_add(&bar[XB_XSUB(b.x)], 1u);
        const unsigned gen = old / nloc;
        if (old + 1u == (gen + 1u) * nloc) {
            __builtin_amdgcn_fence(__ATOMIC_RELEASE, "agent");
            asm volatile("s_waitcnt vmcnt(0)" ::: "memory");
            const unsigned og = xb_add(&bar[XB_TOP], 1u);
            const unsigned tg = og / nx;
            if (og + 1u == (tg + 1u) * nx) xb_add(&bar[XB_TOPGEN], 1u);
            else XB_SPIN(xb_ld(&bar[XB_TOPGEN]) == tg, bar);
            __builtin_amdgcn_fence(__ATOMIC_ACQUIRE, "agent");
            xb_add(&bar[XB_XGEN(b.x)], 1u);
            asm volatile("s_waitcnt vmcnt(0)" ::: "memory");
        } else {
            XB_SPIN(xb_ld(&bar[XB_XGEN(b.x)]) == gen, bar);
            __builtin_amdgcn_fence(__ATOMIC_ACQUIRE, "agent");
            asm volatile("s_waitcnt vmcnt(0)" ::: "memory");
        }
    }
    __syncthreads();
}
#ifndef PH_MASK
#define PH_MASK 0xFFFF
#endif
#define PH(b) ((PH_MASK >> (b)) & 1)
#ifndef REP_MASK
#define REP_MASK 0
#endif
#ifndef XSYNC
#define XSYNC 0
#endif
#define REP(b) for (int _r = 0; _r < 1 + ((REP_MASK >> (b)) & 1); ++_r)
__global__ void __launch_bounds__(512, 2) hybrid_fwd(Args a_unused) {
    extern __shared__ __attribute__((aligned(16))) unsigned char smem[];
    cg::grid_group grid = cg::this_grid();
    LAS unsigned char* lds = (LAS unsigned char*)smem;
    const ArgsP ap = (ArgsP)__builtin_amdgcn_kernarg_segment_ptr();
    if (threadIdx.x < 2) ((volatile LAS unsigned*)(lds + LDS_BARST))[threadIdx.x] = 0u;
    __syncthreads();
    if (blockIdx.x == 0) for (int e = threadIdx.x; e < XCD_BAR_WORDS; e += 512) ((unsigned*)(ap->ws + WS_BAR))[e] = 0u;

#define a launder(ap)
#define ws (launder(ap)->ws)
#define Wb ((bf16_t*)(ws + WS_W))
#define XN ((bf16_t*)(ws + WS_XN))
    REP(0) if (PH(0)) pre0_phase(a);
    grid.sync();
    (void)xcd_barrier_post((unsigned*)(ws + WS_BAR), (volatile LAS unsigned*)(lds + LDS_BARST));
#define GSYNC() do { XcdBarrier _b; _b.bar = (unsigned*)(ws + WS_BAR); _b.x = xb_xcc_id(); _b.st = (volatile LAS unsigned*)(lds + LDS_BARST); xcd_barrier(_b); } while (0)
    for (int _x = 0; _x < XSYNC; ++_x) GSYNC();
    REP(0) if (PH(0)) prep_phase(a, 0, a->in[0], smem);
    GSYNC();
#pragma unroll 1
    for (int layer = 0; layer < 4; ++layer) {
        const int j = layer >> 1;
        if ((layer & 1) == 0) {
            REP(1) if (PH(1)) { pg8::Gemm g{layer == 0 ? XN : (bf16_t*)(ws + WS_Y2), Wb, L, 2048, 1024}; pg8::StaticOrder S; S.init(L, 2048, sg_l(gridDim.x), sg_l(blockIdx.x));
              pg8::EpiStore E{(bf16_t*)(ws + WS_U), 1024, 1024, (size_t)(WS_Z - WS_U) / 2, (const float*)(ws + WS_ROWSQ), 1};
              pg8::gemm_phase<pg8::EpiStore, pg8::StaticOrder, true, true>(lds, g, S, E); }
            GSYNC();
            REP(2) if (PH(2)) ssm_s1(a, smem);
            GSYNC();
            REP(3) if (PH(3)) ssm_s2(a, j, smem);
            GSYNC();
            REP(4) if (PH(4)) ssm_s3(a, j, smem);
            GSYNC();
            REP(5) if (PH(5)) { pg8::Gemm g{(const bf16_t*)(ws + WS_YG), Wb + 2048 * 1024, L, 1024, 1024}; pg8::StaticOrder S; S.init(L, 1024, sg_l(gridDim.x), sg_l(blockIdx.x));
              pg8::EpiGlu E{(const bf16_t*)(ws + WS_YG), (const bf16_t*)(ws + WS_Z), a->in[12] + j * 1024, (bf16_t*)(ws + WS_Y2)};
              pg8::gemm_phase<pg8::EpiGlu, pg8::StaticOrder, true, true, true>(lds, g, S, E); }
            GSYNC();
            if (layer < 3) { if (PH(13)) prep_phase(a, layer + 1, a->out, smem); __syncthreads(); }
            REP(6) if (PH(6)) { pg8::Gemm g{(const bf16_t*)(ws + WS_Y2), Wb + 4096 * 1024, L, 1024, 1024}; pg8::StaticOrder S; S.init(L, 1024, sg_l(gridDim.x), sg_l(blockIdx.x));
              pg8::EpiRes E{layer == 0 ? a->in[0] : (const float*)a->out, a->out, layer < 3 ? XN : (bf16_t*)nullptr, (float*)(ws + WS_ROWSQ)};
              pg8::gemm_phase<pg8::EpiRes, pg8::StaticOrder, true, true>(lds, g, S, E); }
            GSYNC();
        } else {
            REP(7) if (PH(7)) { pg8::Gemm g{XN, Wb, L, 4096, 1024}; pg8::StaticOrder S; S.init(L, 4096, sg_l(gridDim.x), sg_l(blockIdx.x));
              pg8::EpiStore E{(bf16_t*)(ws + WS_BIG), 4096, 0, 0, (const float*)(ws + WS_ROWSQ), 0};
              pg8::gemm_phase<pg8::EpiStore, pg8::StaticOrder, true, true>(lds, g, S, E); }
            GSYNC();
            REP(8) if (PH(8)) attn_a1(a, j, smem, sg_l(_r == 0 && ((REP_MASK >> 8) & 1)));
            GSYNC();
            REP(9) if (PH(9)) attn_a2(a, smem, sg_l(_r == 0 && ((REP_MASK >> 9) & 1)));
            GSYNC();
            REP(10) if (PH(10)) attn_a3(a, j, smem);
            GSYNC();
            REP(11) if (PH(11)) attn_a4(a, j, smem, sg_l(_r == 0 && ((REP_MASK >> 11) & 1)));
            GSYNC();
            if (layer < 3) { if (PH(13)) prep_phase(a, layer + 1, a->out, smem); __syncthreads(); }
            REP(12) if (PH(12)) { pg8::Gemm g{XN, (const bf16_t*)(ws + WS_W2), L, 1024, 1024}; pg8::StaticOrder S; S.init(L, 1024, sg_l(gridDim.x), sg_l(blockIdx.x));
              pg8::EpiRes E{(const float*)a->out, a->out, layer < 3 ? (bf16_t*)(ws + WS_Y2) : (bf16_t*)nullptr, (float*)(ws + WS_ROWSQ)};
              pg8::gemm_phase<pg8::EpiRes, pg8::StaticOrder, true, true>(lds, g, S, E); }
            GSYNC();
        }
    }
}

#undef GSYNC
#undef a
#undef ws
#undef Wb
#undef XN
extern "C" void kernel_launch(void* const* d_in, const int* in_sizes, int n_in, void* d_out, int out_size, void* d_ws, size_t ws_size, hipStream_t stream) {
    static int grid = 0;
    if (grid == 0) {
        if (n_in != 18 || out_size != L * DM || ws_size < WS_END) { fprintf(stderr, "kernel_launch: unexpected shapes (n_in %d, out %d, ws %zu)\n", n_in, out_size, ws_size); grid = -1; return; }
        int dev = 0, cus = 0, per_cu = 0;
        (void)hipGetDevice(&dev); (void)hipDeviceGetAttribute(&cus, hipDeviceAttributeMultiprocessorCount, dev);
        (void)hipFuncSetAttribute((const void*)hybrid_fwd, hipFuncAttributeMaxDynamicSharedMemorySize, LDS_BYTES);
        (void)hipOccupancyMaxActiveBlocksPerMultiprocessor(&per_cu, (const void*)hybrid_fwd, 512, LDS_BYTES);
        if (per_cu < 1) { fprintf(stderr, "kernel_launch: occupancy query says %d blocks per CU\n", per_cu); per_cu = 1; }
        grid = cus * 1;
        if (grid > 256) grid = 256;
    }
    if (grid < 0) return;
    Args a{};
    for (int i = 0; i < 18; ++i) a.in[i] = (const float*)d_in[i];
    a.out = (float*)d_out; a.ws = (unsigned char*)d_ws;
    void* args[] = {&a};
    hipError_t e = hipLaunchCooperativeKernel((const void*)hybrid_fwd, dim3(grid), dim3(512), args, LDS_BYTES, stream);
    if (e != hipSuccess) fprintf(stderr, "cooperative launch failed: %s (grid %d)\n", hipGetErrorString(e), grid);
}
```

```cpp
#include <hip/hip_runtime.h>
#include <hip/hip_cooperative_groups.h>
#include <cstdio>
#include <cstdint>
namespace cg = cooperative_groups;

#define LAS __attribute__((address_space(3)))
typedef unsigned short bf16_t;
typedef short bf16x8 __attribute__((ext_vector_type(8)));
typedef short s16x4 __attribute__((ext_vector_type(4)));
typedef float f32x2 __attribute__((ext_vector_type(2)));
typedef float f32x4 __attribute__((ext_vector_type(4)));
typedef float f32x16 __attribute__((ext_vector_type(16)));
typedef unsigned u32x2 __attribute__((ext_vector_type(2)));
typedef unsigned u32x4 __attribute__((ext_vector_type(4)));
typedef __bf16 bf16v2 __attribute__((ext_vector_type(2)));

__device__ __forceinline__ unsigned pk2(float lo, float hi) { f32x2 v = {lo, hi}; bf16v2 b = __builtin_convertvector(v, bf16v2); return __builtin_bit_cast(unsigned, b); }
__device__ __forceinline__ float bflo(unsigned w) { return __uint_as_float(w << 16); }
__device__ __forceinline__ float bfhi(unsigned w) { return __uint_as_float(w & 0xffff0000u); }
__device__ __forceinline__ float sigmoidf_(float x) { return 1.0f / (1.0f + __expf(-x)); }
__device__ __forceinline__ float gelu_tanh(float y) { const float t = 0.7978845608028654f * (y + 0.044715f * y * y * y); const float e = __expf(2.0f * t); const float th = 1.0f - 2.0f / (e + 1.0f); return 0.5f * y * (1.0f + th); }

__device__ __forceinline__ int tid_l() { int t = threadIdx.x; asm volatile("" : "+v"(t)); return t; }
__device__ __forceinline__ int sg_l(int v) { v = __builtin_amdgcn_readfirstlane(v); asm volatile("" : "+s"(v)); return v; }
constexpr int L = 16384, DM = 1024, NH = 8, HD = 128, NBLK = 64;
constexpr size_t MiB = 1u << 20;
constexpr size_t WS_CTL = 0, WS_BAR = 16 * 1024, WS_KMEAN = 256 * 1024;
constexpr int LDS_BARST = 146432;
constexpr size_t WS_W = 1 * MiB, WS_TAB = 11 * MiB, WS_XN = 21 * MiB, WS_BIG = 53 * MiB;
constexpr size_t WS_U = WS_BIG, WS_Z = WS_BIG + 32 * MiB, WS_YG = WS_BIG + 64 * MiB, WS_Y2 = WS_BIG + 96 * MiB;
constexpr size_t WS_P1 = 181 * MiB, WS_P2 = 213 * MiB, WS_SLOC = 181 * MiB, WS_SIN = 213 * MiB;
constexpr size_t WS_LPART = 245 * MiB, WS_ROPE = 247 * MiB, WS_EP = 249 * MiB, WS_W2 = 251 * MiB, WS_ROWSQ = 253 * MiB, WS_END = 254 * MiB;
constexpr int EP_STRIDE = 19 * 64 * 2;
constexpr int TAB_STRIDE = 147456;
constexpr int LIST_PER_HEAD = 516096;
__host__ __device__ __forceinline__ int list_off(int n) { return 16128 * n - 128 * n * (n - 1); }
constexpr int LDS_BYTES = 147456;
constexpr float NORM_EPS = 1e-6f;

namespace pg8 {
constexpr int M_ROWS = 16384;
constexpr int BM = 256, BK = 64, HALF = 128, HTB = HALF * BK * 2, STAGE_BYTES = 8 * HTB, NXCD = 8, WGM = 8;
__host__ __device__ __forceinline__ int lds_byte(int r, int c) { const int st = (r >> 4) * 2 + (c >> 5), rr = r & 15, cc = c & 31, ob = rr * 64 + cc * 2; return st * 1024 + (ob ^ (((ob >> 9) & 1) << 5)); }
__host__ __device__ __forceinline__ void stage_rc(int b, int& R, int& C) { const int st = b / 1024, sb = b % 1024, swz = sb ^ (((sb >> 9) & 1) << 5); R = (st >> 1) * 16 + swz / 64; C = (st & 1) * 32 + (swz % 64) / 2; }
__host__ __device__ __forceinline__ int perm32(int rho) { const int n = rho >> 4, i = rho & 15; return 8 * (i >> 2) + 4 * n + (i & 3); }
struct Unit { int pm, pn; };
struct Gemm { const bf16_t* A; const bf16_t* Bt; int M, N, K; };
struct StaticOrder {
    int nM, nN, nwg, G, c;
    __host__ __device__ void init(int M, int N, int G_, int c_) { nM = M / BM; nN = N / BM; nwg = nM * nN; G = G_; c = c_; }
    __host__ __device__ bool next(int i, Unit& u) const {
        const long Lx = (long)i * G + c; if (Lx >= nwg) return false;
        int wgid = (int)Lx; { const int q = nwg / NXCD, r = nwg % NXCD, xcd = wgid % NXCD, off = wgid / NXCD; wgid = (xcd < r ? xcd * (q + 1) : r * (q + 1) + (xcd - r) * q) + off; }
        const int nig = WGM * nN, gid = wgid / nig, fm = gid * WGM, gsz = (nM - fm) < WGM ? (nM - fm) : WGM;
        u.pm = fm + ((wgid % nig) % gsz); u.pn = (wgid % nig) / gsz; return true;
    }
    __device__ __forceinline__ void a_ready(const Unit&) const {}
    __device__ __forceinline__ void done(const Unit&) const {}
};

struct EpiStore {
    static constexpr bool PERM = true, AFTER_DRAIN = false;
    bf16_t* O; int ldc; int split_cols; size_t split_stride; const float* rowsq; int ugm;
    __device__ __forceinline__ void operator()(const f32x4 (&acc)[2][2][4][2], const Unit& u, int wr, int wc, int fr, int fq) const {
        const int row0 = u.pm * BM + wr * 64 + fr; int colt = u.pn * BM; bf16_t* base = O;
        if (split_cols) { const int t = colt / split_cols; base += (size_t)t * split_stride; colt -= t * split_cols; }
        const int col0 = colt + wc * 32 + 8 * fq; const bool gm = ugm && base == O;
        float rsv[2][4];
#pragma unroll
        for (int ai = 0; ai < 2; ++ai)
#pragma unroll
            for (int m = 0; m < 4; ++m) { const f32x4* rp = (const f32x4*)(rowsq + (size_t)(row0 + ai * HALF + m * 16) * 16); const f32x4 q0 = rp[0], q1 = rp[1], q2 = rp[2], q3 = rp[3];
                const float tot = (((q0[0] + q0[1]) + (q0[2] + q0[3])) + ((q1[0] + q1[1]) + (q1[2] + q1[3]))) + (((q2[0] + q2[1]) + (q2[2] + q2[3])) + ((q3[0] + q3[1]) + (q3[2] + q3[3])));
                rsv[ai][m] = rsqrtf(tot * (1.f / 1024.f) + NORM_EPS); }
        asm volatile("" ::: "memory");
#pragma unroll
        for (int ai = 0; ai < 2; ++ai)
#pragma unroll
            for (int m = 0; m < 4; ++m) { bf16_t* rowp = gm ? base + ((size_t)(col0 >> 4) * M_ROWS + (row0 + ai * HALF + m * 16)) * 16 + (col0 & 15) : base + (size_t)(row0 + ai * HALF + m * 16) * ldc + col0;
                const float rs = rsv[ai][m];
#pragma unroll
                for (int bj = 0; bj < 2; ++bj) { const f32x4 v0 = acc[ai][bj][m][0] * rs, v1 = acc[ai][bj][m][1] * rs;
                    u32x4 w; w.x = pk2(v0[0], v0[1]); w.y = pk2(v0[2], v0[3]); w.z = pk2(v1[0], v1[1]); w.w = pk2(v1[2], v1[3]);
                    *(u32x4*)(rowp + (gm ? (size_t)bj * 8 * M_ROWS * 16 : (size_t)bj * HALF)) = w; } }
    }
};
struct EpiGlu {
    static constexpr bool PERM = true, AFTER_DRAIN = false;
    const bf16_t* YG; const bf16_t* Z; const float* bias; bf16_t* O;
    __device__ __forceinline__ void operator()(const f32x4 (&acc)[2][2][4][2], const Unit& u, int wr, int wc, int fr, int fq) const {
        const int row0 = u.pm * BM + wr * 64 + fr; const int col0 = u.pn * BM + wc * 32 + 8 * fq;
        f32x4 b0[2], b1[2];
#pragma unroll
        for (int bj = 0; bj < 2; ++bj) { b0[bj] = *(const f32x4*)(bias + col0 + bj * HALF); b1[bj] = *(const f32x4*)(bias + col0 + bj * HALF + 4); }
#pragma unroll
        for (int aq = 0; aq < 4; ++aq) {
            const int ai = aq >> 1, mh = (aq & 1) * 2;
            u32x4 yv[2][2], zv[2][2];
#pragma unroll
            for (int m2 = 0; m2 < 2; ++m2)
#pragma unroll
                for (int bj = 0; bj < 2; ++bj) {
                    const int row = row0 + ai * HALF + (mh + m2) * 16, colg = col0 + bj * HALF;
                    yv[m2][bj] = *(const u32x4*)(YG + ((size_t)(colg >> 4) * M_ROWS + row) * 16 + (colg & 15));
                    zv[m2][bj] = *(const u32x4*)(Z + (size_t)row * DM + colg);
                }
            asm volatile("" ::: "memory");
#pragma unroll
            for (int m2 = 0; m2 < 2; ++m2)
#pragma unroll
                for (int bj = 0; bj < 2; ++bj) {
                    const int m = mh + m2;
                    const size_t off = (size_t)(row0 + ai * HALF + m * 16) * DM + col0 + bj * HALF;
                    const f32x4 v0 = acc[ai][bj][m][0] + b0[bj], v1 = acc[ai][bj][m][1] + b1[bj];
                    float r[8];
#pragma unroll
                    for (int q = 0; q < 4; ++q) {
                        const float a0 = q < 2 ? v0[2 * q] : v1[2 * q - 4], a1 = q < 2 ? v0[2 * q + 1] : v1[2 * q - 3];
                        const float y0 = bflo(yv[m2][bj][q]), y1 = bfhi(yv[m2][bj][q]), z0 = bflo(zv[m2][bj][q]), z1 = bfhi(zv[m2][bj][q]);
                        r[2 * q] = y0 * sigmoidf_(a0) * (z0 * sigmoidf_(z0)); r[2 * q + 1] = y1 * sigmoidf_(a1) * (z1 * sigmoidf_(z1));
                    }
                    u32x4 w; w.x = pk2(r[0], r[1]); w.y = pk2(r[2], r[3]); w.z = pk2(r[4], r[5]); w.w = pk2(r[6], r[7]);
                    *(u32x4*)(O + off) = w;
                }
        }
    }
};
struct EpiRes {
    static constexpr bool PERM = true, AFTER_DRAIN = false;
    const float* base; float* out; bf16_t* xn; float* rowsq;
    __device__ __forceinline__ void operator()(const f32x4 (&acc)[2][2][4][2], const Unit& u, int wr, int wc, int fr, int fq) const {
        const int row0 = u.pm * BM + wr * 64 + fr; const int col0 = u.pn * BM + wc * 32 + 8 * fq;
#pragma unroll
        for (int ai = 0; ai < 2; ++ai) {
            f32x4 pre[4][2][2];
#pragma unroll
            for (int m = 0; m < 4; ++m)
#pragma unroll
                for (int bj = 0; bj < 2; ++bj) { const size_t off = (size_t)(row0 + ai * HALF + m * 16) * DM + col0 + bj * HALF;
                    pre[m][bj][0] = *(const f32x4*)(base + off); pre[m][bj][1] = *(const f32x4*)(base + off + 4); }
            asm volatile("" ::: "memory");
#pragma unroll
            for (int m = 0; m < 4; ++m) {
                float ss = 0.f;
#pragma unroll
                for (int bj = 0; bj < 2; ++bj) {
                    const size_t off = (size_t)(row0 + ai * HALF + m * 16) * DM + col0 + bj * HALF;
                    const f32x4 v0 = pre[m][bj][0] + acc[ai][bj][m][0], v1 = pre[m][bj][1] + acc[ai][bj][m][1];
                    *(f32x4*)(out + off) = v0; *(f32x4*)(out + off + 4) = v1;
                    if (xn) {
                        u32x4 w; w.x = pk2(v0[0], v0[1]); w.y = pk2(v0[2], v0[3]); w.z = pk2(v1[0], v1[1]); w.w = pk2(v1[2], v1[3]);
                        *(u32x4*)(xn + off) = w;
                        ss += (v0[0] * v0[0] + v0[1] * v0[1]) + (v0[2] * v0[2] + v0[3] * v0[3]) + (v1[0] * v1[0] + v1[1] * v1[1]) + (v1[2] * v1[2] + v1[3] * v1[3]);
                    }
                }
                if (xn) { ss += __shfl_xor(ss, 16); ss += __shfl_xor(ss, 32); if (fq == 0) rowsq[(size_t)(row0 + ai * HALF + m * 16) * 16 + u.pn * 4 + wc] = ss; }
            }
        }
    }
};

template <class Epi, class Sched, bool ALIGN_EPI = false, bool SP2 = false, bool AGM = false>
__device__ __forceinline__ void gemm_phase(LAS unsigned char* lds, const Gemm g, const Sched& S, const Epi& E) {
    const int tid = tid_l(), wid = __builtin_amdgcn_readfirstlane(tid >> 6), lane = tid & 63, wr = wid >> 2, wc = wid & 3, fr = lane & 15, fq = lane >> 4;
    const int K = g.K, nt = K / BK;
    unsigned voffA[2], voffB[2];
#pragma unroll
    for (int i = 0; i < 2; ++i) { int R, C; stage_rc(tid * 16 + i * 8192, R, C); const int Rb = Epi::PERM ? ((R & ~31) + perm32(R & 31)) : R;
        voffA[i] = AGM ? (unsigned)(((C >> 4) * M_ROWS + R) * 16 + (C & 15)) * 2u : (unsigned)(R * K + C) * 2u; voffB[i] = (unsigned)(Rb * K + C) * 2u; }
    const size_t kstep = (size_t)(BK * 2);
    const size_t hstep = (size_t)HALF * K * 2;
    const size_t tstep = 2 * hstep;
    const size_t kstepA = AGM ? (size_t)4 * M_ROWS * 32 : kstep, hstepA = AGM ? (size_t)HALF * 32 : hstep, tstepA = 2 * hstepA;
    const unsigned ldsw = (unsigned)wid * 1024u;
    const int aoff = lds_byte(wr * 64 + fr, fq * 8), boff = lds_byte(wc * 32 + fr, fq * 8);
#define PG8_SA(b, h) (((b) * 2 + (h)) * HTB)
#define PG8_SB(b, h) ((4 + (b) * 2 + (h)) * HTB)
#define PG8_STAGE(bufoff, gbase, voff) do { _Pragma("unroll") for (int _i = 0; _i < 2; ++_i) \
        __builtin_amdgcn_global_load_lds((const unsigned*)((const char*)(gbase) + (voff)[_i]), (LAS unsigned*)(lds + (bufoff) + ldsw + _i * 8192), 16, 0, 0); } while (0)
#define PG8_LDA(dst, b, h) do { _Pragma("unroll") for (int m = 0; m < 4; ++m) _Pragma("unroll") for (int k = 0; k < 2; ++k) dst[m][k] = *(const LAS bf16x8*)(lds + PG8_SA(b, h) + aoff + m * 2048 + k * 1024); } while (0)
#define PG8_LDB(dst, b, h) do { _Pragma("unroll") for (int n = 0; n < 2; ++n) _Pragma("unroll") for (int k = 0; k < 2; ++k) dst[n][k] = *(const LAS bf16x8*)(lds + PG8_SB(b, h) + boff + n * 2048 + k * 1024); } while (0)
#define PG8_MMA(ai, bj, At, Bt) do { __builtin_amdgcn_s_setprio(1); _Pragma("unroll") for (int m = 0; m < 4; ++m) _Pragma("unroll") for (int n = 0; n < 2; ++n) _Pragma("unroll") for (int k = 0; k < 2; ++k) \
        acc[ai][bj][m][n] = __builtin_amdgcn_mfma_f32_16x16x32_bf16(Bt[n][k], At[m][k], acc[ai][bj][m][n], 0, 0, 0); __builtin_amdgcn_s_setprio(0); } while (0)
#define PG8_WAIT_V(n) asm volatile("s_waitcnt vmcnt(" #n ")" ::: "memory")
#define PG8_WAIT_L(n) asm volatile("s_waitcnt lgkmcnt(" #n ")" ::: "memory")
#define PG8_BAR __builtin_amdgcn_s_barrier()
#define PG8_SCHED __builtin_amdgcn_sched_barrier(0)
    Unit cur, nxt; int ui = 0;
    if (!S.next(0, cur)) return;
    f32x4 acc[2][2][4][2];
#pragma unroll
    for (int a = 0; a < 2; ++a)
#pragma unroll
        for (int b = 0; b < 2; ++b)
#pragma unroll
            for (int m = 0; m < 4; ++m)
#pragma unroll
                for (int n = 0; n < 2; ++n) acc[a][b][m][n] = (f32x4){0.f, 0.f, 0.f, 0.f};
    bf16x8 At[4][2], B0[2][2], B1[2][2];
    const char* cA = (const char*)g.A + (size_t)cur.pm * tstepA; const char* cB = (const char*)g.Bt + (size_t)cur.pn * tstep;
    S.a_ready(cur);
    if constexpr (SP2) {
        PG8_STAGE(PG8_SB(0, 0), cB, voffB); PG8_STAGE(PG8_SB(0, 1), cB + hstep, voffB); PG8_STAGE(PG8_SA(0, 0), cA, voffA); PG8_STAGE(PG8_SA(0, 1), cA + hstepA, voffA);
        if (wr == 1) PG8_BAR;
        PG8_WAIT_V(2); PG8_BAR;
        PG8_STAGE(PG8_SB(1, 0), cB + kstep, voffB); PG8_STAGE(PG8_SA(1, 0), cA + kstepA, voffA); PG8_STAGE(PG8_SB(1, 1), cB + hstep + kstep, voffB);
        PG8_WAIT_V(6); PG8_BAR;
    } else {
        PG8_STAGE(PG8_SB(0, 0), cB, voffB); PG8_STAGE(PG8_SA(0, 0), cA, voffA); PG8_STAGE(PG8_SB(0, 1), cB + hstep, voffB); PG8_STAGE(PG8_SA(0, 1), cA + hstepA, voffA);
        if (wr == 1) PG8_BAR;
        PG8_WAIT_V(4); PG8_BAR;
        PG8_STAGE(PG8_SB(1, 0), cB + kstep, voffB); PG8_STAGE(PG8_SA(1, 0), cA + kstepA, voffA); PG8_STAGE(PG8_SB(1, 1), cB + hstep + kstep, voffB);
        PG8_WAIT_V(6); PG8_BAR;
    }
    for (;;) {
        const bool has_next = S.next(ui + 1, nxt);
        const char* nA = has_next ? (const char*)g.A + (size_t)nxt.pm * tstepA : cA; const char* nB = has_next ? (const char*)g.Bt + (size_t)nxt.pn * tstep : cB;
        for (int t = 0; t < nt; t += 2) {
            const bool last = (t == nt - 2);
            const char* a1 = cA + (size_t)(t + 1) * kstepA;
            const char* a2 = last ? nA : cA + (size_t)(t + 2) * kstepA; const char* b2 = last ? nB : cB + (size_t)(t + 2) * kstep;
            const char* a3 = a2 + kstepA; const char* b3 = b2 + kstep;
            if (last && has_next) S.a_ready(nxt);
            if constexpr (SP2) {
            PG8_LDB(B0, 0, 0); PG8_LDB(B1, 0, 1); PG8_SCHED; PG8_LDA(At, 0, 0); PG8_STAGE(PG8_SA(1, 1), a1 + hstepA, voffA);
            PG8_WAIT_V(8); PG8_WAIT_L(0); PG8_BAR; PG8_MMA(0, 0, At, B0); PG8_MMA(0, 1, At, B1); PG8_BAR; PG8_SCHED;
            PG8_LDA(At, 0, 1); PG8_STAGE(PG8_SB(0, 0), b2, voffB); PG8_STAGE(PG8_SB(0, 1), b2 + hstep, voffB); PG8_STAGE(PG8_SA(0, 0), a2, voffA);
            PG8_WAIT_V(8); PG8_WAIT_L(0); PG8_BAR; PG8_MMA(1, 0, At, B0); PG8_MMA(1, 1, At, B1); PG8_BAR; PG8_SCHED;
            PG8_LDB(B0, 1, 0); PG8_LDB(B1, 1, 1); PG8_SCHED; PG8_LDA(At, 1, 0); PG8_STAGE(PG8_SA(0, 1), a2 + hstepA, voffA);
            PG8_WAIT_V(8); PG8_WAIT_L(0); PG8_BAR; PG8_MMA(0, 0, At, B0); PG8_MMA(0, 1, At, B1); PG8_BAR; PG8_SCHED;
            PG8_LDA(At, 1, 1); PG8_STAGE(PG8_SB(1, 0), b3, voffB); PG8_STAGE(PG8_SB(1, 1), b3 + hstep, voffB); PG8_STAGE(PG8_SA(1, 0), a3, voffA);
            PG8_WAIT_V(8); PG8_WAIT_L(0); PG8_BAR; PG8_MMA(1, 0, At, B0); PG8_MMA(1, 1, At, B1); PG8_BAR; PG8_SCHED;
            } else {
            PG8_LDB(B0, 0, 0); PG8_SCHED; PG8_LDA(At, 0, 0); PG8_STAGE(PG8_SA(1, 1), a1 + hstepA, voffA);
            PG8_WAIT_L(8); PG8_BAR; PG8_WAIT_L(0); PG8_MMA(0, 0, At, B0); PG8_BAR; PG8_SCHED;
            PG8_LDB(B1, 0, 1); PG8_STAGE(PG8_SB(0, 0), b2, voffB);
            PG8_BAR; PG8_WAIT_L(0); PG8_MMA(0, 1, At, B1); PG8_BAR;
            PG8_LDA(At, 0, 1); PG8_STAGE(PG8_SA(0, 0), a2, voffA);
            PG8_BAR; PG8_WAIT_L(0); PG8_MMA(1, 0, At, B0); PG8_BAR; PG8_SCHED;
            PG8_STAGE(PG8_SB(0, 1), b2 + hstep, voffB);
            PG8_WAIT_V(6); PG8_BAR; PG8_MMA(1, 1, At, B1); PG8_BAR;
            PG8_LDB(B0, 1, 0); PG8_SCHED; PG8_LDA(At, 1, 0); PG8_STAGE(PG8_SA(0, 1), a2 + hstepA, voffA);
            PG8_WAIT_L(8); PG8_BAR; PG8_WAIT_L(0); PG8_MMA(0, 0, At, B0); PG8_BAR; PG8_SCHED;
            PG8_LDB(B1, 1, 1); PG8_STAGE(PG8_SB(1, 0), b3, voffB);
            PG8_BAR; PG8_WAIT_L(0); PG8_MMA(0, 1, At, B1); PG8_BAR;
            PG8_LDA(At, 1, 1); PG8_STAGE(PG8_SA(1, 0), a3, voffA);
            PG8_BAR; PG8_WAIT_L(0); PG8_MMA(1, 0, At, B0); PG8_BAR; PG8_SCHED;
            PG8_STAGE(PG8_SB(1, 1), b3 + hstep, voffB);
            PG8_WAIT_V(6); PG8_BAR; PG8_MMA(1, 1, At, B1); PG8_BAR;
            }
        }
        if constexpr (ALIGN_EPI) { if (wr == 0) PG8_BAR; }
        if constexpr (!Epi::AFTER_DRAIN) { E(acc, cur, wr, wc, fr, fq); S.done(cur); }
        if (!has_next) break;
#pragma unroll
        for (int a = 0; a < 2; ++a)
#pragma unroll
            for (int b = 0; b < 2; ++b)
#pragma unroll
                for (int m = 0; m < 4; ++m)
#pragma unroll
                    for (int n = 0; n < 2; ++n) acc[a][b][m][n] = (f32x4){0.f, 0.f, 0.f, 0.f};
        cur = nxt; cA = nA; cB = nB; ++ui;
        if constexpr (ALIGN_EPI) { if (wr == 1) PG8_BAR; }
    }
    PG8_WAIT_V(0);
    if constexpr (!ALIGN_EPI) { if (wr == 0) PG8_BAR; }
    PG8_BAR;
#undef PG8_SA
#undef PG8_SB
#undef PG8_STAGE
#undef PG8_LDA
#undef PG8_LDB
#undef PG8_MMA
#undef PG8_WAIT_V
#undef PG8_WAIT_L
#undef PG8_BAR
#undef PG8_SCHED
}
}

struct Args { const float* in[18]; float* out; unsigned char* ws; };
typedef const __attribute__((address_space(4))) Args* ArgsP;
__device__ __forceinline__ ArgsP launder(ArgsP p) { asm volatile("" : "+s"(p)); return p; }

#define MFMA16(a, b, c) __builtin_amdgcn_mfma_f32_16x16x32_bf16((a), (b), (c), 0, 0, 0)
#define MFMA32(a, b, c) __builtin_amdgcn_mfma_f32_32x32x16_bf16((a), (b), (c), 0, 0, 0)

__device__ __forceinline__ float wave_sum(float v) {
#pragma unroll
    for (int o = 1; o < 64; o <<= 1) v += __shfl_xor(v, o);
    return v;
}

__device__ __forceinline__ int head_perm(int x) { const int pos = x & 127; return (x & ~127) + (pos & 3) * 32 + (pos >> 2); }
template <int MODE, bool GAIN>
__device__ __forceinline__ void transpose_item(const float* W, int K, int N, bf16_t* WT, float* scr, int item, int lane, const float* gain = nullptr) {
    const int nblk = N / 32, kb = item / nblk, nb = item % nblk, k0 = 64 * kb, n0 = 32 * nb;
#pragma unroll 8
    for (int i = 0; i < 32; ++i) { const int kk = 2 * i + (lane >> 5); int sk = k0 + kk, sn = n0 + (lane & 31);
        if (MODE == 1 && sn >= 3072) sn = head_perm(sn);
        if (MODE == 2) sk = head_perm(sk);
        scr[kk * 33 + (lane & 31)] = W[(size_t)sk * N + sn] * (GAIN ? gain[sk] : 1.f); }
    __builtin_amdgcn_wave_barrier(); asm volatile("s_waitcnt lgkmcnt(0)" ::: "memory");
    const int c = lane & 7;
#pragma unroll
    for (int j = 0; j < 4; ++j) { const int n = (lane >> 3) + 8 * j; const float* s = scr + (8 * c) * 33 + n;
        u32x4 o; o.x = pk2(s[0 * 33], s[1 * 33]); o.y = pk2(s[2 * 33], s[3 * 33]); o.z = pk2(s[4 * 33], s[5 * 33]); o.w = pk2(s[6 * 33], s[7 * 33]);
        *(u32x4*)(WT + (size_t)(n0 + n) * K + k0 + 8 * c) = o; }
    asm volatile("s_waitcnt lgkmcnt(0)" ::: "memory"); __builtin_amdgcn_wave_barrier();
}

__device__ __forceinline__ void ssm_tables(ArgsP a, int j, int g, unsigned char* smem, unsigned char* tab) {
    float* Epow = (float*)smem;
    float* Bb = Epow + 17 * 64 * 2;
    float* Cc = Bb + 64 * 16 * 2;
    float* Fp = Cc + 16 * 64 * 2;
    float* Km = Fp + 128;
    const int tid = tid_l();
    const float* a_re = a->in[3] + (size_t)(j * 64 + g) * 64; const float* a_im = a->in[4] + (size_t)(j * 64 + g) * 64;
    const float* b_re = a->in[6] + (size_t)(j * 64 + g) * 64 * 16; const float* b_im = a->in[7] + (size_t)(j * 64 + g) * 64 * 16;
    const float* c_re = a->in[8] + (size_t)(j * 64 + g) * 16 * 64; const float* c_im = a->in[9] + (size_t)(j * 64 + g) * 16 * 64;
    { const float* ep = (const float*)(a->ws + WS_EP) + (size_t)(j * 64 + g) * EP_STRIDE;
      for (int e = tid; e < 17 * 64 * 2; e += 512) Epow[e] = ep[e];
      if (tid < 128) Fp[tid] = ep[18 * 128 + tid]; }
    __syncthreads();
    for (int e = tid; e < 1024; e += 512) {
        { const int p = e >> 4; const float fr_ = Fp[p * 2], fi_ = Fp[p * 2 + 1], br = b_re[e], bi = b_im[e];
          Bb[e * 2] = fr_ * br - fi_ * bi; Bb[e * 2 + 1] = fr_ * bi + fi_ * br; }
        Cc[e * 2] = c_re[e]; Cc[e * 2 + 1] = c_im[e];
    }
    __syncthreads();
    for (int e = tid; e < 4096; e += 512) {
        const int d = e >> 8, c = (e >> 4) & 15, c2 = e & 15; float acc = 0.f;
        for (int p = 0; p < 64; ++p) {
            const float ar = Epow[(d * 64 + p) * 2], ai = Epow[(d * 64 + p) * 2 + 1], br = Bb[(p * 16 + c2) * 2], bi = Bb[(p * 16 + c2) * 2 + 1];
            const float gr = ar * br - ai * bi, gi = ar * bi + ai * br;
            acc += Cc[(c * 64 + p) * 2] * gr - Cc[(c * 64 + p) * 2 + 1] * gi;
        }
        Km[e] = acc;
    }
    __syncthreads();
    for (int e = tid; e < 16 * 64; e += 512) {
        const int d = e >> 6, l = e & 63, c = l & 15, ts = l >> 5, c0 = ((l >> 4) & 1) * 8, dd = d - ts; float v[8];
#pragma unroll
        for (int jj = 0; jj < 8; ++jj) v[jj] = dd >= 0 ? Km[(dd * 16 + c) * 16 + c0 + jj] : 0.f;
        u32x4 w; w.x = pk2(v[0], v[1]); w.y = pk2(v[2], v[3]); w.z = pk2(v[4], v[5]); w.w = pk2(v[6], v[7]);
        *(u32x4*)(tab + d * 1024 + l * 16) = w;
    }
    for (int e = tid; e < 64 * 64; e += 512) {
        const int f = e >> 6, l = e & 63, mt = f >> 3, ks = f & 7, m = mt * 16 + (l & 15), p = m >> 1, ri = m & 1, tau = ks * 2 + (l >> 5), c0 = ((l >> 4) & 1) * 8;
        const float ar = Epow[((15 - tau) * 64 + p) * 2], ai = Epow[((15 - tau) * 64 + p) * 2 + 1]; float v[8];
#pragma unroll
        for (int jj = 0; jj < 8; ++jj) { const float br = Bb[(p * 16 + c0 + jj) * 2], bi = Bb[(p * 16 + c0 + jj) * 2 + 1]; v[jj] = ri == 0 ? (ar * br - ai * bi) : (ar * bi + ai * br); }
        u32x4 w; w.x = pk2(v[0], v[1]); w.y = pk2(v[2], v[3]); w.z = pk2(v[4], v[5]); w.w = pk2(v[6], v[7]);
        *(u32x4*)(tab + 16384 + f * 1024 + l * 16) = w;
    }
    for (int e = tid; e < 64 * 64; e += 512) {
        const int f = e >> 6, l = e & 63, t = f >> 2, kk = f & 3, c = l & 15, m0 = kk * 32 + (l >> 4) * 8; float v[8];
#pragma unroll
        for (int jj = 0; jj < 8; ++jj) { const int m = m0 + jj, p = m >> 1, ri = m & 1;
            const float ar = Epow[((t + 1) * 64 + p) * 2], ai = Epow[((t + 1) * 64 + p) * 2 + 1], cr = Cc[(c * 64 + p) * 2], ci = Cc[(c * 64 + p) * 2 + 1];
            v[jj] = ri == 0 ? (cr * ar - ci * ai) : -(cr * ai + ci * ar); }
        u32x4 w; w.x = pk2(v[0], v[1]); w.y = pk2(v[2], v[3]); w.z = pk2(v[4], v[5]); w.w = pk2(v[6], v[7]);
        *(u32x4*)(tab + 16384 + 65536 + f * 1024 + l * 16) = w;
    }
    __syncthreads();
}

__device__ __forceinline__ void pre0_phase(ArgsP a) {
    const int tid = tid_l(), G = sg_l(gridDim.x), bid = sg_l(blockIdx.x);
    unsigned char* ws = a->ws;
    float* rope = (float*)(ws + WS_ROPE);
    for (int e = bid * 512 + tid; e < L * 16; e += G * 512) {
        const int pos = e >> 4, i = e & 15;
        const double invf = exp(-(double)i * (1.0 / 16.0) * 13.122363377404328);
        double ang = (double)pos * invf; ang -= 6.283185307179586476925 * floor(ang / 6.283185307179586476925);
        rope[e * 2] = (float)cos(ang); rope[e * 2 + 1] = (float)sin(ang);
    }
    float* epb = (float*)(ws + WS_EP);
    for (int e = bid * 512 + tid; e < 2 * 64 * 19 * 64; e += G * 512) {
        const int p = e & 63, n = (e >> 6) % 19, jg = (e >> 6) / 19;
        const double dt = exp((double)a->in[5][jg]);
        const double lr = (double)a->in[3][(size_t)jg * 64 + p], li = (double)a->in[4][(size_t)jg * 64 + p];
        const double pw = n <= 16 ? (double)n : (n == 17 ? 512.0 : 1.0);
        const double mag = exp(lr * dt * pw); double ang = li * dt * pw; ang -= 6.283185307179586476925 * floor(ang / 6.283185307179586476925);
        double cr = cos(ang) * mag, ci = sin(ang) * mag;
        if (n == 18) { const double nr = cr - 1.0, ni = ci, den = lr * lr + li * li; cr = (nr * lr + ni * li) / den; ci = (ni * lr - nr * li) / den; }
        epb[(size_t)jg * EP_STRIDE + (n * 64 + p) * 2] = (float)cr; epb[(size_t)jg * EP_STRIDE + (n * 64 + p) * 2 + 1] = (float)ci;
    }
}
__device__ __forceinline__ void prep_phase(ArgsP a, int layer, const float* h, unsigned char* smem) {
    const int tid = tid_l(), lane = tid & 63, wave = tid >> 6, G = sg_l(gridDim.x), bid = sg_l(blockIdx.x);
    unsigned char* ws = a->ws;
    const int j = layer >> 1;
    if ((layer & 1) == 0) {
        for (int g = bid; g < 64; g += G) ssm_tables(a, j, g, smem, ws + WS_TAB + (size_t)g * TAB_STRIDE);
    }
    __syncthreads();
    float* scr = (float*)(smem + wave * 16384);
    const int gw = bid * 8 + wave, NGW = G * 8;
    bf16_t* Wb = (bf16_t*)(ws + WS_W);
    const float* gain = a->in[1] + layer * 1024;
    if ((layer & 1) == 0) {
        const float* w_in = a->in[2] + (size_t)j * 1024 * 2048; const float* w_glu = a->in[11] + (size_t)j * 1024 * 1024; const float* w_out = a->in[13] + (size_t)j * 1024 * 1024;
        for (int it = gw; it < 2048; it += NGW) {
            if (it < 1024) transpose_item<0, true>(w_in, 1024, 2048, Wb, scr, it, lane, gain);
            else if (it < 1536) transpose_item<0, false>(w_glu, 1024, 1024, Wb + 2048 * 1024, scr, it - 1024, lane);
            else transpose_item<0, false>(w_out, 1024, 1024, Wb + 4096 * 1024, scr, it - 1536, lane);
        }
    } else {
        const float* w_in = a->in[14] + (size_t)j * 1024 * 4096; const float* w_out = a->in[17] + (size_t)j * 1024 * 1024;
        for (int it = gw; it < 2560; it += NGW) {
            if (it < 2048) transpose_item<1, true>(w_in, 1024, 4096, Wb, scr, it, lane, gain);
            else transpose_item<2, false>(w_out, 1024, 1024, (bf16_t*)(ws + WS_W2), scr, it - 2048, lane);
        }
    }
    if (layer == 0) {
        bf16_t* XN = (bf16_t*)(ws + WS_XN); float* rowsq = (float*)(ws + WS_ROWSQ);
        for (int m = gw; m < L; m += NGW) {
            const f32x4* xr = (const f32x4*)(h + (size_t)m * DM) + lane;
            f32x4 v[4]; float s = 0.f;
#pragma unroll
            for (int q = 0; q < 4; ++q) { v[q] = xr[64 * q]; s += (v[q].x * v[q].x + v[q].y * v[q].y) + (v[q].z * v[q].z + v[q].w * v[q].w); }
            s = wave_sum(s);
            if (lane < 16) rowsq[(size_t)m * 16 + lane] = lane == 0 ? s : 0.f;
            u32x2* o8 = (u32x2*)(XN + (size_t)m * DM) + lane;
#pragma unroll
            for (int q = 0; q < 4; ++q) { u32x2 w; w.x = pk2(v[q].x, v[q].y); w.y = pk2(v[q].z, v[q].w); o8[64 * q] = w; }
        }
    }
}

__device__ __forceinline__ void ssm_s1(ArgsP a, unsigned char* smem) {
    const int tid = tid_l(), lane = tid & 63, wave = tid >> 6, G = sg_l(gridDim.x);
    unsigned char* ws = a->ws;
    const bf16_t* U = (const bf16_t*)(ws + WS_U); float* SL = (float*)(ws + WS_SLOC);
    for (int unit = sg_l(blockIdx.x); unit < 256; unit += G) {
        const int g = unit >> 2, qtr = unit & 3;
        __syncthreads();
        { const u32x4* src = (const u32x4*)(ws + WS_TAB + (size_t)g * TAB_STRIDE + 16384); u32x4* dst = (u32x4*)smem; u32x4 tr[8];
#pragma unroll
          for (int i = 0; i < 8; ++i) tr[i] = src[tid + i * 512];
#pragma unroll
          for (int i = 0; i < 8; ++i) dst[tid + i * 512] = tr[i]; }
        __syncthreads();
#pragma unroll 1
        for (int nt = 0; nt < 2; ++nt) {
            const int chunk0 = qtr * 256 + wave * 32 + nt * 16, n = lane & 15;
            bf16x8 B[8];
#pragma unroll
            for (int ks = 0; ks < 8; ++ks) B[ks] = *(const bf16x8*)(U + ((size_t)g * L + (chunk0 + n) * 16 + ks * 2 + (lane >> 5)) * 16 + ((lane >> 4) & 1) * 8);
#pragma unroll
            for (int mt = 0; mt < 8; ++mt) {
                f32x4 acc = {0.f, 0.f, 0.f, 0.f};
#pragma unroll
                for (int ks = 0; ks < 8; ++ks) { const bf16x8 A = *(const bf16x8*)(smem + (mt * 8 + ks) * 1024 + lane * 16); acc = MFMA16(A, B[ks], acc); }
                *(f32x4*)(SL + ((size_t)(chunk0 + n) * 64 + g) * 128 + mt * 16 + (lane >> 4) * 4) = acc;
                asm volatile("" ::: "memory");
            }
        }
    }
}
__device__ __forceinline__ void ssm_s2(ArgsP a, int j, unsigned char* smem) {
    const int tid = tid_l(), G = sg_l(gridDim.x);
    unsigned char* ws = a->ws;
    const float* SL = (const float*)(ws + WS_SLOC); unsigned* SIN = (unsigned*)(ws + WS_SIN);
    float* ex = (float*)smem;
    for (int unit = sg_l(blockIdx.x); unit < 256; unit += G) {
        const int seg = tid >> 4, sl = tid & 15, st = unit * 16 + sl, g = st >> 6, p = st & 63;
        const float* ep = (const float*)(ws + WS_EP) + (size_t)(j * 64 + g) * EP_STRIDE;
        const float e16r = ep[(16 * 64 + p) * 2], e16i = ep[(16 * 64 + p) * 2 + 1], eSr = ep[(17 * 64 + p) * 2], eSi = ep[(17 * 64 + p) * 2 + 1];
        const float* src = SL + ((size_t)(seg * 32) * 64 + g) * 128 + 2 * p;
        f32x2 v[32];
#pragma unroll
        for (int i = 0; i < 32; ++i) v[i] = *(const f32x2*)(src + (size_t)i * 8192);
        float sr = 0.f, si = 0.f;
#pragma unroll
        for (int i = 0; i < 32; ++i) { const float nr = e16r * sr - e16i * si + v[i].x, ni = e16r * si + e16i * sr + v[i].y; sr = nr; si = ni; }
        __syncthreads();
        ex[(seg * 16 + sl) * 2] = sr; ex[(seg * 16 + sl) * 2 + 1] = si;
        __syncthreads();
        float cr = 0.f, ci = 0.f;
        for (int s = 0; s < seg; ++s) { const float xr = ex[(s * 16 + sl) * 2], xi = ex[(s * 16 + sl) * 2 + 1]; const float nr = eSr * cr - eSi * ci + xr, ni = eSr * ci + eSi * cr + xi; cr = nr; ci = ni; }
        unsigned* dst = SIN + ((size_t)(seg * 32) * 64 + g) * 64 + p;
#pragma unroll
        for (int i = 0; i < 32; ++i) {
            dst[(size_t)i * 4096] = pk2(cr, ci);
            const float nr = e16r * cr - e16i * ci + v[i].x, ni = e16r * ci + e16i * cr + v[i].y; cr = nr; ci = ni;
        }
    }
}
__device__ __forceinline__ void ssm_s3(ArgsP a, int j, unsigned char* smem) {
    const int tid = tid_l(), lane = tid & 63, wave = tid >> 6, G = sg_l(gridDim.x);
    unsigned char* ws = a->ws;
    const bf16_t* U = (const bf16_t*)(ws + WS_U); const bf16_t* SIN = (const bf16_t*)(ws + WS_SIN); bf16_t* YG = (bf16_t*)(ws + WS_YG);
    const float* dsk = a->in[10] + j * 1024;
    for (int unit = sg_l(blockIdx.x); unit < 256; unit += G) {
        const int g = unit >> 2, qtr = unit & 3;
        __syncthreads();
        { const u32x4* srcF = (const u32x4*)(ws + WS_TAB + (size_t)g * TAB_STRIDE); u32x4* dst = (u32x4*)smem;
          const u32x4* srcC = (const u32x4*)(ws + WS_TAB + (size_t)g * TAB_STRIDE + 16384 + 65536); u32x4 tr[10];
#pragma unroll
          for (int i = 0; i < 2; ++i) tr[i] = srcF[tid + i * 512];
#pragma unroll
          for (int i = 0; i < 8; ++i) tr[2 + i] = srcC[tid + i * 512];
#pragma unroll
          for (int i = 0; i < 2; ++i) dst[tid + i * 512] = tr[i];
#pragma unroll
          for (int i = 0; i < 8; ++i) dst[1024 + tid + i * 512] = tr[2 + i]; }
        __syncthreads();
        const unsigned char* Fl = smem; const unsigned char* Wl = smem + 16384;
        const int n = lane & 15, cq = (lane >> 4) * 4;
        const f32x4 dv = *(const f32x4*)(dsk + g * 16 + cq);
#pragma unroll 1
        for (int nt = 0; nt < 2; ++nt) {
            const int chunk = qtr * 256 + wave * 32 + nt * 16 + n;
            bf16x8 Bu[8], Bs[4];
#pragma unroll
            for (int ks = 0; ks < 8; ++ks) Bu[ks] = *(const bf16x8*)(U + ((size_t)g * L + chunk * 16 + ks * 2 + (lane >> 5)) * 16 + ((lane >> 4) & 1) * 8);
#pragma unroll
            for (int kk = 0; kk < 4; ++kk) Bs[kk] = *(const bf16x8*)(SIN + ((size_t)chunk * 64 + g) * 128 + kk * 32 + (lane >> 4) * 8);
            u32x2 uvv[16];
#pragma unroll
            for (int t = 0; t < 16; ++t) uvv[t] = *(const u32x2*)(U + ((size_t)g * L + chunk * 16 + t) * 16 + cq);
#pragma unroll
            for (int t = 0; t < 16; ++t) {
                f32x4 acc = {0.f, 0.f, 0.f, 0.f};
#pragma unroll
                for (int i = 0; i <= t / 2; ++i) { const bf16x8 A = *(const bf16x8*)(Fl + (t - 2 * i) * 1024 + lane * 16); acc = MFMA16(A, Bu[i], acc); }
#pragma unroll
                for (int kk = 0; kk < 4; ++kk) { const bf16x8 A = *(const bf16x8*)(Wl + (t * 4 + kk) * 1024 + lane * 16); acc = MFMA16(A, Bs[kk], acc); }
                const size_t off = ((size_t)g * L + chunk * 16 + t) * 16 + cq;
                const u32x2 uv = uvv[t];
                const float y0 = gelu_tanh(acc[0] + dv[0] * bflo(uv.x)), y1 = gelu_tanh(acc[1] + dv[1] * bfhi(uv.x));
                const float y2 = gelu_tanh(acc[2] + dv[2] * bflo(uv.y)), y3 = gelu_tanh(acc[3] + dv[3] * bfhi(uv.y));
                u32x2 w; w.x = pk2(y0, y1); w.y = pk2(y2, y3);
                *(u32x2*)(YG + off) = w;
                asm volatile("" ::: "memory");
            }
        }
    }
}

constexpr int QK_STRIDE = 4096;
constexpr int KL_STRIDE = 272, VL_STRIDE = 520, VT_OFF = 256 * KL_STRIDE;

__device__ __forceinline__ void attn_a1(ArgsP a, int j, unsigned char* smem, int dry) {
    const int tid = tid_l(), G = sg_l(gridDim.x);
    unsigned char* ws = a->ws;
    bf16_t* QKVZ = (bf16_t*)(ws + WS_BIG); const float* rope = (const float*)(ws + WS_ROPE); float* kmean = (float*)(ws + WS_KMEAN);
    if (sg_l(blockIdx.x) == 0) ((unsigned*)(ws + WS_CTL))[tid] = 0u;
    const int seg = tid & 15, rg = tid >> 4;
    const float* qg = a->in[15] + j * 128 + seg * 8; const float* kg = a->in[16] + j * 128 + seg * 8;
    float gq[8], gk[8];
#pragma unroll
    for (int i = 0; i < 8; ++i) { gq[i] = qg[i] * (0.08838834764831845f * 1.4426950408889634f); gk[i] = kg[i]; }
    float* red = (float*)(smem + 72 * 1024);
    for (int unit = sg_l(blockIdx.x); unit < 512; unit += G) {
        const int h = unit & 7, b = unit >> 3;
        float ksum[8];
#pragma unroll
        for (int i = 0; i < 8; ++i) ksum[i] = 0.f;
        __syncthreads();
#pragma unroll 1
        for (int pb = 0; pb < 2; ++pb) {
            u32x4 rq[4], rk[4], rv[4]; f32x2 rp[4][8];
#pragma unroll
            for (int p4 = 0; p4 < 4; ++p4) {
                const int t = b * 256 + (pb * 4 + p4) * 32 + rg;
                const bf16_t* p = QKVZ + (size_t)t * QK_STRIDE + h * 128 + seg * 8;
                rq[p4] = *(const u32x4*)p; rk[p4] = *(const u32x4*)(p + 1024); rv[p4] = *(const u32x4*)(p + 2048);
#pragma unroll
                for (int i = 0; i < 8; ++i) rp[p4][i] = *(const f32x2*)(rope + ((size_t)t * 16 + (seg & 1) * 8 + i) * 2);
            }
#pragma unroll
            for (int p4 = 0; p4 < 4; ++p4) {
                const int ps = pb * 4 + p4, t = b * 256 + ps * 32 + rg;
#pragma unroll
                for (int which = 0; which < 2; ++which) {
                    bf16_t* p = QKVZ + (size_t)t * QK_STRIDE + which * 1024 + h * 128 + seg * 8;
                    const u32x4 raw = which == 0 ? rq[p4] : rk[p4];
                    float x[8];
#pragma unroll
                    for (int q = 0; q < 4; ++q) { x[2 * q] = bflo(raw[q]); x[2 * q + 1] = bfhi(raw[q]); }
                    float ss = 0.f;
#pragma unroll
                    for (int i = 0; i < 8; ++i) ss += x[i] * x[i];
                    ss += __shfl_xor(ss, 1); ss += __shfl_xor(ss, 2); ss += __shfl_xor(ss, 4); ss += __shfl_xor(ss, 8);
                    const float rstd = rsqrtf(ss * (1.f / 128.f) + NORM_EPS);
#pragma unroll
                    for (int i = 0; i < 8; ++i) x[i] = x[i] * rstd * (which == 0 ? gq[i] : gk[i]);
                    float y[8];
#pragma unroll
                    for (int i = 0; i < 8; ++i) {
                        const float o = __shfl_xor(x[i], 2);
                        y[i] = x[i];
                        if (seg < 2) y[i] = x[i] * rp[p4][i].x - o * rp[p4][i].y;
                        else if (seg < 4) y[i] = x[i] * rp[p4][i].x + o * rp[p4][i].y;
                    }
                    u32x4 w; w.x = pk2(y[0], y[1]); w.y = pk2(y[2], y[3]); w.z = pk2(y[4], y[5]); w.w = pk2(y[6], y[7]);
                    if (!dry) *(u32x4*)p = w;
                    if (which == 1) {
#pragma unroll
                        for (int i = 0; i < 8; ++i) ksum[i] += y[i];
                    }
                }
                { const int key = ps * 32 + rg; *(u32x4*)(smem + key * 256 + ((seg ^ ((key >> 3) & 15)) * 16)) = rv[p4]; }
            }
        }
#pragma unroll
        for (int i = 0; i < 8; ++i) red[rg * 128 + seg * 8 + i] = ksum[i];
        __syncthreads();
        if (tid < 128) { float s = 0.f;
#pragma unroll
            for (int r = 0; r < 32; ++r) s += red[r * 128 + tid];
            if (!dry) kmean[((size_t)h * 64 + b) * 128 + tid] = s * (1.f / 256.f); }
        for (int e = tid; e < 4096; e += 512) {
            const int ko = e & 31, d = e >> 5, key0 = ko * 8;
            unsigned short v[8];
#pragma unroll
            for (int i = 0; i < 8; ++i) v[i] = *(const unsigned short*)(smem + (key0 + i) * 256 + (((d >> 3) ^ (ko & 15)) * 16) + (d & 7) * 2);
            u32x4 w; w.x = v[0] | ((unsigned)v[1] << 16); w.y = v[2] | ((unsigned)v[3] << 16); w.z = v[4] | ((unsigned)v[5] << 16); w.w = v[6] | ((unsigned)v[7] << 16);
            if (!dry) *(u32x4*)(QKVZ + (size_t)(b * 256 + 2 * d + (key0 >> 7)) * QK_STRIDE + 2048 + h * 128 + (key0 & 127)) = w;
        }
    }
}

__device__ __forceinline__ bool gate_better(float v, int i, float w, int k) { return v > w || (v == w && i < k); }
#define TOP3_INSERT(s_, n_) do { const float _s = (s_); const int _n = (n_); \
    const bool _b1 = gate_better(_s, _n, v1, i1), _b2 = gate_better(_s, _n, v2, i2), _b3 = gate_better(_s, _n, v3, i3); \
    const float _nv3 = _b2 ? v2 : (_b3 ? _s : v3); const int _ni3 = _b2 ? i2 : (_b3 ? _n : i3); \
    const float _nv2 = _b1 ? v1 : (_b2 ? _s : v2); const int _ni2 = _b1 ? i1 : (_b2 ? _n : i2); \
    const float _nv1 = _b1 ? _s : v1; const int _ni1 = _b1 ? _n : i1; \
    v1 = _nv1; i1 = _ni1; v2 = _nv2; i2 = _ni2; v3 = _nv3; i3 = _ni3; } while (0)
__device__ __forceinline__ void attn_a2(ArgsP a, unsigned char* smem, int dry) {
    const int tid = tid_l(), lane = tid & 63, wave = tid >> 6, G = sg_l(gridDim.x), r = lane & 31, hh = lane >> 5;
    unsigned char* ws = a->ws;
    const bf16_t* QKVZ = (const bf16_t*)(ws + WS_BIG); const float* kmean = (const float*)(ws + WS_KMEAN);
    unsigned* cnt = (unsigned*)(ws + WS_CTL); unsigned short* lists = (unsigned short*)(ws + WS_TAB);
    unsigned* cntl = (unsigned*)smem; unsigned* basel = cntl + 64;
    int cur_h = -1;
    bf16x8 Khi[2][8], Klo[2][8];
    for (int unit = sg_l(blockIdx.x); unit < 512; unit += G) {
        const int h = unit & 7, b = unit >> 3;
        if (b == 0) continue;
        if (h != cur_h) {
            cur_h = h;
#pragma unroll
            for (int tl = 0; tl < 2; ++tl)
#pragma unroll
                for (int kk = 0; kk < 8; ++kk) {
                    const float* kp = kmean + ((size_t)h * 64 + tl * 32 + r) * 128 + kk * 16 + hh * 8;
                    const f32x4 x0 = *(const f32x4*)kp, x1 = *(const f32x4*)(kp + 4);
                    u32x4 hi; hi.x = pk2(x0[0], x0[1]); hi.y = pk2(x0[2], x0[3]); hi.z = pk2(x1[0], x1[1]); hi.w = pk2(x1[2], x1[3]);
                    u32x4 lo; lo.x = pk2(x0[0] - bflo(hi.x), x0[1] - bfhi(hi.x)); lo.y = pk2(x0[2] - bflo(hi.y), x0[3] - bfhi(hi.y));
                    lo.z = pk2(x1[0] - bflo(hi.z), x1[1] - bfhi(hi.z)); lo.w = pk2(x1[2] - bflo(hi.w), x1[3] - bfhi(hi.w));
                    Khi[tl][kk] = __builtin_bit_cast(bf16x8, hi); Klo[tl][kk] = __builtin_bit_cast(bf16x8, lo);
                }
        }
        const int t = b * 256 + wave * 32 + r;
        bf16x8 qf[8];
#pragma unroll
        for (int kk = 0; kk < 8; ++kk) qf[kk] = *(const bf16x8*)(QKVZ + (size_t)t * QK_STRIDE + h * 128 + kk * 16 + hh * 8);
        float v1 = -INFINITY, v2 = -INFINITY, v3 = -INFINITY; int i1 = 1 << 20, i2 = 1 << 20, i3 = 1 << 20;
#pragma unroll
        for (int tl = 0; tl < 2; ++tl) {
            if (tl == 1 && b <= 32) break;
            f32x16 Gt;
#pragma unroll
            for (int i = 0; i < 16; ++i) Gt[i] = 0.f;
#pragma unroll
            for (int kk = 0; kk < 8; ++kk) { Gt = MFMA32(Khi[tl][kk], qf[kk], Gt); Gt = MFMA32(Klo[tl][kk], qf[kk], Gt); }
#pragma unroll
            for (int i = 0; i < 16; ++i) { const int n = tl * 32 + (i & 3) + 8 * (i >> 2) + 4 * hh; if (n < b) TOP3_INSERT(Gt[i], n); }
        }
        {
            const float w1 = __shfl_xor(v1, 32), w2 = __shfl_xor(v2, 32), w3 = __shfl_xor(v3, 32);
            const int k1 = __shfl_xor(i1, 32), k2 = __shfl_xor(i2, 32), k3 = __shfl_xor(i3, 32);
            TOP3_INSERT(w1, k1); TOP3_INSERT(w2, k2); TOP3_INSERT(w3, k3);
        }
        __syncthreads();
        if (tid < 64) cntl[tid] = 0u;
        __syncthreads();
        unsigned lp1 = 0u, lp2 = 0u, lp3 = 0u;
        if (hh == 0) {
            if (i1 < 64) lp1 = atomicAdd(&cntl[i1], 1u);
            if (i2 < 64) lp2 = atomicAdd(&cntl[i2], 1u);
            if (i3 < 64) lp3 = atomicAdd(&cntl[i3], 1u);
        }
        __syncthreads();
        if (tid < 64) { const unsigned c = cntl[tid]; basel[tid] = (c && !dry) ? atomicAdd(&cnt[h * 64 + tid], c) : 0u; }
        __syncthreads();
        if (hh == 0 && !dry) {
            unsigned short* lh = lists + (size_t)h * LIST_PER_HEAD;
            if (i1 < 64) lh[list_off(i1) + basel[i1] + lp1] = (unsigned short)(t);
            if (i2 < 64) lh[list_off(i2) + basel[i2] + lp2] = (unsigned short)(t | (1 << 14));
            if (i3 < 64) lh[list_off(i3) + basel[i3] + lp3] = (unsigned short)(t | (2 << 14));
        }
    }
}

__device__ __forceinline__ void load_kv(const bf16_t* QKVZ, int h, int n, unsigned char* smem) {
    const int tid = tid_l();
    u32x4 kr[8], vr[8];
#pragma unroll
    for (int i = 0; i < 8; ++i) { const int e = tid + i * 512, key = e >> 4, pc = e & 15;
        kr[i] = *(const u32x4*)(QKVZ + (size_t)(n * 256 + key) * QK_STRIDE + 1024 + h * 128 + pc * 8); }
#pragma unroll
    for (int i = 0; i < 8; ++i) { const int e = tid + i * 512, d = e >> 5, pc = e & 31, key0 = pc * 8;
        vr[i] = *(const u32x4*)(QKVZ + (size_t)(n * 256 + 2 * d + (key0 >> 7)) * QK_STRIDE + 2048 + h * 128 + (key0 & 127)); }
#pragma unroll
    for (int i = 0; i < 8; ++i) { const int e = tid + i * 512, key = e >> 4, pc = e & 15; *(u32x4*)(smem + key * KL_STRIDE + pc * 16) = kr[i]; }
#pragma unroll
    for (int i = 0; i < 8; ++i) { const int e = tid + i * 512, d = e >> 5, pc = e & 31;
        u32x2* dst = (u32x2*)(smem + VT_OFF + d * VL_STRIDE + pc * 16);
        dst[0] = (u32x2){vr[i].x, vr[i].y}; dst[1] = (u32x2){vr[i].z, vr[i].w}; }
}
__device__ __forceinline__ void attn_core(const unsigned char* smem, const bf16x8 (&qf)[8], int nkt, int mask_kt, int qidx, float c2, f32x16 (&O)[4], float& lsum) {
    const int lane = tid_l() & 63, r = lane & 31, hh = lane >> 5;
    const unsigned char* kbase = smem + r * KL_STRIDE + hh * 16;
    const unsigned char* vbase = smem + VT_OFF + r * VL_STRIDE + hh * 8;
    bf16x8 Kf[8];
#pragma unroll
    for (int kk = 0; kk < 8; ++kk) Kf[kk] = *(const bf16x8*)(kbase + kk * 32);
#pragma unroll 1
    for (int kt = 0; kt < nkt; ++kt) {
        f32x16 S;
#pragma unroll
        for (int i = 0; i < 16; ++i) S[i] = -c2;
#pragma unroll
        for (int kk = 0; kk < 8; ++kk) S = MFMA32(Kf[kk], qf[kk], S);
        s16x4 Vl[2][4], Vh[2][4];
#pragma unroll
        for (int s = 0; s < 2; ++s)
#pragma unroll
            for (int dt = 0; dt < 4; ++dt) { const unsigned char* vp = vbase + dt * 32 * VL_STRIDE + (kt * 32 + 16 * s) * 2; Vl[s][dt] = *(const s16x4*)vp; Vh[s][dt] = *(const s16x4*)(vp + 16); }
        { const int ktn = kt + 1 < nkt ? kt + 1 : kt;
#pragma unroll
          for (int kk = 0; kk < 8; ++kk) Kf[kk] = *(const bf16x8*)(kbase + ktn * 32 * KL_STRIDE + kk * 32); }
        asm volatile("" ::: "memory");
        float p[16];
#pragma unroll
        for (int i = 0; i < 16; ++i) { p[i] = __builtin_amdgcn_exp2f(S[i]);
            if (kt == mask_kt) { const int key = kt * 32 + (i & 3) + 8 * (i >> 2) + 4 * hh; if (key > qidx) p[i] = 0.f; }
            lsum += p[i]; }
#pragma unroll
        for (int s = 0; s < 2; ++s) {
            u32x4 pw; pw.x = pk2(p[8 * s], p[8 * s + 1]); pw.y = pk2(p[8 * s + 2], p[8 * s + 3]); pw.z = pk2(p[8 * s + 4], p[8 * s + 5]); pw.w = pk2(p[8 * s + 6], p[8 * s + 7]);
            const bf16x8 pa = __builtin_bit_cast(bf16x8, pw);
#pragma unroll
            for (int dt = 0; dt < 4; ++dt) {
                const bf16x8 Bv = __builtin_shufflevector(Vl[s][dt], Vh[s][dt], 0, 1, 2, 3, 4, 5, 6, 7);
                O[dt] = MFMA32(pa, Bv, O[dt]);
            }
        }
    }
}
__device__ __forceinline__ float attn_ref(ArgsP a, int j) {
    const int lane = tid_l() & 63;
    float mq = fmaxf(fabsf(a->in[15][j * 128 + lane]), fabsf(a->in[15][j * 128 + 64 + lane]));
    float mk = fmaxf(fabsf(a->in[16][j * 128 + lane]), fabsf(a->in[16][j * 128 + 64 + lane]));
#pragma unroll
    for (int o = 1; o < 64; o <<= 1) { mq = fmaxf(mq, __shfl_xor(mq, o)); mk = fmaxf(mk, __shfl_xor(mk, o)); }
    return 11.313708499f * mq * mk;
}
constexpr int LDS_LQ = 141312;

__device__ __forceinline__ void attn_a3(ArgsP a, int j, unsigned char* smem) {
    const int tid = tid_l(), lane = tid & 63, wave = tid >> 6, G = sg_l(gridDim.x), r = lane & 31, hh = lane >> 5;
    unsigned char* ws = a->ws;
    const bf16_t* QKVZ = (const bf16_t*)(ws + WS_BIG);
    const unsigned* cnt = (const unsigned*)(ws + WS_CTL); const unsigned short* lists = (const unsigned short*)(ws + WS_TAB);
    float* lpart = (float*)(ws + WS_LPART);
    int* pre = (int*)(smem + 140 * 1024);
    const float ref = attn_ref(a, j), c2 = ref * 1.4426950408889634f;
    int* cntl = (int*)(smem + 136192);
    __syncthreads();
    { const int c = (int)cnt[tid]; cntl[tid] = c; pre[tid] = (c + 255) >> 8; }
    __syncthreads();
    for (int o = 1; o < 512; o <<= 1) { const int v = pre[tid] + (tid >= o ? pre[tid - o] : 0); __syncthreads(); pre[tid] = v; __syncthreads(); }
    const int total = pre[511]; const int bidx = sg_l(blockIdx.x);
    const int t_lo = (int)(((long)total * bidx) / G), t_hi = (int)(((long)total * (bidx + 1)) / G);
    int cur_pr = -1;
    int e_cur = -1; bf16x8 qf[8];
    auto tile_info = [&](int tile, int& pr, int& tl) { int lo = 0, hi = 511; while (lo < hi) { const int mid = (lo + hi) >> 1; if (pre[mid] > tile) hi = mid; else lo = mid + 1; } pr = lo; tl = tile - (pr ? pre[pr - 1] : 0); };
    auto load_entry = [&](int tile) -> int { int pr, tl; tile_info(tile, pr, tl); const int h = pr >> 6, n = pr & 63, c = cntl[pr]; const int li = tl * 256 + wave * 32 + r; const bool valid = li < c;
        const unsigned e = lists[(size_t)h * LIST_PER_HEAD + list_off(n) + (valid ? li : 0)]; return (int)e | (valid ? 0x10000 : 0); };
    int e_nxt = -1;
    if (t_lo < t_hi) { e_cur = load_entry(t_lo); if (t_lo + 1 < t_hi) e_nxt = load_entry(t_lo + 1); int pr, tl; tile_info(t_lo, pr, tl); const int h = pr >> 6;
#pragma unroll
        for (int kk = 0; kk < 8; ++kk) qf[kk] = *(const bf16x8*)(QKVZ + (size_t)(e_cur & 0x3fff) * QK_STRIDE + h * 128 + kk * 16 + hh * 8); }
    for (int tile = t_lo; tile < t_hi; ++tile) {
        int pr, tl; tile_info(tile, pr, tl);
        const int h = pr >> 6, n = pr & 63;
        if (pr != cur_pr) { __syncthreads(); load_kv(QKVZ, h, n, smem); __syncthreads(); cur_pr = pr; }
        int e_nn = -1;
        if (tile + 2 < t_hi) e_nn = load_entry(tile + 2);
        f32x16 O[4];
#pragma unroll
        for (int dt = 0; dt < 4; ++dt)
#pragma unroll
            for (int i = 0; i < 16; ++i) O[dt][i] = 0.f;
        float lsum = 0.f;
        attn_core(smem, qf, 8, -1, 0, c2, O, lsum);
        if (tile + 1 < t_hi) { int pr2, tl2; tile_info(tile + 1, pr2, tl2); const int h2 = pr2 >> 6;
#pragma unroll
            for (int kk = 0; kk < 8; ++kk) qf[kk] = *(const bf16x8*)(QKVZ + (size_t)(e_nxt & 0x3fff) * QK_STRIDE + h2 * 128 + kk * 16 + hh * 8); }
        lsum += __shfl_xor(lsum, 32);
        if (hh == 0 && (e_cur & 0x10000)) lpart[((size_t)((e_cur >> 14) & 3) * L + (e_cur & 0x3fff)) * 8 + h] = lsum;
#pragma unroll
        for (int i = 0; i < 16; ++i) {
            const int ei = __shfl(e_cur, (i & 3) + 8 * (i >> 2) + 4 * hh);
            if (ei & 0x10000) {
                const int slot = (ei >> 14) & 3, ti = ei & 0x3fff;
                bf16_t* P = (bf16_t*)(ws + (slot == 0 ? WS_XN : (slot == 1 ? WS_P1 : WS_P2))) + (size_t)ti * DM + h * 128 + r * 4;
                u32x2 w; w.x = pk2(O[0][i], O[1][i]); w.y = pk2(O[2][i], O[3][i]);
                *(u32x2*)P = w;
            }
        }
        e_cur = e_nxt; e_nxt = e_nn;
    }
}
__device__ __forceinline__ void attn_a4(ArgsP a, int j, unsigned char* smem, int dry) {
    const int tid = tid_l(), lane = tid & 63, wave = tid >> 6, G = sg_l(gridDim.x), r = lane & 31, hh = lane >> 5;
    unsigned char* ws = a->ws;
    const bf16_t* QKVZ = (const bf16_t*)(ws + WS_BIG); const float* lpart = (const float*)(ws + WS_LPART);
    const float ref = attn_ref(a, j), c2 = ref * 1.4426950408889634f;
    float* lq = (float*)(smem + LDS_LQ) + wave * 32;
    const int qt = wave < 4 ? wave : 11 - wave;
    for (int unit = sg_l(blockIdx.x); unit < 512; unit += G) {
        const int h = unit & 7, b = unit >> 3;
        __syncthreads(); load_kv(QKVZ, h, b, smem); __syncthreads();
        const int qidx = qt * 32 + r, t = b * 256 + qidx;
        bf16x8 qf[8];
#pragma unroll
        for (int kk = 0; kk < 8; ++kk) qf[kk] = *(const bf16x8*)(QKVZ + (size_t)t * QK_STRIDE + h * 128 + kk * 16 + hh * 8);
        f32x16 O[4];
#pragma unroll
        for (int dt = 0; dt < 4; ++dt)
#pragma unroll
            for (int i = 0; i < 16; ++i) O[dt][i] = 0.f;
        float lsum = 0.f;
        attn_core(smem, qf, qt + 1, qt, qidx, c2, O, lsum);
        lsum += __shfl_xor(lsum, 32);
        const int nsel = b < 3 ? b : 3;
        for (int s = 0; s < nsel; ++s) lsum += lpart[((size_t)s * L + t) * 8 + h];
        if (hh == 0) lq[r] = 1.0f / lsum;
        __builtin_amdgcn_wave_barrier(); asm volatile("s_waitcnt lgkmcnt(0)" ::: "memory");
#pragma unroll
        for (int ih = 0; ih < 2; ++ih) {
            u32x2 pv[8][3], zv[8];
#pragma unroll
            for (int i8 = 0; i8 < 8; ++i8) {
                const int i = ih * 8 + i8, qi = (i & 3) + 8 * (i >> 2) + 4 * hh; const size_t ti = (size_t)(b * 256 + qt * 32 + qi);
#pragma unroll
                for (int s = 0; s < 3; ++s) pv[i8][s] = s < nsel ? *(const u32x2*)((const bf16_t*)(ws + (s == 0 ? WS_XN : (s == 1 ? WS_P1 : WS_P2))) + ti * DM + h * 128 + r * 4) : (u32x2){0u, 0u};
                zv[i8] = *(const u32x2*)(QKVZ + ti * QK_STRIDE + 3072 + h * 128 + r * 4);
            }
            asm volatile("" ::: "memory");
#pragma unroll
            for (int i8 = 0; i8 < 8; ++i8) {
                const int i = ih * 8 + i8, qi = (i & 3) + 8 * (i >> 2) + 4 * hh; const size_t ti = (size_t)(b * 256 + qt * 32 + qi);
                const float inv = lq[qi];
                float o0 = O[0][i], o1 = O[1][i], o2 = O[2][i], o3 = O[3][i];
#pragma unroll
                for (int s = 0; s < 3; ++s) { o0 += bflo(pv[i8][s].x); o1 += bfhi(pv[i8][s].x); o2 += bflo(pv[i8][s].y); o3 += bfhi(pv[i8][s].y); }
                const float z0 = bflo(zv[i8].x), z1 = bfhi(zv[i8].x), z2 = bflo(zv[i8].y), z3 = bfhi(zv[i8].y);
                u32x2 w; w.x = pk2(o0 * inv * z0 * sigmoidf_(z0), o1 * inv * z1 * sigmoidf_(z1)); w.y = pk2(o2 * inv * z2 * sigmoidf_(z2), o3 * inv * z3 * sigmoidf_(z3));
                if (!dry) *(u32x2*)((bf16_t*)(ws + WS_XN) + ti * DM + h * 128 + r * 4) = w;
            }
        }
        __builtin_amdgcn_wave_barrier();
    }
}

#define XB_TMO      128
#define XB_XCNT(j)  (256  + 64 * (j))
#define XB_XSUB(j)  (1280 + 64 * (j))
#define XB_XGEN(j)  (2304 + 64 * (j))
#define XB_TOP      3328
#define XB_TOPGEN   3392
#define XCD_BAR_WORDS 3456
#define XB_SPIN_CAP (1u << 22)
__device__ __forceinline__ unsigned xb_ld(unsigned* p)              { return __hip_atomic_load(p, __ATOMIC_RELAXED, __HIP_MEMORY_SCOPE_AGENT); }
__device__ __forceinline__ unsigned xb_add(unsigned* p, unsigned v) { return __hip_atomic_fetch_add(p, v, __ATOMIC_RELAXED, __HIP_MEMORY_SCOPE_AGENT); }
__device__ __forceinline__ unsigned xb_xcc_id() { return (unsigned)__builtin_amdgcn_s_getreg((3 << 11) | 20) & 0xFu; }
#define XB_SPIN(cond, bar) do { unsigned _sp = 0; while (cond) { __builtin_amdgcn_s_sleep(1); \
    if ((++_sp & 255u) == 0u) { if (xb_ld(&(bar)[XB_TMO])) break; if (_sp > XB_SPIN_CAP) { atomicAdd(&(bar)[XB_TMO], 1u); break; } } } } while (0)
struct XcdBarrier { unsigned* bar; unsigned x; volatile LAS unsigned* st; };
__device__ __forceinline__ XcdBarrier xcd_barrier_post(unsigned* bar, volatile LAS unsigned* st) {
    XcdBarrier b; b.bar = bar; b.x = xb_xcc_id(); b.st = st;
    if (threadIdx.x == 0) (void)xb_add(&bar[XB_XCNT(b.x)], 1u);
    return b;
}
__device__ __forceinline__ void xcd_barrier_complete(unsigned* bar, unsigned x, unsigned& nloc, unsigned& nx) {
    const unsigned G = gridDim.x * gridDim.y * gridDim.z;
    unsigned sum, cnt, mine, sp = 0u;
    for (;;) {
        sum = 0u; cnt = 0u; mine = 0u;
#pragma unroll
        for (unsigned j = 0; j < 16; ++j) { const unsigned c = xb_ld(&bar[XB_XCNT(j)]); sum += c; cnt += (c > 0u) ? 1u : 0u; mine = (j == x) ? c : mine; }
        if (sum == G) break;
        __builtin_amdgcn_s_sleep(1);
        if ((++sp & 255u) == 0u) { if (xb_ld(&bar[XB_TMO])) break; if (sp > XB_SPIN_CAP) { atomicAdd(&bar[XB_TMO], 1u); break; } }
    }
    nloc = mine > 0u ? mine : 1u; nx = cnt > 0u ? cnt : 1u;
}
__device__ __forceinline__ void xcd_barrier(const XcdBarrier& b) {
    asm volatile("s_waitcnt vmcnt(0)" ::: "memory");
    __syncthreads();
    if (threadIdx.x == 0) {
        unsigned* bar = b.bar;
        __builtin_amdgcn_s_waitcnt(0);
        unsigned nloc = b.st[0], nx = b.st[1];
        if (nloc == 0u) { xcd_barrier_complete(bar, b.x, nloc, nx); b.st[0] = nloc; b.st[1] = nx; }
        const unsigned old = xb_add(&bar[XB_XSUB(b.x)], 1u);
        const unsigned gen = old / nloc;
        if (old + 1u == (gen + 1u) * nloc) {
            __builtin_amdgcn_fence(__ATOMIC_RELEASE, "agent");
            asm volatile("s_waitcnt vmcnt(0)" ::: "memory");
            const unsigned og = xb_add(&bar[XB_TOP], 1u);
            const unsigned tg = og / nx;
            if (og + 1u == (tg + 1u) * nx) xb_add(&bar[XB_TOPGEN], 1u);
            else XB_SPIN(xb_ld(&bar[XB_TOPGEN]) == tg, bar);
            __builtin_amdgcn_fence(__ATOMIC_ACQUIRE, "agent");
            xb_add(&bar[XB_XGEN(b.x)], 1u);
            asm volatile("s_waitcnt vmcnt(0)" ::: "memory");
        } else {
            XB_SPIN(xb_ld(&bar[XB_XGEN(b.x)]) == gen, bar);
            __builtin_amdgcn_fence(__ATOMIC_ACQUIRE, "agent");
            asm volatile("s_waitcnt vmcnt(0)" ::: "memory");
        }
    }
    __syncthreads();
}
#ifndef PH_MASK
#define PH_MASK 0xFFFF
#endif
#define PH(b) ((PH_MASK >> (b)) & 1)
#ifndef REP_MASK
#define REP_MASK 0
#endif
#ifndef XSYNC
#define XSYNC 0
#endif
#define REP(b) for (int _r = 0; _r < 1 + ((REP_MASK >> (b)) & 1); ++_r)
__global__ void __launch_bounds__(512, 2) hybrid_fwd(Args a_unused) {
    extern __shared__ __attribute__((aligned(16))) unsigned char smem[];
    cg::grid_group grid = cg::this_grid();
    LAS unsigned char* lds = (LAS unsigned char*)smem;
    const ArgsP ap = (ArgsP)__builtin_amdgcn_kernarg_segment_ptr();
    if (threadIdx.x < 2) ((volatile LAS unsigned*)(lds + LDS_BARST))[threadIdx.x] = 0u;
    __syncthreads();
    if (blockIdx.x == 0) for (int e = threadIdx.x; e < XCD_BAR_WORDS; e += 512) ((unsigned*)(ap->ws + WS_BAR))[e] = 0u;

#define a launder(ap)
#define ws (launder(ap)->ws)
#define Wb ((bf16_t*)(ws + WS_W))
#define XN ((bf16_t*)(ws + WS_XN))
    REP(0) if (PH(0)) pre0_phase(a);
    grid.sync();
    (void)xcd_barrier_post((unsigned*)(ws + WS_BAR), (volatile LAS unsigned*)(lds + LDS_BARST));
#define GSYNC() do { XcdBarrier _b; _b.bar = (unsigned*)(ws + WS_BAR); _b.x = xb_xcc_id(); _b.st = (volatile LAS unsigned*)(lds + LDS_BARST); xcd_barrier(_b); } while (0)
    for (int _x = 0; _x < XSYNC; ++_x) GSYNC();
    REP(0) if (PH(0)) prep_phase(a, 0, a->in[0], smem);
    GSYNC();
#pragma unroll 1
    for (int layer = 0; layer < 4; ++layer) {
        const int j = layer >> 1;
        if ((layer & 1) == 0) {
            REP(1) if (PH(1)) { pg8::Gemm g{layer == 0 ? XN : (bf16_t*)(ws + WS_Y2), Wb, L, 2048, 1024}; pg8::StaticOrder S; S.init(L, 2048, sg_l(gridDim.x), sg_l(blockIdx.x));
              pg8::EpiStore E{(bf16_t*)(ws + WS_U), 1024, 1024, (size_t)(WS_Z - WS_U) / 2, (const float*)(ws + WS_ROWSQ), 1};
              pg8::gemm_phase<pg8::EpiStore, pg8::StaticOrder, true, true>(lds, g, S, E); }
            GSYNC();
            REP(2) if (PH(2)) ssm_s1(a, smem);
            GSYNC();
            REP(3) if (PH(3)) ssm_s2(a, j, smem);
            GSYNC();
            REP(4) if (PH(4)) ssm_s3(a, j, smem);
            GSYNC();
            REP(5) if (PH(5)) { pg8::Gemm g{(const bf16_t*)(ws + WS_YG), Wb + 2048 * 1024, L, 1024, 1024}; pg8::StaticOrder S; S.init(L, 1024, sg_l(gridDim.x), sg_l(blockIdx.x));
              pg8::EpiGlu E{(const bf16_t*)(ws + WS_YG), (const bf16_t*)(ws + WS_Z), a->in[12] + j * 1024, (bf16_t*)(ws + WS_Y2)};
              pg8::gemm_phase<pg8::EpiGlu, pg8::StaticOrder, true, true, true>(lds, g, S, E); }
            GSYNC();
            if (layer < 3) { if (PH(13)) prep_phase(a, layer + 1, a->out, smem); __syncthreads(); }
            REP(6) if (PH(6)) { pg8::Gemm g{(const bf16_t*)(ws + WS_Y2), Wb + 4096 * 1024, L, 1024, 1024}; pg8::StaticOrder S; S.init(L, 1024, sg_l(gridDim.x), sg_l(blockIdx.x));
              pg8::EpiRes E{layer == 0 ? a->in[0] : (const float*)a->out, a->out, layer < 3 ? XN : (bf16_t*)nullptr, (float*)(ws + WS_ROWSQ)};
              pg8::gemm_phase<pg8::EpiRes, pg8::StaticOrder, true, true>(lds, g, S, E); }
            GSYNC();
        } else {
            REP(7) if (PH(7)) { pg8::Gemm g{XN, Wb, L, 4096, 1024}; pg8::StaticOrder S; S.init(L, 4096, sg_l(gridDim.x), sg_l(blockIdx.x));
              pg8::EpiStore E{(bf16_t*)(ws + WS_BIG), 4096, 0, 0, (const float*)(ws + WS_ROWSQ), 0};
              pg8::gemm_phase<pg8::EpiStore, pg8::StaticOrder, true, true>(lds, g, S, E); }
            GSYNC();
            REP(8) if (PH(8)) attn_a1(a, j, smem, sg_l(_r == 0 && ((REP_MASK >> 8) & 1)));
            GSYNC();
            REP(9) if (PH(9)) attn_a2(a, smem, sg_l(_r == 0 && ((REP_MASK >> 9) & 1)));
            GSYNC();
            REP(10) if (PH(10)) attn_a3(a, j, smem);
            GSYNC();
            REP(11) if (PH(11)) attn_a4(a, j, smem, sg_l(_r == 0 && ((REP_MASK >> 11) & 1)));
            GSYNC();
            if (layer < 3) { if (PH(13)) prep_phase(a, layer + 1, a->out, smem); __syncthreads(); }
            REP(12) if (PH(12)) { pg8::Gemm g{XN, (const bf16_t*)(ws + WS_W2), L, 1024, 1024}; pg8::StaticOrder S; S.init(L, 1024, sg_l(gridDim.x), sg_l(blockIdx.x));
              pg8::EpiRes E{(const float*)a->out, a->out, layer < 3 ? (bf16_t*)(ws + WS_Y2) : (bf16_t*)nullptr, (float*)(ws + WS_ROWSQ)};
              pg8::gemm_phase<pg8::EpiRes, pg8::StaticOrder, true, true>(lds, g, S, E); }
            GSYNC();
        }
    }
}

#undef GSYNC
#undef a
#undef ws
#undef Wb
#undef XN
extern "C" void kernel_launch(void* const* d_in, const int* in_sizes, int n_in, void* d_out, int out_size, void* d_ws, size_t ws_size, hipStream_t stream) {
    static int grid = 0;
    if (grid == 0) {
        if (n_in != 18 || out_size != L * DM || ws_size < WS_END) { fprintf(stderr, "kernel_launch: unexpected shapes (n_in %d, out %d, ws %zu)\n", n_in, out_size, ws_size); grid = -1; return; }
        int dev = 0, cus = 0, per_cu = 0;
        (void)hipGetDevice(&dev); (void)hipDeviceGetAttribute(&cus, hipDeviceAttributeMultiprocessorCount, dev);
        (void)hipFuncSetAttribute((const void*)hybrid_fwd, hipFuncAttributeMaxDynamicSharedMemorySize, LDS_BYTES);
        (void)hipOccupancyMaxActiveBlocksPerMultiprocessor(&per_cu, (const void*)hybrid_fwd, 512, LDS_BYTES);
        if (per_cu < 1) { fprintf(stderr, "kernel_launch: occupancy query says %d blocks per CU\n", per_cu); per_cu = 1; }
        grid = cus * 1;
        if (grid > 256) grid = 256;
    }
    if (grid < 0) return;
    Args a{};
    for (int i = 0; i < 18; ++i) a.in[i] = (const float*)d_in[i];
    a.out = (float*)d_out; a.ws = (unsigned char*)d_ws;
    void* args[] = {&a};
    hipError_t e = hipLaunchCooperativeKernel((const void*)hybrid_fwd, dim3(grid), dim3(512), args, LDS_BYTES, stream);
    if (e != hipSuccess) fprintf(stderr, "cooperative launch failed: %s (grid %d)\n", hipGetErrorString(e), grid);
}
```
